# Optimizing an MI355X kernel written in HIP

```python
import math
import jax, jax.numpy as jnp
from jax import lax
import numpy as np

D_MODEL = 2048
BATCH = 8
SEQ = 4096
DEPTH = 1
DEC_BATCH = 32
DEC_SEQ = 16
PAST_LEN = 4096

CHUNK = 64
Q_BLOCK = 128
A_HEADS = D_MODEL // 256
A_HEAD_DIM = 64
A_V_DIM = 2 * A_HEAD_DIM
A_WIDTH = A_HEADS * A_V_DIM
A_QK_WIDTH = A_HEADS * 2 * A_HEAD_DIM
ROT_DIM = A_HEAD_DIM // 4
ROPE_THETA = 500000.0
B_HEADS = D_MODEL // 256
B_KEY_DIM = 128
B_VAL_DIM = 128
B_KEY_WIDTH = B_HEADS * B_KEY_DIM
B_WIDTH = B_HEADS * B_VAL_DIM
N_MEM = 256
C_HEADS = 4
C_HEAD_DIM = D_MODEL // 8
C_WIDTH = C_HEADS * C_HEAD_DIM
DN_ALPHA = (2 * DEPTH) ** 0.25
DN_BETA = (8 * DEPTH) ** -0.25
NORM_EPS = 1e-5
IN_WIDTHS = (A_QK_WIDTH, A_QK_WIDTH, A_WIDTH, A_WIDTH,
             B_KEY_WIDTH, B_KEY_WIDTH, B_WIDTH, B_WIDTH, B_WIDTH,
             C_WIDTH, C_WIDTH,
             D_MODEL, D_MODEL, D_MODEL)
N_IN = sum(IN_WIDTHS)

kernel_name = 'stream_diffattn_hgrn2_mem_step'


def _rms_norm(x, g):
    xf = x.astype(jnp.float32)
    return xf * lax.rsqrt(jnp.mean(xf * xf, axis=-1, keepdims=True) + NORM_EPS) * g.astype(jnp.float32)


def _layer_norm(x, g, b):
    xf = x.astype(jnp.float32)
    mu = jnp.mean(xf, axis=-1, keepdims=True)
    var = jnp.mean(jnp.square(xf - mu), axis=-1, keepdims=True)
    return (xf - mu) * lax.rsqrt(var + NORM_EPS) * g.astype(jnp.float32) + b.astype(jnp.float32)


def _rope_partial(x, pos):
    inv_freq = jnp.power(ROPE_THETA, -jnp.arange(0, ROT_DIM, 2, dtype=jnp.float32) / ROT_DIM)
    ang = pos.astype(jnp.float32)[:, None] * inv_freq[None, :]
    cos = jnp.cos(ang)[:, None, None, :]
    sin = jnp.sin(ang)[:, None, None, :]
    xr = x[..., :ROT_DIM].astype(jnp.float32)
    x1, x2 = xr[..., :ROT_DIM // 2], xr[..., ROT_DIM // 2:]
    rot = jnp.concatenate([x1 * cos - x2 * sin, x2 * cos + x1 * sin], axis=-1)
    return jnp.concatenate([rot.astype(x.dtype), x[..., ROT_DIM:]], axis=-1)


def _diff_weights(s, lam):
    p = jax.nn.softmax(s, axis=-1)
    return p[:, :, 0] - lam * p[:, :, 1]


def _diff_attn_prompt(q, k, v, lam):
    n_b, seq = q.shape[:2]
    n_blk = seq // Q_BLOCK
    q_blocks = jnp.moveaxis(q.reshape(n_b, n_blk, Q_BLOCK, A_HEADS, 2, A_HEAD_DIM), 1, 0)
    key_chunk = jnp.arange(seq) // CHUNK
    vf = v.astype(jnp.float32)
    scale = A_HEAD_DIM ** -0.5

    def one_block(args):
        qb, start = args
        q_chunk = (start + jnp.arange(Q_BLOCK)) // CHUNK
        s = jnp.einsum('bqhmd,bkhmd->bhmqk', qb, k).astype(jnp.float32) * scale
        allowed = key_chunk[None, :] <= q_chunk[:, None]
        s = jnp.where(allowed, s, -jnp.inf)
        w = _diff_weights(s, lam)
        return jnp.einsum('bhqk,bkhe->bqhe', w, vf)

    o = lax.map(one_block, (q_blocks, jnp.arange(n_blk) * Q_BLOCK))
    return jnp.moveaxis(o, 0, 1).reshape(n_b, seq, A_HEADS, A_V_DIM)


def _diff_attn_sample(q, k_all, v_all, lam):
    s = jnp.einsum('bqhmd,bkhmd->bhmqk', q, k_all).astype(jnp.float32) * (A_HEAD_DIM ** -0.5)
    w = _diff_weights(s, lam)
    return jnp.einsum('bhqk,bkhe->bqhe', w, v_all.astype(jnp.float32))


def _hgrn2_chunkwise(q, k, v, g, s0, blk):
    n_b, t = q.shape[:2]
    n_c = t // blk

    def to_chunks(a):
        return a.reshape(n_b, n_c, blk, B_HEADS, a.shape[-1]).transpose(1, 0, 3, 2, 4)

    qc, kc, vc, gc = to_chunks(q), to_chunks(k), to_chunks(v), to_chunks(g)
    b = jnp.cumsum(gc, axis=3)
    mid = (blk - 1) // 2
    b_mid = b[:, :, :, mid:mid + 1, :]
    b_last = b[:, :, :, -1:, :]
    scores = jnp.einsum('cnhtd,cnhsd->cnhts', qc * jnp.exp(b - b_mid), kc * jnp.exp(b_mid - b))
    causal = jnp.tril(jnp.ones((blk, blk), dtype=bool))
    o_intra = jnp.einsum('cnhts,cnhse->cnhte', jnp.where(causal, scores, 0.0), vc)
    q_from_state = qc * jnp.exp(b)
    k_to_state = kc * jnp.exp(b_last - b)
    chunk_decay = jnp.exp(b_last[:, :, :, 0, :])

    def step(state, inp):
        q_i, k_i, v_i, d_i = inp
        o_i = jnp.einsum('nhtd,nhde->nhte', q_i, state)
        state = state * d_i[..., None] + jnp.einsum('nhtd,nhte->nhde', k_i, v_i)
        return state, o_i

    s_fin, o_inter = lax.scan(step, s0, (q_from_state, k_to_state, vc, chunk_decay))
    o = (o_intra + o_inter).transpose(1, 0, 3, 2, 4).reshape(n_b, t, B_HEADS, v.shape[-1])
    return o, s_fin


def _mem_attn(q, mem_k, mem_v):
    s = jnp.einsum('bthd,bmhd->bhtm', q, mem_k).astype(jnp.float32) * (C_HEAD_DIM ** -0.5)
    p = jax.nn.softmax(s, axis=-1)
    return jnp.einsum('bhtm,bmhd->bthd', p, mem_v.astype(jnp.float32))


def _layer(x, pos, past_k, past_v, hgrn_s0, mem_k, mem_v, rec_block, layer_idx, lower_bound, params):
    (w_in, lq1, lk1, lq2, lk2, sub_norm, hgrn_gain, w_a, w_b, w_c, w_o, ln_g, ln_b) = params
    f32 = jnp.float32
    n_b, t, _ = x.shape
    split_at = [int(c) for c in np.cumsum(IN_WIDTHS)[:-1]]
    (qa, ka, va, za, qb, fb, ib, ogb, zb, qc, zc,
     gate_a, gate_b, gate_c) = jnp.split(x @ w_in, split_at, axis=-1)

    qa = _rope_partial(qa.reshape(n_b, t, A_HEADS, 2, A_HEAD_DIM), pos)
    ka = _rope_partial(ka.reshape(n_b, t, A_HEADS, 2, A_HEAD_DIM), pos)
    va = va.reshape(n_b, t, A_HEADS, A_V_DIM)
    lam_init = 0.8 - 0.6 * math.exp(-0.3 * layer_idx)
    lam = (jnp.exp(jnp.sum(lq1.astype(f32) * lk1.astype(f32)))
           - jnp.exp(jnp.sum(lq2.astype(f32) * lk2.astype(f32))) + lam_init)
    if past_k is None:
        oa = _diff_attn_prompt(qa, ka, va, lam)
    else:
        oa = _diff_attn_sample(qa, jnp.concatenate([past_k, ka], axis=1),
                               jnp.concatenate([past_v, va], axis=1), lam)
    ya = (_rms_norm(oa, sub_norm) * (1.0 - lam_init)).reshape(n_b, t, A_WIDTH) * jax.nn.silu(za.astype(f32))

    fgate = (lower_bound + (1.0 - lower_bound) * jax.nn.sigmoid(fb.astype(f32))).reshape(n_b, t, B_HEADS, B_KEY_DIM)
    qh = jax.nn.silu(qb.astype(f32)).reshape(n_b, t, B_HEADS, B_KEY_DIM)
    vh = ib.astype(f32).reshape(n_b, t, B_HEADS, B_VAL_DIM)
    ob, s_fin = _hgrn2_chunkwise(qh, 1.0 - fgate, vh, jnp.log(fgate), hgrn_s0.astype(f32), rec_block)
    ob = _rms_norm(ob, hgrn_gain.reshape(B_HEADS, B_VAL_DIM)) * jax.nn.sigmoid(
        ogb.astype(f32).reshape(n_b, t, B_HEADS, B_VAL_DIM))
    yb = ob.reshape(n_b, t, B_WIDTH) * jax.nn.silu(zb.astype(f32))

    oc = _mem_attn(qc.reshape(n_b, t, C_HEADS, C_HEAD_DIM), mem_k, mem_v)
    yc = oc.reshape(n_b, t, C_WIDTH) * jax.nn.silu(zc.astype(f32))

    merged = (jax.nn.sigmoid(gate_a.astype(f32)) * (ya @ w_a.astype(f32))
              + jax.nn.sigmoid(gate_b.astype(f32)) * (yb @ w_b.astype(f32))
              + jax.nn.sigmoid(gate_c.astype(f32)) * (yc @ w_c.astype(f32)))
    sub = merged @ w_o.astype(f32)
    y = _layer_norm(DN_ALPHA * x.astype(f32) + sub, ln_g, ln_b).astype(x.dtype)
    return y, ka, va, s_fin.astype(x.dtype)


def setup_inputs(seed: int = 0) -> dict:
    key = jax.random.key(seed)
    ks = jax.random.split(key, 26)

    def nrm(k, shape, s):
        return jax.random.normal(k, shape, jnp.float32) * s

    return {
        'x_prompt': nrm(ks[0], (BATCH, SEQ, D_MODEL), 1.0),
        'x_sample': nrm(ks[1], (DEC_BATCH, DEC_SEQ, D_MODEL), 1.0),
        'cache_attn_k': nrm(ks[2], (DEPTH, DEC_BATCH, PAST_LEN, A_HEADS, 2, A_HEAD_DIM), 1.0),
        'cache_attn_v': nrm(ks[3], (DEPTH, DEC_BATCH, PAST_LEN, A_HEADS, A_V_DIM), 1.0),
        'state_hgrn': nrm(ks[4], (DEPTH, DEC_BATCH, B_HEADS, B_KEY_DIM, B_VAL_DIM), 0.3),
        'cache_mem_k': nrm(ks[5], (DEPTH, DEC_BATCH, N_MEM, C_HEADS, C_HEAD_DIM), 1.0),
        'cache_mem_v': nrm(ks[6], (DEPTH, DEC_BATCH, N_MEM, C_HEADS, C_HEAD_DIM), 1.0),
        'mem_prompt': nrm(ks[7], (BATCH, N_MEM, D_MODEL), 1.0),
        'w_in': nrm(ks[8], (DEPTH, D_MODEL, N_IN), D_MODEL ** -0.5),
        'lambda_q1': nrm(ks[9], (DEPTH, A_HEAD_DIM), 0.1),
        'lambda_k1': nrm(ks[10], (DEPTH, A_HEAD_DIM), 0.1),
        'lambda_q2': nrm(ks[11], (DEPTH, A_HEAD_DIM), 0.1),
        'lambda_k2': nrm(ks[12], (DEPTH, A_HEAD_DIM), 0.1),
        'attn_sub_norm': 1.0 + nrm(ks[13], (DEPTH, A_V_DIM), 0.02),
        'hgrn_lb_logits': nrm(ks[14], (DEPTH + 1, B_KEY_WIDTH), 0.5),
        'hgrn_norm': 1.0 + nrm(ks[15], (DEPTH, B_WIDTH), 0.02),
        'w_mem_k': nrm(ks[16], (DEPTH, D_MODEL, C_WIDTH), D_MODEL ** -0.5),
        'w_mem_v': nrm(ks[17], (DEPTH, D_MODEL, C_WIDTH), D_MODEL ** -0.5),
        'w_branch_a': nrm(ks[18], (DEPTH, A_WIDTH, D_MODEL), A_WIDTH ** -0.5 * DN_BETA),
        'w_branch_b': nrm(ks[19], (DEPTH, B_WIDTH, D_MODEL), B_WIDTH ** -0.5 * DN_BETA),
        'w_branch_c': nrm(ks[20], (DEPTH, C_WIDTH, D_MODEL), C_WIDTH ** -0.5 * DN_BETA),
        'w_out': nrm(ks[21], (DEPTH, D_MODEL, D_MODEL), D_MODEL ** -0.5 * DN_BETA),
        'ln_gamma': 1.0 + nrm(ks[22], (DEPTH, D_MODEL), 0.02),
        'ln_beta': nrm(ks[23], (DEPTH, D_MODEL), 0.02),
    }


def reference(x_prompt, x_sample, cache_attn_k, cache_attn_v, state_hgrn, cache_mem_k, cache_mem_v,
              mem_prompt, w_in, lambda_q1, lambda_k1, lambda_q2, lambda_k2, attn_sub_norm,
              hgrn_lb_logits, hgrn_norm, w_mem_k, w_mem_v, w_branch_a, w_branch_b, w_branch_c,
              w_out, ln_gamma, ln_beta):
    bp, seq = x_prompt.shape[:2]
    t_new = x_sample.shape[1]
    past = cache_attn_k.shape[2]
    pos_prompt = jnp.arange(seq)
    pos_sample = past + jnp.arange(t_new)
    lower_bounds = jnp.cumsum(jax.nn.softmax(hgrn_lb_logits.astype(jnp.float32), axis=0), axis=0)

    h_p, h_s = x_prompt, x_sample
    kp_l, vp_l, sp_l, mkp_l, mvp_l, ks_l, vs_l, ss_l = [], [], [], [], [], [], [], []
    for l in range(DEPTH):
        params = (w_in[l], lambda_q1[l], lambda_k1[l], lambda_q2[l], lambda_k2[l], attn_sub_norm[l],
                  hgrn_norm[l], w_branch_a[l], w_branch_b[l], w_branch_c[l], w_out[l],
                  ln_gamma[l], ln_beta[l])
        mk_p = (mem_prompt @ w_mem_k[l]).reshape(bp, N_MEM, C_HEADS, C_HEAD_DIM)
        mv_p = (mem_prompt @ w_mem_v[l]).reshape(bp, N_MEM, C_HEADS, C_HEAD_DIM)
        s0_p = jnp.zeros((bp, B_HEADS, B_KEY_DIM, B_VAL_DIM), jnp.float32)
        h_p, k_p, v_p, s_p = _layer(h_p, pos_prompt, None, None, s0_p, mk_p, mv_p, CHUNK, l,
                                    lower_bounds[l], params)
        h_s, k_s, v_s, s_s = _layer(h_s, pos_sample, cache_attn_k[l], cache_attn_v[l], state_hgrn[l],
                                    cache_mem_k[l], cache_mem_v[l], t_new, l, lower_bounds[l], params)
        kp_l.append(k_p); vp_l.append(v_p); sp_l.append(s_p); mkp_l.append(mk_p); mvp_l.append(mv_p)
        ks_l.append(k_s); vs_l.append(v_s); ss_l.append(s_s)

    k_prompt = jnp.stack(kp_l)
    v_prompt = jnp.stack(vp_l)
    hgrn_prompt = jnp.stack(sp_l)
    mem_k_prompt = jnp.stack(mkp_l)
    mem_v_prompt = jnp.stack(mvp_l)
    k_sample = jnp.stack(ks_l)
    v_sample = jnp.stack(vs_l)
    hgrn_sample = jnp.stack(ss_l)
    return (h_p, h_s, k_prompt, v_prompt, hgrn_prompt, mem_k_prompt, mem_v_prompt,
            k_sample, v_sample, hgrn_sample)
```

```cpp
#include <hip/hip_runtime.h>
#include <cstdio>
#include <cstdint>

#define GAS __attribute__((address_space(1)))
#define LAS __attribute__((address_space(3)))
typedef unsigned short bf16;
typedef unsigned v4u __attribute__((ext_vector_type(4)));
typedef unsigned v2u __attribute__((ext_vector_type(2)));
typedef float v4f __attribute__((ext_vector_type(4)));
typedef float v2f __attribute__((ext_vector_type(2)));
#define DI __device__ __forceinline__

constexpr int D = 2048, NB = 8, SEQ = 4096, MP = NB * SEQ, DB = 32, DS = 16, MS = DB * DS, M = MP + MS, PAST = 4096, NMEM = 256;
constexpr int NIN = 17408;
constexpr int C_QA = 0, C_KA = 1024, C_VA = 2048, C_ZA = 3072, C_QB = 4096, C_FB = 5120, C_IB = 6144, C_OG = 7168, C_ZB = 8192, C_QC = 9216, C_ZC = 10240, C_GA = 11264, C_GB = 13312, C_GC = 15360;
constexpr float LOG2E = 1.4426950408889634f, LN2 = 0.6931471805599453f;
constexpr float QA_SCALE = 0.125f * LOG2E, QC_SCALE = 0.0625f * LOG2E;
constexpr float DN_ALPHA = 1.189207115002721f, NORM_EPS = 1e-5f, ONE_M_LAMINIT = 0.8f, LAM_INIT = 0.2f;
constexpr size_t O_YP = 0, O_YS = (size_t)MP * D, O_KP = O_YS + (size_t)MS * D, O_VP = O_KP + (size_t)MP * 1024, O_HP = O_VP + (size_t)MP * 1024,
                 O_MK = O_HP + (size_t)NB * 8 * 128 * 128, O_MV = O_MK + (size_t)NB * NMEM * 1024, O_KS = O_MV + (size_t)NB * NMEM * 1024, O_VS = O_KS + (size_t)MS * 1024,
                 O_HS = O_VS + (size_t)MS * 1024, O_END = O_HS + (size_t)DB * 8 * 128 * 128;
static_assert(O_END == 145752064ull, "output size");
constexpr size_t MiB = 1u << 20;
constexpr size_t WS_CTL = 0, CTL_ZERO_BYTES = 1 * MiB, WS_ROPE = 1 * MiB, WS_XB = 2 * MiB, WS_WT = 140 * MiB, WS_WABC = 216 * MiB, WS_WO = 228 * MiB, WS_MKV = 236 * MiB,
                 WS_G = 244 * MiB, WS_OB = 374 * MiB, WS_P = 504 * MiB, WS_END = 1609 * MiB, WS_MG = WS_XB;
static_assert(WS_XB + (size_t)(M + 2048) * D * 2 <= WS_WT && WS_WT + (size_t)(NIN + 2048) * D * 2 <= WS_WABC && WS_G + (size_t)M * 1024 * 4 <= WS_OB && WS_OB + (size_t)M * 1024 * 4 <= WS_P && WS_P + (size_t)M * NIN * 2 <= WS_END, "ws map");
constexpr int CW_BAR = 4096;
constexpr int RING_BYTES = 131072, LDSCTL_OFF = RING_BYTES, MISC_OFF = LDSCTL_OFF + 320, LDS_BYTES = 147456;

DI float bf2f(unsigned short u) { return __uint_as_float((unsigned)u << 16); }
DI float bflo(unsigned u) { return __uint_as_float(u << 16); }
DI float bfhi(unsigned u) { return __uint_as_float(u & 0xffff0000u); }
DI unsigned f2bf(float f) { unsigned u = __float_as_uint(f); return (u + 0x7fffu + ((u >> 16) & 1u)) >> 16; }
DI unsigned pk2(float lo, float hi) { return f2bf(lo) | (f2bf(hi) << 16); }
DI float fexp2(float x) { return __builtin_amdgcn_exp2f(x); }
DI float frcp(float x) { return __builtin_amdgcn_rcpf(x); }
DI float sigm(float x) { return frcp(1.0f + fexp2(-x * LOG2E)); }
DI float silu(float x) { return x * sigm(x); }
DI float wave_sum(float v) {
#pragma unroll
    for (int o = 1; o < 64; o <<= 1) v += __shfl_xor(v, o);
    return v;
}
DI float wave_max(float v) {
#pragma unroll
    for (int o = 1; o < 64; o <<= 1) v = fmaxf(v, __shfl_xor(v, o));
    return v;
}

#define XB_TMO      128
#define XB_XCNT(j)  (256  + 64 * (j))
#define XB_XSUB(j)  (1280 + 64 * (j))
#define XB_XGEN(j)  (2304 + 64 * (j))
#define XB_TOP      3328
#define XB_TOPGEN   3392
#define XCD_BAR_WORDS 3456
#define XB_SPIN_CAP (1u << 18)
DI unsigned xb_ld(unsigned* p)              { return __hip_atomic_load(p, __ATOMIC_RELAXED, __HIP_MEMORY_SCOPE_AGENT); }
DI unsigned xb_add(unsigned* p, unsigned v) { return __hip_atomic_fetch_add(p, v, __ATOMIC_RELAXED, __HIP_MEMORY_SCOPE_AGENT); }
DI unsigned xb_xcc_id() { return (unsigned)__builtin_amdgcn_s_getreg((3 << 11) | 20) & 0xFu; }
#define XB_SPIN(cond, bar) do { unsigned _sp = 0; while (cond) { __builtin_amdgcn_s_sleep(1); \
    if ((++_sp & 255u) == 0u) { if (xb_ld(&(bar)[XB_TMO])) break; if (_sp > XB_SPIN_CAP) { atomicAdd(&(bar)[XB_TMO], 1u); break; } } } } while (0)
struct XcdBarrier { unsigned* bar; unsigned x; volatile LAS unsigned* st; };
DI XcdBarrier xcd_barrier_post(unsigned* bar, volatile LAS unsigned* st) {
    XcdBarrier b; b.bar = bar; b.x = xb_xcc_id(); b.st = st;
    if (threadIdx.x == 0) (void)xb_add(&bar[XB_XCNT(b.x)], 1u);
    return b;
}
DI void xcd_barrier_complete(unsigned* bar, unsigned x, unsigned& nloc, unsigned& nx) {
    const unsigned G = gridDim.x * gridDim.y * gridDim.z;
    unsigned sum, cnt, mine, sp = 0u;
    for (;;) {
        sum = 0u; cnt = 0u; mine = 0u;
#pragma unroll
        for (unsigned j = 0; j < 16; ++j) { const unsigned c = xb_ld(&bar[XB_XCNT(j)]); sum += c; cnt += (c > 0u) ? 1u : 0u; mine = (j == x) ? c : mine; }
        if (sum == G) break;
        __builtin_amdgcn_s_sleep(1);
        if ((++sp & 255u) == 0u) { if (xb_ld(&bar[XB_TMO])) break; if (sp > XB_SPIN_CAP) { atomicAdd(&bar[XB_TMO], 1u); break; } }
    }
    nloc = mine > 0u ? mine : 1u; nx = cnt > 0u ? cnt : 1u;
}
DI void xcd_barrier(const XcdBarrier& b) {
    asm volatile("s_waitcnt vmcnt(0)" ::: "memory");
    __syncthreads();
    if (threadIdx.x == 0) {
        unsigned* bar = b.bar;
        __builtin_amdgcn_s_waitcnt(0);
        unsigned nloc = b.st[0], nx = b.st[1];
        if (nloc == 0u) { xcd_barrier_complete(bar, b.x, nloc, nx); b.st[0] = nloc; b.st[1] = nx; }
        const unsigned old = xb_add(&bar[XB_XSUB(b.x)], 1u);
        const unsigned gen = old / nloc;
        if (old + 1u == (gen + 1u) * nloc) {
            __builtin_amdgcn_fence(__ATOMIC_RELEASE, "agent");
            asm volatile("s_waitcnt vmcnt(0)" ::: "memory");
            const unsigned og = xb_add(&bar[XB_TOP], 1u);
            const unsigned tg = og / nx;
            if (og + 1u == (tg + 1u) * nx) xb_add(&bar[XB_TOPGEN], 1u);
            else XB_SPIN(xb_ld(&bar[XB_TOPGEN]) == tg, bar);
            __builtin_amdgcn_fence(__ATOMIC_ACQUIRE, "agent");
            xb_add(&bar[XB_XGEN(b.x)], 1u);
            asm volatile("s_waitcnt vmcnt(0)" ::: "memory");
        } else {
            XB_SPIN(xb_ld(&bar[XB_XGEN(b.x)]) == gen, bar);
            __builtin_amdgcn_fence(__ATOMIC_ACQUIRE, "agent");
            asm volatile("s_waitcnt vmcnt(0)" ::: "memory");
        }
    }
    __syncthreads();
}

namespace pg8 {
#define PG8_LAS __attribute__((address_space(3)))
typedef unsigned short bf16_t;
typedef short bf16x8 __attribute__((ext_vector_type(8)));
typedef float f32x4 __attribute__((ext_vector_type(4)));
typedef unsigned u32x4 __attribute__((ext_vector_type(4)));
constexpr int BM = 256, BK = 64, HALF = 128, HTB = HALF * BK * 2, STAGE_BYTES = 8 * HTB, NXCD = 8, WGM = 8;
__host__ __device__ __forceinline__ int lds_byte(int r, int c) { const int st = (r >> 4) * 2 + (c >> 5), rr = r & 15, cc = c & 31, ob = rr * 64 + cc * 2; return st * 1024 + (ob ^ (((ob >> 9) & 1) << 5)); }
__host__ __device__ __forceinline__ void stage_rc(int b, int& R, int& C) { const int st = b / 1024, sb = b % 1024, swz = sb ^ (((sb >> 9) & 1) << 5); R = (st >> 1) * 16 + swz / 64; C = (st & 1) * 32 + (swz % 64) / 2; }
__host__ __device__ __forceinline__ int perm32(int rho) { const int n = rho >> 4, i = rho & 15; return 8 * (i >> 2) + 4 * n + (i & 3); }
struct Unit { int pm, pn, br; };
template <int AC0, int AC1, int AC2>
struct GemmT {
    const char* A; const char* Bt; int lda, ldb, K; size_t b_br;
    __device__ __forceinline__ const char* a_ptr(const Unit& u) const { const int ac = u.br == 0 ? AC0 : (u.br == 1 ? AC1 : AC2); return A + ((size_t)u.pm * BM * lda + ac) * 2; }
    __device__ __forceinline__ const char* b_ptr(const Unit& u) const { return Bt + (size_t)u.br * b_br + (size_t)u.pn * BM * ldb * 2; }
};
__host__ __device__ __forceinline__ void tile_of(int L, int nM, int nN, int& pm, int& pn) {
    const int nwg = nM * nN; int wgid = L; { const int q = nwg / NXCD, r = nwg % NXCD, xcd = wgid % NXCD, off = wgid / NXCD; wgid = (xcd < r ? xcd * (q + 1) : r * (q + 1) + (xcd - r) * q) + off; }
    const int nig = WGM * nN, gid = wgid / nig, fm = gid * WGM, gsz = (nM - fm) < WGM ? (nM - fm) : WGM;
    pm = fm + ((wgid % nig) % gsz); pn = (wgid % nig) / gsz;
}
__device__ __forceinline__ unsigned cvt_pk_bf16(float lo, float hi) { unsigned r; asm volatile("v_cvt_pk_bf16_f32 %0, %1, %2" : "=v"(r) : "v"(lo), "v"(hi)); return r; }
template <class Epi, class Sched, bool ALIGN_EPI, bool SP2, class Gemm>
__device__ __forceinline__ void gemm_phase(PG8_LAS unsigned char* lds, const Gemm g, const Sched& S, const Epi& E) {
    const int tid = threadIdx.x, wid = __builtin_amdgcn_readfirstlane(tid >> 6), lane = tid & 63, wr = wid >> 2, wc = wid & 3, fr = lane & 15, fq = lane >> 4;
    const int K = g.K, nt = K / BK;
    unsigned voffA[2], voffB[2];
#pragma unroll
    for (int i = 0; i < 2; ++i) { int R, C; stage_rc(tid * 16 + i * 8192, R, C); const int Rb = Epi::PERM ? ((R & ~31) + perm32(R & 31)) : R;
        voffA[i] = (unsigned)(R * g.lda + C) * 2u; voffB[i] = (unsigned)(Rb * g.ldb + C) * 2u; }
    const size_t kstep = (size_t)(BK * 2);
    const size_t hA = (size_t)HALF * g.lda * 2, hB = (size_t)HALF * g.ldb * 2;
    const unsigned ldsw = (unsigned)wid * 1024u;
    const int aoff = lds_byte(wr * 64 + fr, fq * 8), boff = lds_byte(wc * 32 + fr, fq * 8);
#define PG8_SA(b, h) (((b) * 2 + (h)) * HTB)
#define PG8_SB(b, h) ((4 + (b) * 2 + (h)) * HTB)
#define PG8_STAGE(bufoff, gbase, voff) do { _Pragma("unroll") for (int _i = 0; _i < 2; ++_i) \
        __builtin_amdgcn_global_load_lds((const unsigned*)((const char*)(gbase) + (voff)[_i]), (PG8_LAS unsigned*)(lds + (bufoff) + ldsw + _i * 8192), 16, 0, 0); } while (0)
#define PG8_LDA(dst, b, h) do { _Pragma("unroll") for (int m = 0; m < 4; ++m) _Pragma("unroll") for (int k = 0; k < 2; ++k) dst[m][k] = *(const PG8_LAS bf16x8*)(lds + PG8_SA(b, h) + aoff + m * 2048 + k * 1024); } while (0)
#define PG8_LDB(dst, b, h) do { _Pragma("unroll") for (int n = 0; n < 2; ++n) _Pragma("unroll") for (int k = 0; k < 2; ++k) dst[n][k] = *(const PG8_LAS bf16x8*)(lds + PG8_SB(b, h) + boff + n * 2048 + k * 1024); } while (0)
#define PG8_MMA(ai, bj, At, Bt) do { __builtin_amdgcn_s_setprio(1); _Pragma("unroll") for (int m = 0; m < 4; ++m) _Pragma("unroll") for (int n = 0; n < 2; ++n) _Pragma("unroll") for (int k = 0; k < 2; ++k) \
        acc[ai][bj][m][n] = __builtin_amdgcn_mfma_f32_16x16x32_bf16(Bt[n][k], At[m][k], acc[ai][bj][m][n], 0, 0, 0); __builtin_amdgcn_s_setprio(0); } while (0)
#define PG8_WAIT_V(n) asm volatile("s_waitcnt vmcnt(" #n ")" ::: "memory")
#define PG8_WAIT_L(n) asm volatile("s_waitcnt lgkmcnt(" #n ")" ::: "memory")
#define PG8_BAR __builtin_amdgcn_s_barrier()
#define PG8_SCHED __builtin_amdgcn_sched_barrier(0)
    Unit cur, nxt; int ui = 0;
    if (!S.next(0, cur)) return;
    f32x4 acc[2][2][4][2];
#pragma unroll
    for (int a = 0; a < 2; ++a)
#pragma unroll
        for (int b = 0; b < 2; ++b)
#pragma unroll
            for (int m = 0; m < 4; ++m)
#pragma unroll
                for (int n = 0; n < 2; ++n) acc[a][b][m][n] = (f32x4){0.f, 0.f, 0.f, 0.f};
    bf16x8 At[4][2], B0[2][2], B1[2][2];
    const char* cA = g.a_ptr(cur); const char* cB = g.b_ptr(cur);
    S.a_ready(cur);
    if constexpr (SP2) {
        PG8_STAGE(PG8_SB(0, 0), cB, voffB); PG8_STAGE(PG8_SB(0, 1), cB + hB, voffB); PG8_STAGE(PG8_SA(0, 0), cA, voffA); PG8_STAGE(PG8_SA(0, 1), cA + hA, voffA);
        if (wr == 1) PG8_BAR;
        PG8_WAIT_V(2); PG8_BAR;
        PG8_STAGE(PG8_SB(1, 0), cB + kstep, voffB); PG8_STAGE(PG8_SA(1, 0), cA + kstep, voffA); PG8_STAGE(PG8_SB(1, 1), cB + hB + kstep, voffB);
        PG8_WAIT_V(6); PG8_BAR;
    } else {
        PG8_STAGE(PG8_SB(0, 0), cB, voffB); PG8_STAGE(PG8_SA(0, 0), cA, voffA); PG8_STAGE(PG8_SB(0, 1), cB + hB, voffB); PG8_STAGE(PG8_SA(0, 1), cA + hA, voffA);
        if (wr == 1) PG8_BAR;
        PG8_WAIT_V(4); PG8_BAR;
        PG8_STAGE(PG8_SB(1, 0), cB + kstep, voffB); PG8_STAGE(PG8_SA(1, 0), cA + kstep, voffA); PG8_STAGE(PG8_SB(1, 1), cB + hB + kstep, voffB);
        PG8_WAIT_V(6); PG8_BAR;
    }
    for (;;) {
        const bool has_next = S.next(ui + 1, nxt);
        const char* nA = has_next ? g.a_ptr(nxt) : cA; const char* nB = has_next ? g.b_ptr(nxt) : cB;
        for (int t = 0; t < nt; t += 2) {
            const bool last = (t == nt - 2);
            const char* a1 = cA + (size_t)(t + 1) * kstep;
            const char* a2 = last ? nA : cA + (size_t)(t + 2) * kstep; const char* b2 = last ? nB : cB + (size_t)(t + 2) * kstep;
            const char* a3 = a2 + kstep; const char* b3 = b2 + kstep;
            if (last && has_next) S.a_ready(nxt);
            if constexpr (SP2) {
            PG8_LDB(B0, 0, 0); PG8_LDB(B1, 0, 1); PG8_SCHED; PG8_LDA(At, 0, 0); PG8_STAGE(PG8_SA(1, 1), a1 + hA, voffA);
            PG8_WAIT_V(8); PG8_WAIT_L(0); PG8_BAR; PG8_MMA(0, 0, At, B0); PG8_MMA(0, 1, At, B1); PG8_BAR; PG8_SCHED;
            PG8_LDA(At, 0, 1); PG8_STAGE(PG8_SB(0, 0), b2, voffB); PG8_STAGE(PG8_SB(0, 1), b2 + hB, voffB); PG8_STAGE(PG8_SA(0, 0), a2, voffA);
            PG8_WAIT_V(8); PG8_WAIT_L(0); PG8_BAR; PG8_MMA(1, 0, At, B0); PG8_MMA(1, 1, At, B1); PG8_BAR; PG8_SCHED;
            PG8_LDB(B0, 1, 0); PG8_LDB(B1, 1, 1); PG8_SCHED; PG8_LDA(At, 1, 0); PG8_STAGE(PG8_SA(0, 1), a2 + hA, voffA);
            PG8_WAIT_V(8); PG8_WAIT_L(0); PG8_BAR; PG8_MMA(0, 0, At, B0); PG8_MMA(0, 1, At, B1); PG8_BAR; PG8_SCHED;
            PG8_LDA(At, 1, 1); PG8_STAGE(PG8_SB(1, 0), b3, voffB); PG8_STAGE(PG8_SB(1, 1), b3 + hB, voffB); PG8_STAGE(PG8_SA(1, 0), a3, voffA);
            PG8_WAIT_V(8); PG8_WAIT_L(0); PG8_BAR; PG8_MMA(1, 0, At, B0); PG8_MMA(1, 1, At, B1); PG8_BAR; PG8_SCHED;
            } else {
            PG8_LDB(B0, 0, 0); PG8_SCHED; PG8_LDA(At, 0, 0); PG8_STAGE(PG8_SA(1, 1), a1 + hA, voffA);
            PG8_WAIT_L(8); PG8_BAR; PG8_WAIT_L(0); PG8_MMA(0, 0, At, B0); PG8_BAR; PG8_SCHED;
            PG8_LDB(B1, 0, 1); PG8_STAGE(PG8_SB(0, 0), b2, voffB);
            PG8_BAR; PG8_WAIT_L(0); PG8_MMA(0, 1, At, B1); PG8_BAR;
            PG8_LDA(At, 0, 1); PG8_STAGE(PG8_SA(0, 0), a2, voffA);
            PG8_BAR; PG8_WAIT_L(0); PG8_MMA(1, 0, At, B0); PG8_BAR; PG8_SCHED;
            PG8_STAGE(PG8_SB(0, 1), b2 + hB, voffB);
            PG8_WAIT_V(6); PG8_BAR; PG8_MMA(1, 1, At, B1); PG8_BAR;
            PG8_LDB(B0, 1, 0); PG8_SCHED; PG8_LDA(At, 1, 0); PG8_STAGE(PG8_SA(0, 1), a2 + hA, voffA);
            PG8_WAIT_L(8); PG8_BAR; PG8_WAIT_L(0); PG8_MMA(0, 0, At, B0); PG8_BAR; PG8_SCHED;
            PG8_LDB(B1, 1, 1); PG8_STAGE(PG8_SB(1, 0), b3, voffB);
            PG8_BAR; PG8_WAIT_L(0); PG8_MMA(0, 1, At, B1); PG8_BAR;
            PG8_LDA(At, 1, 1); PG8_STAGE(PG8_SA(1, 0), a3, voffA);
            PG8_BAR; PG8_WAIT_L(0); PG8_MMA(1, 0, At, B0); PG8_BAR; PG8_SCHED;
            PG8_STAGE(PG8_SB(1, 1), b3 + hB, voffB);
            PG8_WAIT_V(6); PG8_BAR; PG8_MMA(1, 1, At, B1); PG8_BAR;
            }
        }
        if constexpr (ALIGN_EPI) { if (wr == 0) PG8_BAR; }
        if constexpr (!Epi::AFTER_DRAIN) { E(acc, cur, wr, wc, fr, fq); S.done(cur); }
        if (!has_next) break;
#pragma unroll
        for (int a = 0; a < 2; ++a)
#pragma unroll
            for (int b = 0; b < 2; ++b)
#pragma unroll
                for (int m = 0; m < 4; ++m)
#pragma unroll
                    for (int n = 0; n < 2; ++n) acc[a][b][m][n] = (f32x4){0.f, 0.f, 0.f, 0.f};
        cur = nxt; cA = nA; cB = nB; ++ui;
        if constexpr (ALIGN_EPI) { if (wr == 1) PG8_BAR; }
    }
    PG8_WAIT_V(0);
    if constexpr (!ALIGN_EPI) { if (wr == 0) PG8_BAR; }
    PG8_BAR;
    if constexpr (Epi::AFTER_DRAIN) { E.fused(acc, cur, wr, wc, fr, fq, lds, wid, lane); S.done(cur); }
#undef PG8_SA
#undef PG8_SB
#undef PG8_STAGE
#undef PG8_LDA
#undef PG8_LDB
#undef PG8_MMA
#undef PG8_WAIT_V
#undef PG8_WAIT_L
#undef PG8_BAR
#undef PG8_SCHED
}
}

struct Args { const float* in[24]; float* out; unsigned char* ws; int ph_lo, ph_hi; };
#define IN_(k) (A_.in[k])
#define X_PROMPT IN_(0)
#define X_SAMPLE IN_(1)
#define CACHE_K IN_(2)
#define CACHE_V IN_(3)
#define STATE_HGRN IN_(4)
#define CACHE_MK IN_(5)
#define CACHE_MV IN_(6)
#define MEM_PROMPT IN_(7)
#define W_IN IN_(8)
#define LQ1 IN_(9)
#define LK1 IN_(10)
#define LQ2 IN_(11)
#define LK2 IN_(12)
#define SUB_NORM IN_(13)
#define LB_LOGITS IN_(14)
#define HGRN_NORM IN_(15)
#define W_MEM_K IN_(16)
#define W_MEM_V IN_(17)
#define W_A IN_(18)
#define W_B IN_(19)
#define W_C IN_(20)
#define W_OUT IN_(21)
#define LN_G IN_(22)
#define LN_B IN_(23)
#define OUT_ (A_.out)
#define WS_(off) (A_.ws + (off))
#define XB_ ((bf16*)WS_(WS_XB))
#define WT_ ((bf16*)WS_(WS_WT))
#define WABC_ ((bf16*)WS_(WS_WABC))
#define WO_ ((bf16*)WS_(WS_WO))
#define MKV_ ((bf16*)WS_(WS_MKV))
#define P_ ((bf16*)WS_(WS_P))
#define MG_ ((bf16*)WS_(WS_MG))
#define G_ ((float*)WS_(WS_G))
#define OB_ ((float*)WS_(WS_OB))
#define ROPE_ ((v2f*)WS_(WS_ROPE))
typedef const Args& Ctx;

struct InProjOrder {
    int G, c;
    DI bool next(int i, pg8::Unit& u) const {
        const int L = i * G + c; u.br = 0;
        if (L < 130 * 68) { pg8::tile_of(L, 130, 68, u.pm, u.pn); return true; }
        const int l = L - 130 * 68; if (l >= 64) return false;
        u.pm = 130 + (l & 7); u.pn = 68 + (l >> 3); return true;
    }
    DI void a_ready(const pg8::Unit&) const {}
    DI void done(const pg8::Unit&) const {}
};
struct MergeOrder {
    int G, c;
    DI bool next(int i, pg8::Unit& u) const {
        const int T = (i / 3) * G + c; if (T >= 130 * 8) return false;
        pg8::tile_of(T, 130, 8, u.pm, u.pn); u.br = i % 3; return true;
    }
    DI void a_ready(const pg8::Unit&) const {}
    DI void done(const pg8::Unit&) const {}
};
struct OutOrder {
    int G, c;
    DI bool next(int i, pg8::Unit& u) const {
        const int L = i * G + c; if (L >= 130 * 8) return false;
        pg8::tile_of(L, 130, 8, u.pm, u.pn); u.br = 0; return true;
    }
    DI void a_ready(const pg8::Unit&) const {}
    DI void done(const pg8::Unit&) const {}
};

DI void st8bf(bf16* p, const float (&v)[8]) {
    v4u w; w.x = pg8::cvt_pk_bf16(v[0], v[1]); w.y = pg8::cvt_pk_bf16(v[2], v[3]); w.z = pg8::cvt_pk_bf16(v[4], v[5]); w.w = pg8::cvt_pk_bf16(v[6], v[7]);
    *(v4u*)p = w;
}
DI void st8f(float* p, const float (&v)[8]) { *(v4f*)p = (v4f){v[0], v[1], v[2], v[3]}; *(v4f*)(p + 4) = (v4f){v[4], v[5], v[6], v[7]}; }
DI void ld8bf(const bf16* p, float (&f)[8]) {
    const v4u w = *(const v4u*)p;
    f[0] = bflo(w.x); f[1] = bfhi(w.x); f[2] = bflo(w.y); f[3] = bfhi(w.y); f[4] = bflo(w.z); f[5] = bfhi(w.z); f[6] = bflo(w.w); f[7] = bfhi(w.w);
}

struct EpiIn {
    static constexpr bool PERM = true, AFTER_DRAIN = false;
    bf16* P; float* G; float* out; bf16* MKV; const float* lbl; const v2f* rope;
    template <int MODE>
    DI void rows(const pg8::f32x4 (&acc)[2][2][4][2], const pg8::Unit& u, int wr, int wc, int fr, int fq) const {
        const int pn = u.pn, tc0 = wc * 32 + fq * 8;
        float lbv[2][8];
        if constexpr (MODE == 4) {
#pragma unroll
            for (int bj = 0; bj < 2; ++bj) { const int cf = (pn - 20) * 256 + bj * 128 + tc0;
#pragma unroll
                for (int i = 0; i < 8; ++i) lbv[bj][i] = sigm(lbl[cf + i] - lbl[1024 + cf + i]); }
        }
#pragma unroll
        for (int ai = 0; ai < 2; ++ai)
#pragma unroll
            for (int m = 0; m < 4; ++m) {
                const int row = u.pm * 256 + ai * 128 + wr * 64 + m * 16 + fr;
                v2f cs[8];
                if constexpr (MODE <= 1) {
                    const int pos = row < MP ? (row & (SEQ - 1)) : PAST + ((row - MP) & (DS - 1));
                    const v4f* rp = (const v4f*)(rope + (size_t)pos * 8);
#pragma unroll
                    for (int i = 0; i < 4; ++i) { const v4f t = rp[i]; cs[2 * i] = (v2f){t.x, t.y}; cs[2 * i + 1] = (v2f){t.z, t.w}; }
                }
#pragma unroll
                for (int bj = 0; bj < 2; ++bj) {
                    float v[8];
#pragma unroll
                    for (int i = 0; i < 4; ++i) { v[i] = acc[ai][bj][m][0][i]; v[4 + i] = acc[ai][bj][m][1][i]; }
                    const int col = pn * 256 + bj * 128 + tc0;
                    if constexpr (MODE <= 1) {
                        if ((wc & 1) == 0) {
                            const float sgn = fq == 0 ? -1.f : 1.f;
#pragma unroll
                            for (int i = 0; i < 8; ++i) { const float pr = __shfl_xor(v[i], 16); const float r = v[i] * cs[i].x + sgn * pr * cs[i].y; v[i] = fq < 2 ? r : v[i]; }
                        }
                        if constexpr (MODE == 0) {
#pragma unroll
                            for (int i = 0; i < 8; ++i) v[i] *= QA_SCALE;
                        }
                    }
                    if constexpr (MODE == 1 || MODE == 2) {
                        const int cs1 = (pn & 3) * 256 + bj * 128 + tc0;
                        float* dst = row < MP ? out + (MODE == 1 ? O_KP : O_VP) + (size_t)row * 1024 + cs1 : out + (MODE == 1 ? O_KS : O_VS) + (size_t)(row - MP) * 1024 + cs1;
                        st8f(dst, v);
                    }
                    if constexpr (MODE == 3) {
#pragma unroll
                        for (int i = 0; i < 8; ++i) v[i] = silu(v[i]);
                    }
                    if constexpr (MODE == 6) {
#pragma unroll
                        for (int i = 0; i < 8; ++i) v[i] = sigm(v[i]);
                    }
                    if constexpr (MODE == 7) {
#pragma unroll
                        for (int i = 0; i < 8; ++i) v[i] *= QC_SCALE;
                    }
                    if constexpr (MODE == 4) {
                        const int cf = (pn - 20) * 256 + bj * 128 + tc0;
#pragma unroll
                        for (int i = 0; i < 8; ++i) { const float lb = lbv[bj][i]; const float f = lb + (1.f - lb) * sigm(v[i]); v[i] = __builtin_amdgcn_logf(f) * LN2; }
                        st8f(G + (size_t)row * 1024 + cf, v);
                    } else if constexpr (MODE == 8) {
                        const int r = row - M, cm = (pn - 68) * 256 + bj * 128 + tc0;
                        float* dst = cm < 1024 ? out + O_MK + (size_t)r * 1024 + cm : out + O_MV + (size_t)r * 1024 + (cm - 1024);
                        st8f(dst, v);
                        st8bf(MKV + (size_t)r * 2048 + cm, v);
                    } else {
                        st8bf(P + (size_t)row * NIN + col, v);
                    }
                }
            }
    }
    DI void operator()(const pg8::f32x4 (&acc)[2][2][4][2], const pg8::Unit& u, int wr, int wc, int fr, int fq) const {
        const int pn = u.pn;
        int mode;
        if (pn >= 68) mode = 8;
        else if (pn >= 44) mode = 6;
        else { const int seg = pn >> 2; mode = seg == 0 ? 0 : seg == 1 ? 1 : seg == 2 ? 2 : seg == 5 ? 4 : seg == 6 ? 5 : seg == 7 ? 6 : seg == 9 ? 7 : 3; }
        switch (mode) {
            case 0: rows<0>(acc, u, wr, wc, fr, fq); break;
            case 1: rows<1>(acc, u, wr, wc, fr, fq); break;
            case 2: rows<2>(acc, u, wr, wc, fr, fq); break;
            case 3: rows<3>(acc, u, wr, wc, fr, fq); break;
            case 4: rows<4>(acc, u, wr, wc, fr, fq); break;
            case 5: rows<5>(acc, u, wr, wc, fr, fq); break;
            case 6: rows<6>(acc, u, wr, wc, fr, fq); break;
            case 7: rows<7>(acc, u, wr, wc, fr, fq); break;
            default: rows<8>(acc, u, wr, wc, fr, fq); break;
        }
    }
};

struct EpiMerge {
    static constexpr bool PERM = true, AFTER_DRAIN = false;
    const bf16* P; bf16* MG;
    DI void operator()(const pg8::f32x4 (&acc)[2][2][4][2], const pg8::Unit& u, int wr, int wc, int fr, int fq) const {
        const int tc0 = wc * 32 + fq * 8, gbase = u.br == 0 ? C_GA : (u.br == 1 ? C_GB : C_GC);
#pragma unroll
        for (int ai = 0; ai < 2; ++ai)
#pragma unroll
            for (int m = 0; m < 4; ++m) {
                const int row = u.pm * 256 + ai * 128 + wr * 64 + m * 16 + fr;
#pragma unroll
                for (int bj = 0; bj < 2; ++bj) {
                    const int col = u.pn * 256 + bj * 128 + tc0;
                    float g[8], v[8];
                    ld8bf(P + (size_t)row * NIN + gbase + col, g);
#pragma unroll
                    for (int i = 0; i < 4; ++i) { v[i] = acc[ai][bj][m][0][i] * g[i]; v[4 + i] = acc[ai][bj][m][1][i] * g[4 + i]; }
                    bf16* mp = MG + (size_t)row * D + col;
                    if (u.br != 0) { float o[8]; ld8bf(mp, o);
#pragma unroll
                        for (int i = 0; i < 8; ++i) v[i] += o[i]; }
                    st8bf(mp, v);
                }
            }
    }
};

struct EpiOut {
    static constexpr bool PERM = false, AFTER_DRAIN = false;
    const float* xp; const float* xs; float* out;
    DI void operator()(const pg8::f32x4 (&acc)[2][2][4][2], const pg8::Unit& u, int wr, int wc, int fr, int fq) const {
#pragma unroll
        for (int ai = 0; ai < 2; ++ai)
#pragma unroll
            for (int m = 0; m < 4; ++m) {
                const int row = u.pm * 256 + ai * 128 + wr * 64 + m * 16 + fr;
                const float* xr = row < MP ? xp + (size_t)row * D : xs + (size_t)(row - MP) * D;
#pragma unroll
                for (int bj = 0; bj < 2; ++bj)
#pragma unroll
                    for (int n = 0; n < 2; ++n) {
                        const int col = u.pn * 256 + bj * 128 + wc * 32 + n * 16 + fq * 4;
                        const v4f x4 = *(const v4f*)(xr + col);
                        const pg8::f32x4 a4 = acc[ai][bj][m][n];
                        *(v4f*)(out + (size_t)row * D + col) = (v4f){DN_ALPHA * x4.x + a4[0], DN_ALPHA * x4.y + a4[1], DN_ALPHA * x4.z + a4[2], DN_ALPHA * x4.w + a4[3]};
                    }
            }
    }
};

DI void p0_transpose_item(const float* W, int K, int N, bf16* WT, int row_off, LAS float* scr, int item, int lane) {
    const int nblk = N / 32, kb = item / nblk, nb = item % nblk, k0 = 64 * kb, n0 = 32 * nb;
#pragma unroll 8
    for (int i = 0; i < 32; ++i) { const int kk = 2 * i + (lane >> 5); scr[kk * 33 + (lane & 31)] = W[(size_t)(k0 + kk) * N + n0 + (lane & 31)]; }
    asm volatile("s_waitcnt lgkmcnt(0)" ::: "memory");
    const int c = lane & 7;
#pragma unroll
    for (int j = 0; j < 4; ++j) { const int n = (lane >> 3) + 8 * j; const LAS float* s = scr + (8 * c) * 33 + n;
        v4u o; o.x = pk2(s[0 * 33], s[1 * 33]); o.y = pk2(s[2 * 33], s[3 * 33]); o.z = pk2(s[4 * 33], s[5 * 33]); o.w = pk2(s[6 * 33], s[7 * 33]);
        *(v4u*)(WT + (size_t)(row_off + n0 + n) * K + k0 + 8 * c) = o; }
    asm volatile("s_waitcnt lgkmcnt(0)" ::: "memory");
}
DI void p0_row_to_bf16(const float* xrow, bf16* orow, int lane) {
    const v4f* xr = (const v4f*)xrow + lane;
    v2u* o8 = (v2u*)orow + lane;
#pragma unroll
    for (int j = 0; j < 8; ++j) { const v4f v = xr[64 * j]; o8[64 * j] = (v2u){pk2(v.x, v.y), pk2(v.z, v.w)}; }
}
DI void p0_rope_entry(v2f* rope, int idx) {
    const int pos = idx >> 3, i = idx & 7;
    const float invf = i == 0 ? 1.0f : i == 1 ? 0.1939227432012558f : i == 2 ? 0.03760603070259094f : i == 3 ? 0.007292664609849453f : i == 4 ? 0.0014142135623842478f
                     : i == 5 ? 0.00027424818836152554f : i == 6 ? 5.318296098266728e-05f : 1.0313386155758053e-05f;
    const float ang = (float)pos * invf;
    const double x = (double)ang, twopi = 6.283185307179586476925286766559;
    const double k = __builtin_rint(x / twopi), r = x - k * twopi, r2 = r * r;
    double c = 1.0, s = 1.0;
#pragma unroll
    for (int n = 17; n >= 1; --n) { c = 1.0 - c * r2 / (double)((2 * n - 1) * (2 * n)); s = 1.0 - s * r2 / (double)((2 * n) * (2 * n + 1)); }
    rope[idx] = (v2f){(float)c, (float)(s * r)};
}

DI float dot_bf16(const unsigned (&qp)[32], const bf16* krow) {
    const v4u* kp = (const v4u*)krow; float s0 = 0.f, s1 = 0.f;
#pragma unroll
    for (int i = 0; i < 8; ++i) { const v4u w = kp[i];
        s0 += bflo(qp[4 * i]) * bflo(w.x) + bflo(qp[4 * i + 1]) * bflo(w.y) + bflo(qp[4 * i + 2]) * bflo(w.z) + bflo(qp[4 * i + 3]) * bflo(w.w);
        s1 += bfhi(qp[4 * i]) * bfhi(w.x) + bfhi(qp[4 * i + 1]) * bfhi(w.y) + bfhi(qp[4 * i + 2]) * bfhi(w.z) + bfhi(qp[4 * i + 3]) * bfhi(w.w); }
    return s0 + s1;
}
DI float dot_f32(const unsigned (&qp)[32], const float* krow) {
    const v4f* kp = (const v4f*)krow; float s0 = 0.f, s1 = 0.f;
#pragma unroll
    for (int i = 0; i < 16; ++i) { const v4f w = kp[i];
        s0 += bflo(qp[2 * i]) * w.x + bflo(qp[2 * i + 1]) * w.z;
        s1 += bfhi(qp[2 * i]) * w.y + bfhi(qp[2 * i + 1]) * w.w; }
    return s0 + s1;
}
DI void axpy_bf16(float (&O)[64], float p, const bf16* vrow) {
    const v4u* vp = (const v4u*)vrow;
#pragma unroll
    for (int i = 0; i < 8; ++i) { const v4u w = vp[i];
        O[8 * i + 0] += p * bflo(w.x); O[8 * i + 1] += p * bfhi(w.x); O[8 * i + 2] += p * bflo(w.y); O[8 * i + 3] += p * bfhi(w.y);
        O[8 * i + 4] += p * bflo(w.z); O[8 * i + 5] += p * bfhi(w.z); O[8 * i + 6] += p * bflo(w.w); O[8 * i + 7] += p * bfhi(w.w); }
}
DI void axpy_f32(float (&O)[64], float p, const float* vrow) {
    const v4f* vp = (const v4f*)vrow;
#pragma unroll
    for (int i = 0; i < 16; ++i) { const v4f w = vp[i]; O[4 * i] += p * w.x; O[4 * i + 1] += p * w.y; O[4 * i + 2] += p * w.z; O[4 * i + 3] += p * w.w; }
}

template <bool SAMPLE>
DI void naive_attn_item(Ctx A_, int m, int h, float lam, int lane) {
    bf16* P = P_;
    int nk, b = 0, mb = 0;
    if (SAMPLE) { b = (m - MP) >> 4; nk = PAST; } else { const int pos = m & (SEQ - 1); nk = ((pos >> 6) + 1) << 6; mb = m - pos; }
    float r0 = 0.f, r1 = 0.f;
    for (int mp = 0; mp < 2; ++mp) {
        unsigned qp[32];
        { const v4u* qs = (const v4u*)(P + (size_t)m * NIN + C_QA + h * 128 + mp * 64);
#pragma unroll
          for (int i = 0; i < 8; ++i) { const v4u w = qs[i]; qp[4 * i] = w.x; qp[4 * i + 1] = w.y; qp[4 * i + 2] = w.z; qp[4 * i + 3] = w.w; } }
        const bf16* kb16 = P + (size_t)mb * NIN + C_KA + h * 128 + mp * 64;
        const float* kf = CACHE_K + ((size_t)b * PAST * 8 + h) * 128 + mp * 64;
        const bf16* kn16 = P + (size_t)(MP + b * DS) * NIN + C_KA + h * 128 + mp * 64;
        float mx = -INFINITY;
        for (int j = lane; j < nk; j += 64) { const float s = SAMPLE ? dot_f32(qp, kf + (size_t)j * 1024) : dot_bf16(qp, kb16 + (size_t)j * NIN); mx = fmaxf(mx, s); }
        if (SAMPLE) { if (lane < DS) { const float s = dot_bf16(qp, kn16 + (size_t)lane * NIN); mx = fmaxf(mx, s); } }
        mx = wave_max(mx);
        for (int hv = 0; hv < 2; ++hv) {
            const bf16* vb16 = P + (size_t)mb * NIN + C_VA + h * 128 + hv * 64;
            const float* vf = CACHE_V + ((size_t)b * PAST * 8 + h) * 128 + hv * 64;
            const bf16* vn16 = P + (size_t)(MP + b * DS) * NIN + C_VA + h * 128 + hv * 64;
            float l = 0.f; float O[64];
#pragma unroll
            for (int e = 0; e < 64; ++e) O[e] = 0.f;
            for (int j = lane; j < nk; j += 64) {
                const float s = SAMPLE ? dot_f32(qp, kf + (size_t)j * 1024) : dot_bf16(qp, kb16 + (size_t)j * NIN);
                const float p = fexp2(s - mx); l += p;
                if (SAMPLE) axpy_f32(O, p, vf + (size_t)j * 1024); else axpy_bf16(O, p, vb16 + (size_t)j * NIN);
            }
            if (SAMPLE) { if (lane < DS) { const float s = dot_bf16(qp, kn16 + (size_t)lane * NIN); const float p = fexp2(s - mx); l += p; axpy_bf16(O, p, vn16 + (size_t)lane * NIN); } }
            l = wave_sum(l);
            float x = 0.f;
#pragma unroll
            for (int e = 0; e < 64; ++e) { const float a = wave_sum(O[e]); x = lane == e ? a : x; }
            x *= 1.0f / l;
            if (mp == 1) x *= -lam;
            if (hv == 0) r0 += x; else r1 += x;
        }
    }
    const float ss = wave_sum(r0 * r0 + r1 * r1);
    const float inv = 1.0f / sqrtf(ss * (1.0f / 128.0f) + NORM_EPS);
    const float sn0 = SUB_NORM[lane], sn1 = SUB_NORM[64 + lane];
    bf16* zp = P + (size_t)m * NIN + C_ZA + h * 128 + lane;
    const float z0 = bf2f(zp[0]), z1 = bf2f(zp[64]);
    zp[0] = (bf16)f2bf(r0 * inv * sn0 * ONE_M_LAMINIT * z0);
    zp[64] = (bf16)f2bf(r1 * inv * sn1 * ONE_M_LAMINIT * z1);
}

DI void naive_cross_item(Ctx A_, int m, int hc, int lane) {
    bf16* P = P_;
    const bool samp = m >= MP; const int b = samp ? (m - MP) >> 4 : m >> 12;
    const v2u qw = *(const v2u*)(P + (size_t)m * NIN + C_QC + hc * 256 + 4 * lane);
    const float q0 = bflo(qw.x), q1 = bfhi(qw.x), q2 = bflo(qw.y), q3 = bfhi(qw.y);
    const bf16* kb = MKV_ + (size_t)b * NMEM * 2048 + hc * 256 + 4 * lane;
    const float* kf = CACHE_MK + ((size_t)b * NMEM * 4 + hc) * 256 + 4 * lane;
    const float* vf = CACHE_MV + ((size_t)b * NMEM * 4 + hc) * 256 + 4 * lane;
    float sc[4];
#pragma unroll
    for (int jj = 0; jj < 4; ++jj) { sc[jj] = 0.f;
        for (int l = 0; l < 64; ++l) { const int j = jj * 64 + l; float part;
            if (samp) { const v4f k = *(const v4f*)(kf + (size_t)j * 1024); part = q0 * k.x + q1 * k.y + q2 * k.z + q3 * k.w; }
            else { const v2u k = *(const v2u*)(kb + (size_t)j * 2048); part = q0 * bflo(k.x) + q1 * bfhi(k.x) + q2 * bflo(k.y) + q3 * bfhi(k.y); }
            part = wave_sum(part); sc[jj] = lane == l ? part : sc[jj]; } }
    const float mx = wave_max(fmaxf(fmaxf(sc[0], sc[1]), fmaxf(sc[2], sc[3])));
    float p[4], ls = 0.f;
#pragma unroll
    for (int jj = 0; jj < 4; ++jj) { p[jj] = fexp2(sc[jj] - mx); ls += p[jj]; }
    ls = wave_sum(ls);
    float o0 = 0.f, o1 = 0.f, o2 = 0.f, o3 = 0.f;
#pragma unroll
    for (int jj = 0; jj < 4; ++jj)
        for (int l = 0; l < 64; ++l) { const int j = jj * 64 + l; const float pj = __shfl(p[jj], l);
            if (samp) { const v4f v = *(const v4f*)(vf + (size_t)j * 1024); o0 += pj * v.x; o1 += pj * v.y; o2 += pj * v.z; o3 += pj * v.w; }
            else { const v2u v = *(const v2u*)(kb + 1024 + (size_t)j * 2048); o0 += pj * bflo(v.x); o1 += pj * bfhi(v.x); o2 += pj * bflo(v.y); o3 += pj * bfhi(v.y); } }
    const float il = 1.0f / ls;
    v2u* zp = (v2u*)(P + (size_t)m * NIN + C_ZC + hc * 256 + 4 * lane);
    const v2u z = *zp;
    *zp = (v2u){pk2(o0 * il * bflo(z.x), o1 * il * bfhi(z.x)), pk2(o2 * il * bflo(z.y), o3 * il * bfhi(z.y))};
}

DI void naive_hgrn_item(Ctx A_, LAS float* hs, int row0, int T, int h, int half, const float* s0, float* sout, int lane) {
    const bf16* P = P_; const float* G = G_; float* OB = OB_;
    const int dv = half * 64 + lane;
    float S[128];
#pragma unroll
    for (int dk = 0; dk < 128; ++dk) S[dk] = s0 ? s0[(size_t)dk * 128 + dv] : 0.f;
    const bf16* qrow = P + (size_t)row0 * NIN + C_QB + h * 128 + lane;
    const bf16* vrow = P + (size_t)row0 * NIN + C_IB + h * 128 + dv;
    const float* grow = G + (size_t)row0 * 1024 + h * 128 + lane;
    unsigned short qa = qrow[0], qb = qrow[64], va = vrow[0]; float ga = grow[0], gb = grow[64];
    for (int t = 0; t < T; ++t) {
        const float v = bf2f(va), f0 = fexp2(ga * LOG2E), f1 = fexp2(gb * LOG2E);
        hs[lane] = f0; hs[64 + lane] = f1; hs[128 + lane] = 1.f - f0; hs[192 + lane] = 1.f - f1; hs[256 + lane] = bf2f(qa); hs[320 + lane] = bf2f(qb);
        if (t + 1 < T) { const size_t o = (size_t)(t + 1); qa = qrow[o * NIN]; qb = qrow[o * NIN + 64]; va = vrow[o * NIN]; ga = grow[o * 1024]; gb = grow[o * 1024 + 64]; }
        float o = 0.f;
#pragma unroll
        for (int d4 = 0; d4 < 32; ++d4) {
            const v4f f4 = *(const LAS v4f*)(hs + 4 * d4), k4 = *(const LAS v4f*)(hs + 128 + 4 * d4), q4 = *(const LAS v4f*)(hs + 256 + 4 * d4);
            S[4 * d4 + 0] = S[4 * d4 + 0] * f4.x + k4.x * v; o += S[4 * d4 + 0] * q4.x;
            S[4 * d4 + 1] = S[4 * d4 + 1] * f4.y + k4.y * v; o += S[4 * d4 + 1] * q4.y;
            S[4 * d4 + 2] = S[4 * d4 + 2] * f4.z + k4.z * v; o += S[4 * d4 + 2] * q4.z;
            S[4 * d4 + 3] = S[4 * d4 + 3] * f4.w + k4.w * v; o += S[4 * d4 + 3] * q4.w;
            if ((d4 & 3) == 3) asm volatile("" ::: "memory");
        }
        OB[(size_t)(row0 + t) * 1024 + h * 128 + dv] = o;
    }
#pragma unroll
    for (int dk = 0; dk < 128; ++dk) sout[(size_t)dk * 128 + dv] = S[dk];
}

DI void hgrn_post_item(Ctx A_, int m, int h, int lane) {
    bf16* P = P_;
    const v2f o = *(const v2f*)(OB_ + (size_t)m * 1024 + h * 128 + 2 * lane);
    const float ss = wave_sum(o.x * o.x + o.y * o.y);
    const float inv = 1.0f / sqrtf(ss * (1.0f / 128.0f) + NORM_EPS);
    const v2f gn = *(const v2f*)(HGRN_NORM + h * 128 + 2 * lane);
    const unsigned og = *(const unsigned*)(P + (size_t)m * NIN + C_OG + h * 128 + 2 * lane);
    unsigned* zp = (unsigned*)(P + (size_t)m * NIN + C_ZB + h * 128 + 2 * lane);
    const unsigned z = *zp;
    *zp = pk2(o.x * inv * gn.x * bflo(og) * bflo(z), o.y * inv * gn.y * bfhi(og) * bfhi(z));
}

DI void ln_row(Ctx A_, int m, int lane) {
    v4f* xr = (v4f*)(OUT_ + (size_t)m * D) + lane;
    v4f v[8]; float s = 0.f;
#pragma unroll
    for (int j = 0; j < 8; ++j) { v[j] = xr[64 * j]; s += (v[j].x + v[j].y) + (v[j].z + v[j].w); }
    const float mean = wave_sum(s) * (1.0f / D); float s2 = 0.f;
#pragma unroll
    for (int j = 0; j < 8; ++j) { v[j] = v[j] - mean; s2 += (v[j].x * v[j].x + v[j].y * v[j].y) + (v[j].z * v[j].z + v[j].w * v[j].w); }
    const float rstd = 1.0f / sqrtf(wave_sum(s2) * (1.0f / D) + NORM_EPS);
    const v4f* gp = (const v4f*)LN_G + lane; const v4f* bp = (const v4f*)LN_B + lane;
#pragma unroll
    for (int j = 0; j < 8; ++j) { const v4f g = gp[64 * j], bb = bp[64 * j]; xr[64 * j] = v[j] * rstd * g + bb; }
}

__global__ void __launch_bounds__(256) k_hgrn(Args args) {
    __shared__ __attribute__((aligned(16))) float hsm[4 * 512];
    const Args& A_ = args;
    const int lane = threadIdx.x & 63, wave = __builtin_amdgcn_readfirstlane(threadIdx.x >> 6), it = blockIdx.x * 4 + wave;
    LAS float* hs = (LAS float*)hsm + wave * 512;
    if (it < 128) { const int p = it, b = p >> 4, h = (p >> 1) & 7, half = p & 1;
        naive_hgrn_item(A_, hs, b * SEQ, SEQ, h, half, nullptr, OUT_ + O_HP + (size_t)(b * 8 + h) * 16384, lane); }
    else if (it < 128 + 512) { const int s = it - 128, b = s >> 4, h = (s >> 1) & 7, half = s & 1;
        naive_hgrn_item(A_, hs, MP + b * DS, DS, h, half, STATE_HGRN + (size_t)(b * 8 + h) * 16384, OUT_ + O_HS + (size_t)(b * 8 + h) * 16384, lane); }
}
DI float lam_of(Ctx A_, int lane) {
    const float d1 = wave_sum(LQ1[lane] * LK1[lane]), d2 = wave_sum(LQ2[lane] * LK2[lane]);
    return __expf(d1) - __expf(d2) + LAM_INIT;
}
__global__ void __launch_bounds__(256) k_attn_prompt(Args args) {
    const Args& A_ = args;
    const int lane = threadIdx.x & 63, wave = __builtin_amdgcn_readfirstlane(threadIdx.x >> 6), it = blockIdx.x * 4 + wave;
    const float lam = lam_of(A_, lane);
    if (it < MP * 8) naive_attn_item<false>(A_, it & (MP - 1), it >> 15, lam, lane);
}
__global__ void __launch_bounds__(256) k_attn_sample(Args args) {
    const Args& A_ = args;
    const int lane = threadIdx.x & 63, wave = __builtin_amdgcn_readfirstlane(threadIdx.x >> 6), it = blockIdx.x * 4 + wave;
    const float lam = lam_of(A_, lane);
    if (it < MS * 8) naive_attn_item<true>(A_, MP + (it & (MS - 1)), it >> 9, lam, lane);
}
__global__ void __launch_bounds__(256) k_cross(Args args) {
    const Args& A_ = args;
    const int lane = threadIdx.x & 63, wave = __builtin_amdgcn_readfirstlane(threadIdx.x >> 6), it = blockIdx.x * 4 + wave;
    if (it < M * 4) naive_cross_item(A_, it >> 2, it & 3, lane);
}
__global__ void __launch_bounds__(256) k_hgrn_post(Args args) {
    const Args& A_ = args;
    const int lane = threadIdx.x & 63, wave = __builtin_amdgcn_readfirstlane(threadIdx.x >> 6), it = blockIdx.x * 4 + wave;
    if (it < M * 8) hgrn_post_item(A_, it >> 3, it & 7, lane);
}

__global__ void __launch_bounds__(512, 2) fwd(Args args) {
    extern __shared__ __attribute__((aligned(16))) unsigned char lds_raw[];
    LAS unsigned char* lds = (LAS unsigned char*)lds_raw;
    const int tid = threadIdx.x, lane = tid & 63, wave = __builtin_amdgcn_readfirstlane(tid >> 6);
    const int G = gridDim.x, gw = blockIdx.x * 8 + wave, NGW = G * 8;
    const Args& A_ = args;
    const int lo = args.ph_lo, hi = args.ph_hi;
#define IN(k) (lo <= (k) && (k) < hi)
#define BOTH(k) (IN(k) && IN((k) + 1))

    for (int u = tid; u < (LDS_BYTES - LDSCTL_OFF) / 4; u += 512) ((LAS unsigned*)(lds + LDSCTL_OFF))[u] = 0u;
    __syncthreads();
    XcdBarrier bar; bar.bar = (unsigned*)WS_(WS_CTL) + CW_BAR; bar.x = 0; bar.st = nullptr;
    if (hi - lo > 1) bar = xcd_barrier_post((unsigned*)WS_(WS_CTL) + CW_BAR, (volatile LAS unsigned*)(lds + MISC_OFF) + 8);

    if (IN(0)) {
        LAS float* scr = (LAS float*)(lds + wave * 16384);
        constexpr int I_IN = 32 * 544, I_MK = 32 * 32, I_BR = 16 * 64, I_O = 32 * 64;
        constexpr int NIT = I_IN + 2 * I_MK + 3 * I_BR + I_O;
        for (int it = gw; it < NIT; it += NGW) {
            int r = it;
            if (r < I_IN) { p0_transpose_item(W_IN, D, NIN, WT_, 0, scr, r, lane); continue; } r -= I_IN;
            if (r < I_MK) { p0_transpose_item(W_MEM_K, D, 1024, WT_, NIN, scr, r, lane); continue; } r -= I_MK;
            if (r < I_MK) { p0_transpose_item(W_MEM_V, D, 1024, WT_, NIN + 1024, scr, r, lane); continue; } r -= I_MK;
            if (r < I_BR) { p0_transpose_item(W_A, 1024, D, WABC_, 0, scr, r, lane); continue; } r -= I_BR;
            if (r < I_BR) { p0_transpose_item(W_B, 1024, D, WABC_, 2048, scr, r, lane); continue; } r -= I_BR;
            if (r < I_BR) { p0_transpose_item(W_C, 1024, D, WABC_, 4096, scr, r, lane); continue; } r -= I_BR;
            p0_transpose_item(W_OUT, D, D, WO_, 0, scr, r, lane);
        }
        for (int m = gw; m < M + 2048; m += NGW) {
            const float* src = m < MP ? X_PROMPT + (size_t)m * D : (m < M ? X_SAMPLE + (size_t)(m - MP) * D : MEM_PROMPT + (size_t)(m - M) * D);
            p0_row_to_bf16(src, XB_ + (size_t)m * D, lane);
        }
        for (int i = blockIdx.x * 512 + tid; i < (PAST + DS) * 8; i += G * 512) p0_rope_entry(ROPE_, i);
        if (BOTH(0)) xcd_barrier(bar);
    }

    if (IN(1)) {
        pg8::GemmT<0, 0, 0> g{(const char*)XB_, (const char*)WT_, D, D, D, 0};
        InProjOrder S{G, (int)blockIdx.x};
        EpiIn E{P_, G_, OUT_, MKV_, LB_LOGITS, ROPE_};
        pg8::gemm_phase<EpiIn, InProjOrder, true, true>(lds, g, S, E);
        if (BOTH(1)) xcd_barrier(bar);
    }

    if (IN(2)) {
        if (BOTH(2)) xcd_barrier(bar);
    }

    if (IN(3)) {
        pg8::GemmT<C_ZA, C_ZB, C_ZC> g{(const char*)P_, (const char*)WABC_, NIN, 1024, 1024, (size_t)2048 * 1024 * 2};
        MergeOrder S{G, (int)blockIdx.x};
        EpiMerge E{P_, MG_};
        pg8::gemm_phase<EpiMerge, MergeOrder, true, true>(lds, g, S, E);
        if (BOTH(3)) xcd_barrier(bar);
    }

    if (IN(4)) {
        pg8::GemmT<0, 0, 0> g{(const char*)MG_, (const char*)WO_, D, D, D, 0};
        OutOrder S{G, (int)blockIdx.x};
        EpiOut E{X_PROMPT, X_SAMPLE, OUT_};
        pg8::gemm_phase<EpiOut, OutOrder, true, true>(lds, g, S, E);
        if (BOTH(4)) xcd_barrier(bar);
    }

    if (IN(5)) { for (int m = gw; m < M; m += NGW) ln_row(A_, m, lane); }
#undef IN
#undef BOTH
}

extern "C" void kernel_launch(void* const* d_in, const int* in_sizes, int n_in, void* d_out, int out_size, void* d_ws, size_t ws_size, hipStream_t stream) {
    static int grid = 0;
    if (grid == 0) {
        if (n_in != 24 || (size_t)out_size != O_END || ws_size < WS_END) { fprintf(stderr, "kernel_launch: unexpected shapes (n_in %d out %d ws %zu, need ws %zu); nothing launched\n", n_in, out_size, ws_size, (size_t)WS_END); grid = -1; return; }
        int dev = 0, cus = 0;
        if (hipGetDevice(&dev) != hipSuccess || hipDeviceGetAttribute(&cus, hipDeviceAttributeMultiprocessorCount, dev) != hipSuccess) { grid = -1; return; }
        if (hipFuncSetAttribute((const void*)fwd, hipFuncAttributeMaxDynamicSharedMemorySize, LDS_BYTES) != hipSuccess) { fprintf(stderr, "kernel_launch: hipFuncSetAttribute failed\n"); grid = -1; return; }
        grid = cus > 0 ? cus : 256;
    }
    if (grid < 0) return;
    if (hipMemsetAsync((char*)d_ws + WS_CTL, 0, CTL_ZERO_BYTES, stream) != hipSuccess) return;
    Args a{};
    for (int i = 0; i < 24; ++i) a.in[i] = (const float*)d_in[i];
    a.out = (float*)d_out; a.ws = (unsigned char*)d_ws;
    a.ph_lo = 0; a.ph_hi = 1; hipLaunchKernelGGL(fwd, dim3(grid), dim3(512), LDS_BYTES, stream, a);
    a.ph_lo = 1; a.ph_hi = 2; hipLaunchKernelGGL(fwd, dim3(grid), dim3(512), LDS_BYTES, stream, a);
    a.ph_lo = 0; a.ph_hi = 0;
    hipLaunchKernelGGL(k_hgrn, dim3((128 + 512) / 4), dim3(256), 0, stream, a);
    hipLaunchKernelGGL(k_attn_prompt, dim3(MP * 8 / 4), dim3(256), 0, stream, a);
    hipLaunchKernelGGL(k_attn_sample, dim3(MS * 8 / 4), dim3(256), 0, stream, a);
    hipLaunchKernelGGL(k_cross, dim3(M * 4 / 4), dim3(256), 0, stream, a);
    hipLaunchKernelGGL(k_hgrn_post, dim3(M * 8 / 4), dim3(256), 0, stream, a);
    a.ph_lo = 3; a.ph_hi = 4; hipLaunchKernelGGL(fwd, dim3(grid), dim3(512), LDS_BYTES, stream, a);
    a.ph_lo = 4; a.ph_hi = 5; hipLaunchKernelGGL(fwd, dim3(grid), dim3(512), LDS_BYTES, stream, a);
    a.ph_lo = 5; a.ph_hi = 6; hipLaunchKernelGGL(fwd, dim3(grid), dim3(512), LDS_BYTES, stream, a);
    const hipError_t le = hipPeekAtLastError();
    if (le != hipSuccess) fprintf(stderr, "kernel_launch: launch failed: %s\n", hipGetErrorName(le));
}
```

```cpp
#include <hip/hip_runtime.h>
#include <cstdio>
#include <cstdint>

#define GAS __attribute__((address_space(1)))
#define LAS __attribute__((address_space(3)))
typedef unsigned short bf16;
typedef unsigned v4u __attribute__((ext_vector_type(4)));
typedef unsigned v2u __attribute__((ext_vector_type(2)));
typedef float v4f __attribute__((ext_vector_type(4)));
typedef float v2f __attribute__((ext_vector_type(2)));
#define DI __device__ __forceinline__

constexpr int D = 2048, NB = 8, SEQ = 4096, MP = NB * SEQ, DB = 32, DS = 16, MS = DB * DS, M = MP + MS, PAST = 4096, NMEM = 256;
constexpr int NIN = 17408;
constexpr int C_QA = 0, C_KA = 1024, C_VA = 2048, C_ZA = 3072, C_QB = 4096, C_FB = 5120, C_IB = 6144, C_OG = 7168, C_ZB = 8192, C_QC = 9216, C_ZC = 10240, C_GA = 11264, C_GB = 13312, C_GC = 15360;
constexpr float LOG2E = 1.4426950408889634f, LN2 = 0.6931471805599453f;
constexpr float QA_SCALE = 0.125f * LOG2E, QC_SCALE = 0.0625f * LOG2E;
constexpr float DN_ALPHA = 1.189207115002721f, NORM_EPS = 1e-5f, ONE_M_LAMINIT = 0.8f, LAM_INIT = 0.2f;
constexpr size_t O_YP = 0, O_YS = (size_t)MP * D, O_KP = O_YS + (size_t)MS * D, O_VP = O_KP + (size_t)MP * 1024, O_HP = O_VP + (size_t)MP * 1024,
                 O_MK = O_HP + (size_t)NB * 8 * 128 * 128, O_MV = O_MK + (size_t)NB * NMEM * 1024, O_KS = O_MV + (size_t)NB * NMEM * 1024, O_VS = O_KS + (size_t)MS * 1024,
                 O_HS = O_VS + (size_t)MS * 1024, O_END = O_HS + (size_t)DB * 8 * 128 * 128;
static_assert(O_END == 145752064ull, "output size");
constexpr size_t MiB = 1u << 20;
constexpr size_t WS_CTL = 0, CTL_ZERO_BYTES = 1 * MiB, WS_ROPE = 1 * MiB, WS_XB = 2 * MiB, WS_WT = 140 * MiB, WS_WABC = 216 * MiB, WS_WO = 228 * MiB, WS_MKV = 374 * MiB,
                 WS_G = 244 * MiB, WS_OB = 374 * MiB, WS_P = 504 * MiB, WS_END = 1609 * MiB, WS_MG = WS_XB;
static_assert(WS_XB + (size_t)(M + 2048) * D * 2 <= WS_WT && WS_WT + (size_t)(NIN + 2048) * D * 2 <= WS_WABC && WS_G + (size_t)M * 1024 * 4 <= WS_OB && WS_OB + (size_t)M * 1024 * 4 <= WS_P && WS_P + (size_t)M * NIN * 2 <= WS_END, "ws map");
constexpr int CW_BAR = 4096;
constexpr int RING_BYTES = 131072, LDSCTL_OFF = RING_BYTES, MISC_OFF = LDSCTL_OFF + 320, LDS_BYTES = 147456;

DI float bf2f(unsigned short u) { return __uint_as_float((unsigned)u << 16); }
DI float bflo(unsigned u) { return __uint_as_float(u << 16); }
DI float bfhi(unsigned u) { return __uint_as_float(u & 0xffff0000u); }
DI unsigned f2bf(float f) { unsigned u = __float_as_uint(f); return (u + 0x7fffu + ((u >> 16) & 1u)) >> 16; }
DI unsigned pk2(float lo, float hi) { return f2bf(lo) | (f2bf(hi) << 16); }
DI float fexp2(float x) { return __builtin_amdgcn_exp2f(x); }
DI float frcp(float x) { return __builtin_amdgcn_rcpf(x); }
DI float sigm(float x) { return frcp(1.0f + fexp2(-x * LOG2E)); }
DI float silu(float x) { return x * sigm(x); }
DI float wave_sum(float v) {
#pragma unroll
    for (int o = 1; o < 64; o <<= 1) v += __shfl_xor(v, o);
    return v;
}
DI float wave_max(float v) {
#pragma unroll
    for (int o = 1; o < 64; o <<= 1) v = fmaxf(v, __shfl_xor(v, o));
    return v;
}

#define XB_TMO      128
#define XB_XCNT(j)  (256  + 64 * (j))
#define XB_XSUB(j)  (1280 + 64 * (j))
#define XB_XGEN(j)  (2304 + 64 * (j))
#define XB_TOP      3328
#define XB_TOPGEN   3392
#define XCD_BAR_WORDS 3456
#define XB_SPIN_CAP (1u << 18)
DI unsigned xb_ld(unsigned* p)              { return __hip_atomic_load(p, __ATOMIC_RELAXED, __HIP_MEMORY_SCOPE_AGENT); }
DI unsigned xb_add(unsigned* p, unsigned v) { return __hip_atomic_fetch_add(p, v, __ATOMIC_RELAXED, __HIP_MEMORY_SCOPE_AGENT); }
DI unsigned xb_xcc_id() { return (unsigned)__builtin_amdgcn_s_getreg((3 << 11) | 20) & 0xFu; }
#define XB_SPIN(cond, bar) do { unsigned _sp = 0; while (cond) { __builtin_amdgcn_s_sleep(1); \
    if ((++_sp & 255u) == 0u) { if (xb_ld(&(bar)[XB_TMO])) break; if (_sp > XB_SPIN_CAP) { atomicAdd(&(bar)[XB_TMO], 1u); break; } } } } while (0)
struct XcdBarrier { unsigned* bar; unsigned x; volatile LAS unsigned* st; };
DI XcdBarrier xcd_barrier_post(unsigned* bar, volatile LAS unsigned* st) {
    XcdBarrier b; b.bar = bar; b.x = xb_xcc_id(); b.st = st;
    if (threadIdx.x == 0) (void)xb_add(&bar[XB_XCNT(b.x)], 1u);
    return b;
}
DI void xcd_barrier_complete(unsigned* bar, unsigned x, unsigned& nloc, unsigned& nx) {
    const unsigned G = gridDim.x * gridDim.y * gridDim.z;
    unsigned sum, cnt, mine, sp = 0u;
    for (;;) {
        sum = 0u; cnt = 0u; mine = 0u;
#pragma unroll
        for (unsigned j = 0; j < 16; ++j) { const unsigned c = xb_ld(&bar[XB_XCNT(j)]); sum += c; cnt += (c > 0u) ? 1u : 0u; mine = (j == x) ? c : mine; }
        if (sum == G) break;
        __builtin_amdgcn_s_sleep(1);
        if ((++sp & 255u) == 0u) { if (xb_ld(&bar[XB_TMO])) break; if (sp > XB_SPIN_CAP) { atomicAdd(&bar[XB_TMO], 1u); break; } }
    }
    nloc = mine > 0u ? mine : 1u; nx = cnt > 0u ? cnt : 1u;
}
DI void xcd_barrier(const XcdBarrier& b) {
    asm volatile("s_waitcnt vmcnt(0)" ::: "memory");
    __syncthreads();
    if (threadIdx.x == 0) {
        unsigned* bar = b.bar;
        __builtin_amdgcn_s_waitcnt(0);
        unsigned nloc = b.st[0], nx = b.st[1];
        if (nloc == 0u) { xcd_barrier_complete(bar, b.x, nloc, nx); b.st[0] = nloc; b.st[1] = nx; }
        const unsigned old = xb_add(&bar[XB_XSUB(b.x)], 1u);
        const unsigned gen = old / nloc;
        if (old + 1u == (gen + 1u) * nloc) {
            __builtin_amdgcn_fence(__ATOMIC_RELEASE, "agent");
            asm volatile("s_waitcnt vmcnt(0)" ::: "memory");
            const unsigned og = xb_add(&bar[XB_TOP], 1u);
            const unsigned tg = og / nx;
            if (og + 1u == (tg + 1u) * nx) xb_add(&bar[XB_TOPGEN], 1u);
            else XB_SPIN(xb_ld(&bar[XB_TOPGEN]) == tg, bar);
            __builtin_amdgcn_fence(__ATOMIC_ACQUIRE, "agent");
            xb_add(&bar[XB_XGEN(b.x)], 1u);
            asm volatile("s_waitcnt vmcnt(0)" ::: "memory");
        } else {
            XB_SPIN(xb_ld(&bar[XB_XGEN(b.x)]) == gen, bar);
            __builtin_amdgcn_fence(__ATOMIC_ACQUIRE, "agent");
            asm volatile("s_waitcnt vmcnt(0)" ::: "memory");
        }
    }
    __syncthreads();
}

namespace pg8 {
#define PG8_LAS __attribute__((address_space(3)))
typedef unsigned short bf16_t;
typedef short bf16x8 __attribute__((ext_vector_type(8)));
typedef float f32x4 __attribute__((ext_vector_type(4)));
typedef unsigned u32x4 __attribute__((ext_vector_type(4)));
constexpr int BM = 256, BK = 64, HALF = 128, HTB = HALF * BK * 2, STAGE_BYTES = 8 * HTB, NXCD = 8, WGM = 8;
__host__ __device__ __forceinline__ int lds_byte(int r, int c) { const int st = (r >> 4) * 2 + (c >> 5), rr = r & 15, cc = c & 31, ob = rr * 64 + cc * 2; return st * 1024 + (ob ^ (((ob >> 9) & 1) << 5)); }
__host__ __device__ __forceinline__ void stage_rc(int b, int& R, int& C) { const int st = b / 1024, sb = b % 1024, swz = sb ^ (((sb >> 9) & 1) << 5); R = (st >> 1) * 16 + swz / 64; C = (st & 1) * 32 + (swz % 64) / 2; }
__host__ __device__ __forceinline__ int perm32(int rho) { const int n = rho >> 4, i = rho & 15; return 8 * (i >> 2) + 4 * n + (i & 3); }
struct Unit { int pm, pn, br; };
template <int AC0, int AC1, int AC2>
struct GemmT {
    const char* A; const char* Bt; int lda, ldb, K; size_t b_br;
    __device__ __forceinline__ const char* a_ptr(const Unit& u) const { const int ac = u.br == 0 ? AC0 : (u.br == 1 ? AC1 : AC2); return A + ((size_t)u.pm * BM * lda + ac) * 2; }
    __device__ __forceinline__ const char* b_ptr(const Unit& u) const { return Bt + (size_t)u.br * b_br + (size_t)u.pn * BM * ldb * 2; }
};
__host__ __device__ __forceinline__ void tile_of(int L, int nM, int nN, int& pm, int& pn) {
    const int nwg = nM * nN; int wgid = L; { const int q = nwg / NXCD, r = nwg % NXCD, xcd = wgid % NXCD, off = wgid / NXCD; wgid = (xcd < r ? xcd * (q + 1) : r * (q + 1) + (xcd - r) * q) + off; }
    const int nig = WGM * nN, gid = wgid / nig, fm = gid * WGM, gsz = (nM - fm) < WGM ? (nM - fm) : WGM;
    pm = fm + ((wgid % nig) % gsz); pn = (wgid % nig) / gsz;
}
__device__ __forceinline__ unsigned cvt_pk_bf16(float lo, float hi) { unsigned r; asm volatile("v_cvt_pk_bf16_f32 %0, %1, %2" : "=v"(r) : "v"(lo), "v"(hi)); return r; }
template <class Epi, class Sched, bool ALIGN_EPI, bool SP2, class Gemm>
__device__ __forceinline__ void gemm_phase(PG8_LAS unsigned char* lds, const Gemm g, const Sched& S, const Epi& E) {
    const int tid = threadIdx.x, wid = __builtin_amdgcn_readfirstlane(tid >> 6), lane = tid & 63, wr = wid >> 2, wc = wid & 3, fr = lane & 15, fq = lane >> 4;
    const int K = g.K, nt = K / BK;
    unsigned voffA[2], voffB[2];
#pragma unroll
    for (int i = 0; i < 2; ++i) { int R, C; stage_rc(tid * 16 + i * 8192, R, C); const int Rb = Epi::PERM ? ((R & ~31) + perm32(R & 31)) : R;
        voffA[i] = (unsigned)(R * g.lda + C) * 2u; voffB[i] = (unsigned)(Rb * g.ldb + C) * 2u; }
    const size_t kstep = (size_t)(BK * 2);
    const size_t hA = (size_t)HALF * g.lda * 2, hB = (size_t)HALF * g.ldb * 2;
    const unsigned ldsw = (unsigned)wid * 1024u;
    const int aoff = lds_byte(wr * 64 + fr, fq * 8), boff = lds_byte(wc * 32 + fr, fq * 8);
#define PG8_SA(b, h) (((b) * 2 + (h)) * HTB)
#define PG8_SB(b, h) ((4 + (b) * 2 + (h)) * HTB)
#define PG8_STAGE(bufoff, gbase, voff) do { _Pragma("unroll") for (int _i = 0; _i < 2; ++_i) \
        __builtin_amdgcn_global_load_lds((const unsigned*)((const char*)(gbase) + (voff)[_i]), (PG8_LAS unsigned*)(lds + (bufoff) + ldsw + _i * 8192), 16, 0, 0); } while (0)
#define PG8_LDA(dst, b, h) do { _Pragma("unroll") for (int m = 0; m < 4; ++m) _Pragma("unroll") for (int k = 0; k < 2; ++k) dst[m][k] = *(const PG8_LAS bf16x8*)(lds + PG8_SA(b, h) + aoff + m * 2048 + k * 1024); } while (0)
#define PG8_LDB(dst, b, h) do { _Pragma("unroll") for (int n = 0; n < 2; ++n) _Pragma("unroll") for (int k = 0; k < 2; ++k) dst[n][k] = *(const PG8_LAS bf16x8*)(lds + PG8_SB(b, h) + boff + n * 2048 + k * 1024); } while (0)
#define PG8_MMA(ai, bj, At, Bt) do { __builtin_amdgcn_s_setprio(1); _Pragma("unroll") for (int m = 0; m < 4; ++m) _Pragma("unroll") for (int n = 0; n < 2; ++n) _Pragma("unroll") for (int k = 0; k < 2; ++k) \
        acc[ai][bj][m][n] = __builtin_amdgcn_mfma_f32_16x16x32_bf16(Bt[n][k], At[m][k], acc[ai][bj][m][n], 0, 0, 0); __builtin_amdgcn_s_setprio(0); } while (0)
#define PG8_WAIT_V(n) asm volatile("s_waitcnt vmcnt(" #n ")" ::: "memory")
#define PG8_WAIT_L(n) asm volatile("s_waitcnt lgkmcnt(" #n ")" ::: "memory")
#define PG8_BAR __builtin_amdgcn_s_barrier()
#define PG8_SCHED __builtin_amdgcn_sched_barrier(0)
    Unit cur, nxt; int ui = 0;
    if (!S.next(0, cur)) return;
    f32x4 acc[2][2][4][2];
#pragma unroll
    for (int a = 0; a < 2; ++a)
#pragma unroll
        for (int b = 0; b < 2; ++b)
#pragma unroll
            for (int m = 0; m < 4; ++m)
#pragma unroll
                for (int n = 0; n < 2; ++n) acc[a][b][m][n] = (f32x4){0.f, 0.f, 0.f, 0.f};
    bf16x8 At[4][2], B0[2][2], B1[2][2];
    const char* cA = g.a_ptr(cur); const char* cB = g.b_ptr(cur);
    S.a_ready(cur);
    if constexpr (SP2) {
        PG8_STAGE(PG8_SB(0, 0), cB, voffB); PG8_STAGE(PG8_SB(0, 1), cB + hB, voffB); PG8_STAGE(PG8_SA(0, 0), cA, voffA); PG8_STAGE(PG8_SA(0, 1), cA + hA, voffA);
        if (wr == 1) PG8_BAR;
        PG8_WAIT_V(2); PG8_BAR;
        PG8_STAGE(PG8_SB(1, 0), cB + kstep, voffB); PG8_STAGE(PG8_SA(1, 0), cA + kstep, voffA); PG8_STAGE(PG8_SB(1, 1), cB + hB + kstep, voffB);
        PG8_WAIT_V(6); PG8_BAR;
    } else {
        PG8_STAGE(PG8_SB(0, 0), cB, voffB); PG8_STAGE(PG8_SA(0, 0), cA, voffA); PG8_STAGE(PG8_SB(0, 1), cB + hB, voffB); PG8_STAGE(PG8_SA(0, 1), cA + hA, voffA);
        if (wr == 1) PG8_BAR;
        PG8_WAIT_V(4); PG8_BAR;
        PG8_STAGE(PG8_SB(1, 0), cB + kstep, voffB); PG8_STAGE(PG8_SA(1, 0), cA + kstep, voffA); PG8_STAGE(PG8_SB(1, 1), cB + hB + kstep, voffB);
        PG8_WAIT_V(6); PG8_BAR;
    }
    for (;;) {
        const bool has_next = S.next(ui + 1, nxt);
        const char* nA = has_next ? g.a_ptr(nxt) : cA; const char* nB = has_next ? g.b_ptr(nxt) : cB;
        for (int t = 0; t < nt; t += 2) {
            const bool last = (t == nt - 2);
            const char* a1 = cA + (size_t)(t + 1) * kstep;
            const char* a2 = last ? nA : cA + (size_t)(t + 2) * kstep; const char* b2 = last ? nB : cB + (size_t)(t + 2) * kstep;
            const char* a3 = a2 + kstep; const char* b3 = b2 + kstep;
            if (last && has_next) S.a_ready(nxt);
            if constexpr (SP2) {
            PG8_LDB(B0, 0, 0); PG8_LDB(B1, 0, 1); PG8_SCHED; PG8_LDA(At, 0, 0); PG8_STAGE(PG8_SA(1, 1), a1 + hA, voffA);
            PG8_WAIT_V(8); PG8_WAIT_L(0); PG8_BAR; PG8_MMA(0, 0, At, B0); PG8_MMA(0, 1, At, B1); PG8_BAR; PG8_SCHED;
            PG8_LDA(At, 0, 1); PG8_STAGE(PG8_SB(0, 0), b2, voffB); PG8_STAGE(PG8_SB(0, 1), b2 + hB, voffB); PG8_STAGE(PG8_SA(0, 0), a2, voffA);
            PG8_WAIT_V(8); PG8_WAIT_L(0); PG8_BAR; PG8_MMA(1, 0, At, B0); PG8_MMA(1, 1, At, B1); PG8_BAR; PG8_SCHED;
            PG8_LDB(B0, 1, 0); PG8_LDB(B1, 1, 1); PG8_SCHED; PG8_LDA(At, 1, 0); PG8_STAGE(PG8_SA(0, 1), a2 + hA, voffA);
            PG8_WAIT_V(8); PG8_WAIT_L(0); PG8_BAR; PG8_MMA(0, 0, At, B0); PG8_MMA(0, 1, At, B1); PG8_BAR; PG8_SCHED;
            PG8_LDA(At, 1, 1); PG8_STAGE(PG8_SB(1, 0), b3, voffB); PG8_STAGE(PG8_SB(1, 1), b3 + hB, voffB); PG8_STAGE(PG8_SA(1, 0), a3, voffA);
            PG8_WAIT_V(8); PG8_WAIT_L(0); PG8_BAR; PG8_MMA(1, 0, At, B0); PG8_MMA(1, 1, At, B1); PG8_BAR; PG8_SCHED;
            } else {
            PG8_LDB(B0, 0, 0); PG8_SCHED; PG8_LDA(At, 0, 0); PG8_STAGE(PG8_SA(1, 1), a1 + hA, voffA);
            PG8_WAIT_L(8); PG8_BAR; PG8_WAIT_L(0); PG8_MMA(0, 0, At, B0); PG8_BAR; PG8_SCHED;
            PG8_LDB(B1, 0, 1); PG8_STAGE(PG8_SB(0, 0), b2, voffB);
            PG8_BAR; PG8_WAIT_L(0); PG8_MMA(0, 1, At, B1); PG8_BAR;
            PG8_LDA(At, 0, 1); PG8_STAGE(PG8_SA(0, 0), a2, voffA);
            PG8_BAR; PG8_WAIT_L(0); PG8_MMA(1, 0, At, B0); PG8_BAR; PG8_SCHED;
            PG8_STAGE(PG8_SB(0, 1), b2 + hB, voffB);
            PG8_WAIT_V(6); PG8_BAR; PG8_MMA(1, 1, At, B1); PG8_BAR;
            PG8_LDB(B0, 1, 0); PG8_SCHED; PG8_LDA(At, 1, 0); PG8_STAGE(PG8_SA(0, 1), a2 + hA, voffA);
            PG8_WAIT_L(8); PG8_BAR; PG8_WAIT_L(0); PG8_MMA(0, 0, At, B0); PG8_BAR; PG8_SCHED;
            PG8_LDB(B1, 1, 1); PG8_STAGE(PG8_SB(1, 0), b3, voffB);
            PG8_BAR; PG8_WAIT_L(0); PG8_MMA(0, 1, At, B1); PG8_BAR;
            PG8_LDA(At, 1, 1); PG8_STAGE(PG8_SA(1, 0), a3, voffA);
            PG8_BAR; PG8_WAIT_L(0); PG8_MMA(1, 0, At, B0); PG8_BAR; PG8_SCHED;
            PG8_STAGE(PG8_SB(1, 1), b3 + hB, voffB);
            PG8_WAIT_V(6); PG8_BAR; PG8_MMA(1, 1, At, B1); PG8_BAR;
            }
        }
        if constexpr (ALIGN_EPI) { if (wr == 0) PG8_BAR; }
        if constexpr (!Epi::AFTER_DRAIN) { E(acc, cur, wr, wc, fr, fq); S.done(cur); }
        if (!has_next) break;
#pragma unroll
        for (int a = 0; a < 2; ++a)
#pragma unroll
            for (int b = 0; b < 2; ++b)
#pragma unroll
                for (int m = 0; m < 4; ++m)
#pragma unroll
                    for (int n = 0; n < 2; ++n) acc[a][b][m][n] = (f32x4){0.f, 0.f, 0.f, 0.f};
        cur = nxt; cA = nA; cB = nB; ++ui;
        if constexpr (ALIGN_EPI) { if (wr == 1) PG8_BAR; }
    }
    PG8_WAIT_V(0);
    if constexpr (!ALIGN_EPI) { if (wr == 0) PG8_BAR; }
    PG8_BAR;
    if constexpr (Epi::AFTER_DRAIN) { E.fused(acc, cur, wr, wc, fr, fq, lds, wid, lane); S.done(cur); }
#undef PG8_SA
#undef PG8_SB
#undef PG8_STAGE
#undef PG8_LDA
#undef PG8_LDB
#undef PG8_MMA
#undef PG8_WAIT_V
#undef PG8_WAIT_L
#undef PG8_BAR
#undef PG8_SCHED
}
}

struct Args { const float* in[24]; float* out; unsigned char* ws; int ph_lo, ph_hi, li, pad; };
#define IN_(k) (A_.in[k])
#define X_PROMPT IN_(0)
#define X_SAMPLE IN_(1)
#define CACHE_K IN_(2)
#define CACHE_V IN_(3)
#define STATE_HGRN IN_(4)
#define CACHE_MK IN_(5)
#define CACHE_MV IN_(6)
#define MEM_PROMPT IN_(7)
#define W_IN IN_(8)
#define LQ1 IN_(9)
#define LK1 IN_(10)
#define LQ2 IN_(11)
#define LK2 IN_(12)
#define SUB_NORM IN_(13)
#define LB_LOGITS IN_(14)
#define HGRN_NORM IN_(15)
#define W_MEM_K IN_(16)
#define W_MEM_V IN_(17)
#define W_A IN_(18)
#define W_B IN_(19)
#define W_C IN_(20)
#define W_OUT IN_(21)
#define LN_G IN_(22)
#define LN_B IN_(23)
#define OUT_ (A_.out)
#define WS_(off) (A_.ws + (off))
#define XB_ ((bf16*)WS_(WS_XB))
#define WT_ ((bf16*)WS_(WS_WT))
#define WABC_ ((bf16*)WS_(WS_WABC))
#define WO_ ((bf16*)WS_(WS_WO))
#define MKV_ ((bf16*)WS_(WS_MKV))
#define P_ ((bf16*)WS_(WS_P))
#define MG_ ((bf16*)WS_(WS_MG))
#define G_ ((float*)WS_(WS_G))
#define OB_ ((float*)WS_(WS_OB))
#define ROPE_ ((v2f*)WS_(WS_ROPE))
typedef const Args& Ctx;

struct InProjOrder {
    int G, c;
    DI bool next(int i, pg8::Unit& u) const {
        const int L = i * G + c; u.br = 0;
        if (L < 130 * 68) { pg8::tile_of(L, 130, 68, u.pm, u.pn); return true; }
        const int l = L - 130 * 68; if (l >= 64) return false;
        u.pm = 130 + (l & 7); u.pn = 68 + (l >> 3); return true;
    }
    DI void a_ready(const pg8::Unit&) const {}
    DI void done(const pg8::Unit&) const {}
};
struct MergeOrder {
    int G, c;
    DI bool next(int i, pg8::Unit& u) const {
        const int T = (i / 3) * G + c; if (T >= 130 * 8) return false;
        pg8::tile_of(T, 130, 8, u.pm, u.pn); u.br = i % 3; return true;
    }
    DI void a_ready(const pg8::Unit&) const {}
    DI void done(const pg8::Unit&) const {}
};
struct OutOrder {
    int G, c;
    DI bool next(int i, pg8::Unit& u) const {
        const int L = i * G + c; if (L >= 130 * 8) return false;
        pg8::tile_of(L, 130, 8, u.pm, u.pn); u.br = 0; return true;
    }
    DI void a_ready(const pg8::Unit&) const {}
    DI void done(const pg8::Unit&) const {}
};

DI void st8bf(bf16* p, const float (&v)[8]) {
    v4u w; w.x = pg8::cvt_pk_bf16(v[0], v[1]); w.y = pg8::cvt_pk_bf16(v[2], v[3]); w.z = pg8::cvt_pk_bf16(v[4], v[5]); w.w = pg8::cvt_pk_bf16(v[6], v[7]);
    *(v4u*)p = w;
}
DI void st8f(float* p, const float (&v)[8]) { *(v4f*)p = (v4f){v[0], v[1], v[2], v[3]}; *(v4f*)(p + 4) = (v4f){v[4], v[5], v[6], v[7]}; }
DI void ld8bf(const bf16* p, float (&f)[8]) {
    const v4u w = *(const v4u*)p;
    f[0] = bflo(w.x); f[1] = bfhi(w.x); f[2] = bflo(w.y); f[3] = bfhi(w.y); f[4] = bflo(w.z); f[5] = bfhi(w.z); f[6] = bflo(w.w); f[7] = bfhi(w.w);
}

struct EpiIn {
    static constexpr bool PERM = true, AFTER_DRAIN = false;
    bf16* P; float* G; float* out; bf16* MKV; const float* lbl; const v2f* rope;
    template <int MODE>
    DI void rows(const pg8::f32x4 (&acc)[2][2][4][2], const pg8::Unit& u, int wr, int wc, int fr, int fq) const {
        const int pn = u.pn, tc0 = wc * 32 + fq * 8;
        float lbv[2][8];
        if constexpr (MODE == 4) {
#pragma unroll
            for (int bj = 0; bj < 2; ++bj) { const int cf = (pn - 20) * 256 + bj * 128 + tc0;
#pragma unroll
                for (int i = 0; i < 8; ++i) lbv[bj][i] = sigm(lbl[cf + i] - lbl[1024 + cf + i]); }
        }
#pragma unroll
        for (int ai = 0; ai < 2; ++ai)
#pragma unroll
            for (int m = 0; m < 4; ++m) {
                const int row = u.pm * 256 + ai * 128 + wr * 64 + m * 16 + fr;
                v2f cs[8];
                if constexpr (MODE <= 1) {
                    const int pos = row < MP ? (row & (SEQ - 1)) : PAST + ((row - MP) & (DS - 1));
                    const v4f* rp = (const v4f*)(rope + (size_t)pos * 8);
#pragma unroll
                    for (int i = 0; i < 4; ++i) { const v4f t = rp[i]; cs[2 * i] = (v2f){t.x, t.y}; cs[2 * i + 1] = (v2f){t.z, t.w}; }
                }
#pragma unroll
                for (int bj = 0; bj < 2; ++bj) {
                    float v[8];
#pragma unroll
                    for (int i = 0; i < 4; ++i) { v[i] = acc[ai][bj][m][0][i]; v[4 + i] = acc[ai][bj][m][1][i]; }
                    const int col = pn * 256 + bj * 128 + tc0;
                    if constexpr (MODE <= 1) {
                        if ((wc & 1) == 0) {
                            const float sgn = fq == 0 ? -1.f : 1.f;
#pragma unroll
                            for (int i = 0; i < 8; ++i) { const float pr = __shfl_xor(v[i], 16); const float r = v[i] * cs[i].x + sgn * pr * cs[i].y; v[i] = fq < 2 ? r : v[i]; }
                        }
                        if constexpr (MODE == 0) {
#pragma unroll
                            for (int i = 0; i < 8; ++i) v[i] *= QA_SCALE;
                        }
                    }
                    if constexpr (MODE == 1 || MODE == 2) {
                        const int cs1 = (pn & 3) * 256 + bj * 128 + tc0;
                        float* dst = row < MP ? out + (MODE == 1 ? O_KP : O_VP) + (size_t)row * 1024 + cs1 : out + (MODE == 1 ? O_KS : O_VS) + (size_t)(row - MP) * 1024 + cs1;
                        st8f(dst, v);
                    }
                    if constexpr (MODE == 3) {
#pragma unroll
                        for (int i = 0; i < 8; ++i) v[i] = silu(v[i]);
                    }
                    if constexpr (MODE == 6) {
#pragma unroll
                        for (int i = 0; i < 8; ++i) v[i] = sigm(v[i]);
                    }
                    if constexpr (MODE == 7) {
#pragma unroll
                        for (int i = 0; i < 8; ++i) v[i] *= QC_SCALE;
                    }
                    if constexpr (MODE == 4) {
                        const int cf = (pn - 20) * 256 + bj * 128 + tc0;
#pragma unroll
                        for (int i = 0; i < 8; ++i) { const float lb = lbv[bj][i]; const float f = lb + (1.f - lb) * sigm(v[i]); v[i] = __builtin_amdgcn_logf(f) * LN2; }
                        st8f(G + (size_t)row * 1024 + cf, v);
                    } else if constexpr (MODE == 8) {
                        const int r = row - M, cm = (pn - 68) * 256 + bj * 128 + tc0;
                        float* dst = cm < 1024 ? out + O_MK + (size_t)r * 1024 + cm : out + O_MV + (size_t)r * 1024 + (cm - 1024);
                        st8f(dst, v);
                        st8bf(MKV + (size_t)r * 2048 + cm, v);
                    } else {
                        st8bf(P + (size_t)row * NIN + col, v);
                    }
                }
            }
    }
    DI void operator()(const pg8::f32x4 (&acc)[2][2][4][2], const pg8::Unit& u, int wr, int wc, int fr, int fq) const {
        const int pn = u.pn;
        int mode;
        if (pn >= 68) mode = 8;
        else if (pn >= 44) mode = 6;
        else { const int seg = pn >> 2; mode = seg == 0 ? 0 : seg == 1 ? 1 : seg == 2 ? 2 : seg == 5 ? 4 : seg == 6 ? 5 : seg == 7 ? 6 : seg == 9 ? 7 : 3; }
        switch (mode) {
            case 0: rows<0>(acc, u, wr, wc, fr, fq); break;
            case 1: rows<1>(acc, u, wr, wc, fr, fq); break;
            case 2: rows<2>(acc, u, wr, wc, fr, fq); break;
            case 3: rows<3>(acc, u, wr, wc, fr, fq); break;
            case 4: rows<4>(acc, u, wr, wc, fr, fq); break;
            case 5: rows<5>(acc, u, wr, wc, fr, fq); break;
            case 6: rows<6>(acc, u, wr, wc, fr, fq); break;
            case 7: rows<7>(acc, u, wr, wc, fr, fq); break;
            default: rows<8>(acc, u, wr, wc, fr, fq); break;
        }
    }
};

struct EpiMerge {
    static constexpr bool PERM = true, AFTER_DRAIN = false;
    const bf16* P; bf16* MG;
    DI void operator()(const pg8::f32x4 (&acc)[2][2][4][2], const pg8::Unit& u, int wr, int wc, int fr, int fq) const {
        const int tc0 = wc * 32 + fq * 8, gbase = u.br == 0 ? C_GA : (u.br == 1 ? C_GB : C_GC);
#pragma unroll
        for (int ai = 0; ai < 2; ++ai)
#pragma unroll
            for (int m = 0; m < 4; ++m) {
                const int row = u.pm * 256 + ai * 128 + wr * 64 + m * 16 + fr;
#pragma unroll
                for (int bj = 0; bj < 2; ++bj) {
                    const int col = u.pn * 256 + bj * 128 + tc0;
                    float g[8], v[8];
                    ld8bf(P + (size_t)row * NIN + gbase + col, g);
#pragma unroll
                    for (int i = 0; i < 4; ++i) { v[i] = acc[ai][bj][m][0][i] * g[i]; v[4 + i] = acc[ai][bj][m][1][i] * g[4 + i]; }
                    bf16* mp = MG + (size_t)row * D + col;
                    if (u.br != 0) { float o[8]; ld8bf(mp, o);
#pragma unroll
                        for (int i = 0; i < 8; ++i) v[i] += o[i]; }
                    st8bf(mp, v);
                }
            }
    }
};

struct EpiOut {
    static constexpr bool PERM = false, AFTER_DRAIN = false;
    const float* xp; const float* xs; float* out;
    DI void operator()(const pg8::f32x4 (&acc)[2][2][4][2], const pg8::Unit& u, int wr, int wc, int fr, int fq) const {
#pragma unroll
        for (int ai = 0; ai < 2; ++ai)
#pragma unroll
            for (int m = 0; m < 4; ++m) {
                const int row = u.pm * 256 + ai * 128 + wr * 64 + m * 16 + fr;
                const float* xr = row < MP ? xp + (size_t)row * D : xs + (size_t)(row - MP) * D;
#pragma unroll
                for (int bj = 0; bj < 2; ++bj)
#pragma unroll
                    for (int n = 0; n < 2; ++n) {
                        const int col = u.pn * 256 + bj * 128 + wc * 32 + n * 16 + fq * 4;
                        const v4f x4 = *(const v4f*)(xr + col);
                        const pg8::f32x4 a4 = acc[ai][bj][m][n];
                        *(v4f*)(out + (size_t)row * D + col) = (v4f){DN_ALPHA * x4.x + a4[0], DN_ALPHA * x4.y + a4[1], DN_ALPHA * x4.z + a4[2], DN_ALPHA * x4.w + a4[3]};
                    }
            }
    }
};

DI void p0_transpose_item(const float* W, int K, int N, bf16* WT, int row_off, LAS float* scr, int item, int lane) {
    const int nblk = N / 32, kb = item / nblk, nb = item % nblk, k0 = 64 * kb, n0 = 32 * nb;
#pragma unroll 8
    for (int i = 0; i < 32; ++i) { const int kk = 2 * i + (lane >> 5); scr[kk * 33 + (lane & 31)] = W[(size_t)(k0 + kk) * N + n0 + (lane & 31)]; }
    asm volatile("s_waitcnt lgkmcnt(0)" ::: "memory");
    const int c = lane & 7;
#pragma unroll
    for (int j = 0; j < 4; ++j) { const int n = (lane >> 3) + 8 * j; const LAS float* s = scr + (8 * c) * 33 + n;
        v4u o; o.x = pk2(s[0 * 33], s[1 * 33]); o.y = pk2(s[2 * 33], s[3 * 33]); o.z = pk2(s[4 * 33], s[5 * 33]); o.w = pk2(s[6 * 33], s[7 * 33]);
        *(v4u*)(WT + (size_t)(row_off + n0 + n) * K + k0 + 8 * c) = o; }
    asm volatile("s_waitcnt lgkmcnt(0)" ::: "memory");
}
DI void p0_row_to_bf16(const float* xrow, bf16* orow, int lane) {
    const v4f* xr = (const v4f*)xrow + lane;
    v2u* o8 = (v2u*)orow + lane;
#pragma unroll
    for (int j = 0; j < 8; ++j) { const v4f v = xr[64 * j]; o8[64 * j] = (v2u){pk2(v.x, v.y), pk2(v.z, v.w)}; }
}
DI void p0_rope_entry(v2f* rope, int idx) {
    const int pos = idx >> 3, i = idx & 7;
    const float invf = i == 0 ? 1.0f : i == 1 ? 0.1939227432012558f : i == 2 ? 0.03760603070259094f : i == 3 ? 0.007292664609849453f : i == 4 ? 0.0014142135623842478f
                     : i == 5 ? 0.00027424818836152554f : i == 6 ? 5.318296098266728e-05f : 1.0313386155758053e-05f;
    const float ang = (float)pos * invf;
    const double x = (double)ang, twopi = 6.283185307179586476925286766559;
    const double k = __builtin_rint(x / twopi), r = x - k * twopi, r2 = r * r;
    double c = 1.0, s = 1.0;
#pragma unroll
    for (int n = 17; n >= 1; --n) { c = 1.0 - c * r2 / (double)((2 * n - 1) * (2 * n)); s = 1.0 - s * r2 / (double)((2 * n) * (2 * n + 1)); }
    rope[idx] = (v2f){(float)c, (float)(s * r)};
}

DI void ln_row(Ctx A_, int m, int lane) {
    v4f* xr = (v4f*)(OUT_ + (size_t)m * D) + lane;
    v4f v[8]; float s = 0.f;
#pragma unroll
    for (int j = 0; j < 8; ++j) { v[j] = xr[64 * j]; s += (v[j].x + v[j].y) + (v[j].z + v[j].w); }
    const float mean = wave_sum(s) * (1.0f / D); float s2 = 0.f;
#pragma unroll
    for (int j = 0; j < 8; ++j) { v[j] = v[j] - mean; s2 += (v[j].x * v[j].x + v[j].y * v[j].y) + (v[j].z * v[j].z + v[j].w * v[j].w); }
    const float rstd = 1.0f / sqrtf(wave_sum(s2) * (1.0f / D) + NORM_EPS);
    const v4f* gp = (const v4f*)LN_G + lane; const v4f* bp = (const v4f*)LN_B + lane;
#pragma unroll
    for (int j = 0; j < 8; ++j) { const v4f g = gp[64 * j], bb = bp[64 * j]; xr[64 * j] = v[j] * rstd * g + bb; }
}

DI float lam_of(Ctx A_, int lane) {
    const float d1 = wave_sum(LQ1[lane] * LK1[lane]), d2 = wave_sum(LQ2[lane] * LK2[lane]);
    return __expf(d1) - __expf(d2) + LAM_INIT;
}
namespace fa {
typedef short bf16x8 __attribute__((ext_vector_type(8)));
typedef short s16x4 __attribute__((ext_vector_type(4)));
typedef float f32x16 __attribute__((ext_vector_type(16)));
typedef float f32x2_t __attribute__((ext_vector_type(2)));
typedef __bf16 bf16x2_t __attribute__((ext_vector_type(2)));
typedef short v4i16_t __attribute__((ext_vector_type(4)));
constexpr int KT = 16384, VT = 16384, BUF = KT + VT, WSF_OFF = 2 * BUF;
DI int crow(int i, int hh) { return (i & 3) + 8 * (i >> 2) + 4 * hh; }
DI unsigned cvtpk(float lo, float hi) { f32x2_t v = {lo, hi}; bf16x2_t b = __builtin_convertvector(v, bf16x2_t); return __builtin_bit_cast(unsigned, b); }
DI bf16x8 pack8(const f32x16& x, int s8) {
    v4u p; p.x = cvtpk(x[s8], x[s8 + 1]); p.y = cvtpk(x[s8 + 2], x[s8 + 3]); p.z = cvtpk(x[s8 + 4], x[s8 + 5]); p.w = cvtpk(x[s8 + 6], x[s8 + 7]);
    return __builtin_bit_cast(bf16x8, p);
}
DI s16x4 vtr(const LAS unsigned char* p) { return __builtin_bit_cast(s16x4, __builtin_amdgcn_ds_read_tr16_b64_v4i16((LAS v4i16_t*)p)); }
DI void load_tile(LAS unsigned char* buf, const bf16* Kg, const bf16* Vg, int kv0, int wave, int lane) {
#pragma unroll
    for (int i = 0; i < 2; ++i) { const int c = 2 * wave + i;
        __builtin_amdgcn_global_load_lds((const unsigned*)(Kg + (size_t)(kv0 + lane) * NIN + c * 8), (LAS unsigned*)(buf + c * 1024), 16, 0, 0); }
#pragma unroll
    for (int i = 0; i < 2; ++i) { const int pc = 2 * wave + i;
        __builtin_amdgcn_global_load_lds((const unsigned*)(Vg + (size_t)(kv0 + 16 * (pc & 3) + (lane >> 2)) * NIN + (pc >> 2) * 32 + (lane & 3) * 8),
                                         (LAS unsigned*)(buf + KT + (pc >> 2) * 4096 + (pc & 3) * 1024), 16, 0, 0); }
}
DI void attn_unit(Ctx A_, LAS unsigned char* lds, int b, int h, int qb, float lam, int wave, int lane) {
    const int r = lane & 31, hh = lane >> 5, mp = wave >> 2, rg = wave & 3;
    bf16* P = P_;
    const size_t rowb = (size_t)b * SEQ;
    const bf16* Kg = P + rowb * NIN + C_KA + h * 128; const bf16* Vg = P + rowb * NIN + C_VA + h * 128;
    const int q0 = qb * 128 + rg * 32;
    const int NT = 2 * qb + 2, NTw = 2 * qb + 1 + (rg >> 1);
    LAS float* wsf = (LAS float*)(lds + WSF_OFF) + wave * 128;
    load_tile(lds, Kg, Vg, 0, wave, lane);
    bf16x8 qr[4];
    { const bf16* Qg = P + (rowb + q0 + r) * NIN + C_QA + h * 128 + mp * 64 + hh * 8;
#pragma unroll
      for (int d0 = 0; d0 < 4; ++d0) qr[d0] = *(const bf16x8*)(Qg + d0 * 16); }
    f32x16 o[4];
#pragma unroll
    for (int nb = 0; nb < 4; ++nb)
#pragma unroll
        for (int i = 0; i < 16; ++i) o[nb][i] = 0.f;
    float m = -INFINITY, l = 0.f;
    const int g16 = (lane >> 4) & 1, p4 = lane & 3, q4 = (lane & 15) >> 2;
    for (int t = 0; t < NT; ++t) {
        asm volatile("s_waitcnt vmcnt(0) lgkmcnt(0)" ::: "memory"); __builtin_amdgcn_s_barrier(); asm volatile("" ::: "memory");
        if (t + 1 < NT) load_tile(lds + ((t + 1) & 1) * BUF, Kg, Vg, (t + 1) * 64, wave, lane);
        if (t < NTw) {
            const LAS unsigned char* buf = lds + (t & 1) * BUF;
            const LAS unsigned char* kb = buf + (mp * 8 + hh) * 1024 + r * 16;
            f32x16 p0, p1;
#pragma unroll
            for (int i = 0; i < 16; ++i) { p0[i] = 0.f; p1[i] = 0.f; }
#pragma unroll
            for (int d0 = 0; d0 < 4; ++d0) {
                const bf16x8 k0 = *(const LAS bf16x8*)(kb + d0 * 2048), k1 = *(const LAS bf16x8*)(kb + d0 * 2048 + 512);
                p0 = __builtin_amdgcn_mfma_f32_32x32x16_bf16(k0, qr[d0], p0, 0, 0, 0);
                p1 = __builtin_amdgcn_mfma_f32_32x32x16_bf16(k1, qr[d0], p1, 0, 0, 0);
            }
            float tm = fmaxf(p0[0], p1[0]);
#pragma unroll
            for (int i = 1; i < 16; ++i) tm = fmaxf(tm, fmaxf(p0[i], p1[i]));
            tm = fmaxf(tm, __shfl_xor(tm, 32));
            if (__any(tm > m)) {
                const float mn = fmaxf(m, tm), f = fexp2(m - mn); m = mn; l *= f;
                if (hh == 0) wsf[r] = f;
                float fr[16];
#pragma unroll
                for (int i = 0; i < 16; ++i) fr[i] = wsf[crow(i, hh)];
#pragma unroll
                for (int nb = 0; nb < 4; ++nb)
#pragma unroll
                    for (int i = 0; i < 16; ++i) o[nb][i] *= fr[i];
            }
            float ls = 0.f;
#pragma unroll
            for (int i = 0; i < 16; ++i) { p0[i] = fexp2(p0[i] - m); p1[i] = fexp2(p1[i] - m); ls += p0[i] + p1[i]; }
            l += ls;
            bf16x8 pf[4]; pf[0] = pack8(p0, 0); pf[1] = pack8(p0, 8); pf[2] = pack8(p1, 0); pf[3] = pack8(p1, 8);
            const LAS unsigned char* vp = buf + KT + g16 * 32 + p4 * 8 + (4 * hh + q4) * 64;
#pragma unroll
            for (int ks = 0; ks < 4; ++ks)
#pragma unroll
                for (int nb = 0; nb < 4; ++nb) {
                    const s16x4 lo = vtr(vp + nb * 4096 + ks * 1024), hi = vtr(vp + nb * 4096 + ks * 1024 + 512);
                    const bf16x8 vf = __builtin_shufflevector(lo, hi, 0, 1, 2, 3, 4, 5, 6, 7);
                    o[nb] = __builtin_amdgcn_mfma_f32_32x32x16_bf16(pf[ks], vf, o[nb], 0, 0, 0);
                }
        }
    }
    l += __shfl_xor(l, 32);
    if (hh == 0) wsf[32 + r] = l;
    float rl[16];
#pragma unroll
    for (int i = 0; i < 16; ++i) rl[i] = 1.0f / wsf[32 + crow(i, hh)];
    const float sc = mp == 0 ? 1.0f : lam;
#pragma unroll
    for (int nb = 0; nb < 4; ++nb)
#pragma unroll
        for (int i = 0; i < 16; ++i) o[nb][i] *= rl[i] * sc;
    asm volatile("s_waitcnt vmcnt(0) lgkmcnt(0)" ::: "memory"); __builtin_amdgcn_s_barrier(); asm volatile("" ::: "memory");
    LAS float* X2 = (LAS float*)lds + rg * 4096 + lane;
    if (mp == 1) {
#pragma unroll
        for (int nb = 0; nb < 4; ++nb)
#pragma unroll
            for (int i = 0; i < 16; ++i) X2[(nb * 16 + i) * 64] = o[nb][i];
    }
    asm volatile("s_waitcnt lgkmcnt(0)" ::: "memory"); __builtin_amdgcn_s_barrier(); asm volatile("" ::: "memory");
    if (mp == 0) {
        float ssq[16];
#pragma unroll
        for (int i = 0; i < 16; ++i) ssq[i] = 0.f;
#pragma unroll
        for (int nb = 0; nb < 4; ++nb)
#pragma unroll
            for (int i = 0; i < 16; ++i) { const float d = o[nb][i] - X2[(nb * 16 + i) * 64]; o[nb][i] = d; ssq[i] += d * d; }
#pragma unroll
        for (int i = 0; i < 16; ++i) {
            float v = ssq[i];
#pragma unroll
            for (int x = 1; x < 32; x <<= 1) v += __shfl_xor(v, x);
            ssq[i] = ONE_M_LAMINIT / sqrtf(v * (1.0f / 128.0f) + NORM_EPS);
        }
#pragma unroll
        for (int nb = 0; nb < 4; ++nb) {
            const float sn = SUB_NORM[nb * 32 + r];
#pragma unroll
            for (int i = 0; i < 16; ++i) {
                bf16* zp = P + (rowb + q0 + crow(i, hh)) * NIN + C_ZA + h * 128 + nb * 32 + r;
                *zp = (bf16)f2bf(o[nb][i] * ssq[i] * sn * bf2f(*zp));
            }
        }
    }
    asm volatile("s_waitcnt lgkmcnt(0)" ::: "memory"); __builtin_amdgcn_s_barrier(); asm volatile("" ::: "memory");
}
DI void attn_phase(Ctx A_, LAS unsigned char* lds, int G, int c, float lam, int wave, int lane) {
    if (G == 256) {
        const int bh = c >> 2, s = c & 3;
#pragma unroll 1
        for (int i = 0; i < 8; ++i) { const int base = 4 * (i >> 1) + s; const int qb = (i & 1) ? 31 - base : base;
            attn_unit(A_, lds, bh >> 3, bh & 7, qb, lam, wave, lane); }
    } else {
#pragma unroll 1
        for (int u = c; u < 2048; u += G) { const int qb = 31 - (u >> 6), bh = u & 63; attn_unit(A_, lds, bh >> 3, bh & 7, qb, lam, wave, lane); }
    }
}
}

namespace hg {
using fa::bf16x8; using fa::s16x4; using fa::f32x16; using fa::crow; using fa::pack8; using fa::vtr;
constexpr int RP = 272;
constexpr int OFF_QT = 0, OFF_KT = 17408, OFF_QS = 34816, OFF_KS = 52224, OFF_V = 69632, OFF_OX = 86016, OFF_SEG = 118784, OFF_DEC = 122880;
static_assert(OFF_DEC + 512 <= RING_BYTES, "hgrn lds map");
#define HG_BAR() do { asm volatile("s_waitcnt vmcnt(0) lgkmcnt(0)" ::: "memory"); __builtin_amdgcn_s_barrier(); asm volatile("" ::: "memory"); } while (0)
#define HG_LBAR() do { asm volatile("s_waitcnt lgkmcnt(0)" ::: "memory"); __builtin_amdgcn_s_barrier(); asm volatile("" ::: "memory"); } while (0)
DI void hgrn_unit(Ctx A_, LAS unsigned char* lds, int row0, int T, int NC, int h, const float* s0, float* sout, int wave, int lane, int tid) {
    bf16* P = P_; const float* G = G_;
    const int r = lane & 31, hh = lane >> 5, j = wave & 3, tb = wave >> 2;
    const int dkp = tid & 63, seg = wave;
    const int g16 = (lane >> 4) & 1, p4 = lane & 3, q4 = (lane & 15) >> 2;
    f32x16 S[4];
#pragma unroll
    for (int i = 0; i < 4; ++i)
#pragma unroll
        for (int e = 0; e < 16; ++e) S[i][e] = s0 ? s0[(size_t)(32 * i + crow(e, hh)) * 128 + 32 * j + r] : 0.f;
    v2f gx[8]; unsigned qx[8], vx[8];
#define HG_LOAD(c) do { _Pragma("unroll") for (int i = 0; i < 8; ++i) { const int t = 8 * seg + i; const size_t row = (size_t)row0 + 64 * (c) + t; \
        if (t < T) { gx[i] = *(const v2f*)(G + row * 1024 + h * 128 + 2 * dkp); qx[i] = *(const unsigned*)(P + row * NIN + C_QB + h * 128 + 2 * dkp); vx[i] = *(const unsigned*)(P + row * NIN + C_IB + h * 128 + 2 * dkp); } \
        else { gx[i] = (v2f){0.f, 0.f}; qx[i] = 0u; vx[i] = 0u; } } } while (0)
    HG_LOAD(0);
#pragma unroll 1
    for (int c = 0; c < NC; ++c) {
        float b0[8], b1[8]; float a0 = 0.f, a1 = 0.f;
#pragma unroll
        for (int i = 0; i < 8; ++i) { a0 += gx[i].x; a1 += gx[i].y; b0[i] = a0; b1[i] = a1; }
        *(LAS v2f*)(lds + OFF_SEG + (seg * 128 + 2 * dkp) * 4) = (v2f){a0, a1};
        HG_LBAR();
        float pre0 = 0.f, pre1 = 0.f, mid0 = 0.f, mid1 = 0.f, last0 = 0.f, last1 = 0.f;
#pragma unroll
        for (int sg = 0; sg < 8; ++sg) { const v2f sv = *(const LAS v2f*)(lds + OFF_SEG + (sg * 128 + 2 * dkp) * 4);
            if (sg < seg) { pre0 += sv.x; pre1 += sv.y; } if (sg < 4) { mid0 += sv.x; mid1 += sv.y; } last0 += sv.x; last1 += sv.y; }
#pragma unroll
        for (int i = 0; i < 8; ++i) {
            const int t = 8 * seg + i;
            const float bb0 = b0[i] + pre0, bb1 = b1[i] + pre1;
            const float k0 = 1.f - fexp2(gx[i].x * LOG2E), k1 = 1.f - fexp2(gx[i].y * LOG2E), q0 = bflo(qx[i]), q1 = bfhi(qx[i]);
            *(LAS unsigned*)(lds + OFF_QT + t * RP + 4 * dkp) = fa::cvtpk(q0 * fexp2((bb0 - mid0) * LOG2E), q1 * fexp2((bb1 - mid1) * LOG2E));
            *(LAS unsigned*)(lds + OFF_KT + t * RP + 4 * dkp) = fa::cvtpk(k0 * fexp2((mid0 - bb0) * LOG2E), k1 * fexp2((mid1 - bb1) * LOG2E));
            *(LAS unsigned*)(lds + OFF_QS + t * RP + 4 * dkp) = fa::cvtpk(q0 * fexp2(bb0 * LOG2E), q1 * fexp2(bb1 * LOG2E));
            *(LAS unsigned*)(lds + OFF_KS + t * RP + 4 * dkp) = fa::cvtpk(k0 * fexp2((last0 - bb0) * LOG2E), k1 * fexp2((last1 - bb1) * LOG2E));
            *(LAS unsigned*)(lds + OFF_V + (dkp >> 4) * 4096 + t * 64 + (dkp & 15) * 4) = vx[i];
        }
        if (seg == 0) *(LAS v2f*)(lds + OFF_DEC + 8 * dkp) = (v2f){fexp2(last0 * LOG2E), fexp2(last1 * LOG2E)};
        if (c + 1 < NC) HG_LOAD(c + 1);
        HG_LBAR();
        f32x16 X[2];
#pragma unroll
        for (int sb = 0; sb < 2; ++sb) {
#pragma unroll
            for (int e = 0; e < 16; ++e) X[sb][e] = 0.f;
            if (sb <= tb) {
#pragma unroll
                for (int d0 = 0; d0 < 8; ++d0) {
                    const bf16x8 ka = *(const LAS bf16x8*)(lds + OFF_KT + (32 * sb + r) * RP + (16 * d0 + 8 * hh) * 2);
                    const bf16x8 qb = *(const LAS bf16x8*)(lds + OFF_QT + (32 * tb + r) * RP + (16 * d0 + 8 * hh) * 2);
                    X[sb] = __builtin_amdgcn_mfma_f32_32x32x16_bf16(ka, qb, X[sb], 0, 0, 0);
                }
                if (sb == tb) {
#pragma unroll
                    for (int e = 0; e < 16; ++e) X[sb][e] = crow(e, hh) > r ? 0.f : X[sb][e];
                }
            }
        }
        f32x16 o;
#pragma unroll
        for (int e = 0; e < 16; ++e) o[e] = 0.f;
        { const LAS unsigned char* vp = lds + OFF_V + j * 4096 + g16 * 32 + p4 * 8 + (4 * hh + q4) * 64;
#pragma unroll
          for (int sb = 0; sb < 2; ++sb) if (sb <= tb) {
#pragma unroll
              for (int s2 = 0; s2 < 2; ++s2) {
                  const bf16x8 pf = pack8(X[sb], 8 * s2);
                  const s16x4 lo = vtr(vp + (32 * sb + 16 * s2) * 64), hi = vtr(vp + (32 * sb + 16 * s2) * 64 + 512);
                  const bf16x8 vf = __builtin_shufflevector(lo, hi, 0, 1, 2, 3, 4, 5, 6, 7);
                  o = __builtin_amdgcn_mfma_f32_32x32x16_bf16(pf, vf, o, 0, 0, 0);
              } } }
#pragma unroll
        for (int i = 0; i < 4; ++i)
#pragma unroll
            for (int s2 = 0; s2 < 2; ++s2) {
                const LAS unsigned char* ap = lds + OFF_QS + (32 * tb + r) * RP + (32 * i + 16 * s2 + 4 * hh) * 2;
                const v2u alo = *(const LAS v2u*)ap, ahi = *(const LAS v2u*)(ap + 16);
                const v4u a4 = {alo.x, alo.y, ahi.x, ahi.y};
                o = __builtin_amdgcn_mfma_f32_32x32x16_bf16(__builtin_bit_cast(bf16x8, a4), pack8(S[i], 8 * s2), o, 0, 0, 0);
            }
#pragma unroll
        for (int e = 0; e < 16; ++e) *(LAS float*)(lds + OFF_OX + ((32 * tb + crow(e, hh)) * 128 + 32 * j + r) * 4) = o[e];
#pragma unroll
        for (int i = 0; i < 4; ++i)
#pragma unroll
            for (int e = 0; e < 16; ++e) S[i][e] *= *(const LAS float*)(lds + OFF_DEC + (32 * i + crow(e, hh)) * 4);
#pragma unroll
        for (int ks = 0; ks < 4; ++ks) {
            const LAS unsigned char* vq = lds + OFF_V + j * 4096 + (16 * ks + 8 * hh + q4) * 64 + g16 * 32 + p4 * 8;
            const s16x4 vlo = vtr(vq), vhi = vtr(vq + 256);
            const bf16x8 vb = __builtin_shufflevector(vlo, vhi, 0, 1, 2, 3, 4, 5, 6, 7);
#pragma unroll
            for (int i = 0; i < 4; ++i) {
                const LAS unsigned char* kq = lds + OFF_KS + (16 * ks + 8 * hh + q4) * RP + (32 * i + 16 * g16 + 4 * p4) * 2;
                const s16x4 klo = vtr(kq), khi = vtr(kq + 4 * RP);
                const bf16x8 ka = __builtin_shufflevector(klo, khi, 0, 1, 2, 3, 4, 5, 6, 7);
                S[i] = __builtin_amdgcn_mfma_f32_32x32x16_bf16(ka, vb, S[i], 0, 0, 0);
            }
        }
        HG_LBAR();
        {
            const int t = tid >> 3, cg = tid & 7;
            const LAS v4f* ox = (const LAS v4f*)(lds + OFF_OX + (t * 128 + 16 * cg) * 4);
            const v4f x0 = ox[0], x1 = ox[1], x2 = ox[2], x3 = ox[3];
            float ss = (x0.x * x0.x + x0.y * x0.y + x0.z * x0.z + x0.w * x0.w) + (x1.x * x1.x + x1.y * x1.y + x1.z * x1.z + x1.w * x1.w)
                     + (x2.x * x2.x + x2.y * x2.y + x2.z * x2.z + x2.w * x2.w) + (x3.x * x3.x + x3.y * x3.y + x3.z * x3.z + x3.w * x3.w);
            ss += __shfl_xor(ss, 1); ss += __shfl_xor(ss, 2); ss += __shfl_xor(ss, 4);
            if (t < T) {
                const float inv = 1.0f / sqrtf(ss * (1.0f / 128.0f) + NORM_EPS);
                const size_t row = (size_t)row0 + 64 * c + t;
                const float* gn = HGRN_NORM + h * 128 + 16 * cg;
                const bf16* ogp = P + row * NIN + C_OG + h * 128 + 16 * cg; bf16* zp = P + row * NIN + C_ZB + h * 128 + 16 * cg;
                float og[16], z[16]; ld8bf(ogp, *(float(*)[8])og); ld8bf(ogp + 8, *(float(*)[8])(og + 8)); ld8bf(zp, *(float(*)[8])z); ld8bf(zp + 8, *(float(*)[8])(z + 8));
                const float xv[16] = {x0.x, x0.y, x0.z, x0.w, x1.x, x1.y, x1.z, x1.w, x2.x, x2.y, x2.z, x2.w, x3.x, x3.y, x3.z, x3.w};
                float y[16];
#pragma unroll
                for (int e = 0; e < 16; ++e) y[e] = xv[e] * inv * gn[e] * og[e] * z[e];
                st8bf(zp, *(float(*)[8])y); st8bf(zp + 8, *(float(*)[8])(y + 8));
            }
        }
    }
    if (tb == 0) {
#pragma unroll
        for (int i = 0; i < 4; ++i)
#pragma unroll
            for (int e = 0; e < 16; ++e) sout[(size_t)(32 * i + crow(e, hh)) * 128 + 32 * j + r] = S[i][e];
    }
    HG_BAR();
#undef HG_LOAD
}
}

namespace ca {
using fa::bf16x8; using fa::s16x4; using fa::f32x16; using fa::crow; using fa::pack8; using fa::vtr;
constexpr int KT = 16384, BUF = 32768, WSF_OFF = RING_BYTES + 1024;
DI void load_tile(LAS unsigned char* buf, const bf16* Kg, const bf16* Vg, int kv0, int wave, int lane) {
#pragma unroll
    for (int i = 0; i < 2; ++i) { const int pc = 2 * wave + i;
        __builtin_amdgcn_global_load_lds((const unsigned*)(Kg + (size_t)(kv0 + (lane & 31)) * 2048 + (2 * pc + (lane >> 5)) * 8), (LAS unsigned*)(buf + pc * 1024), 16, 0, 0); }
#pragma unroll
    for (int i = 0; i < 2; ++i) { const int pc = 2 * wave + i;
        __builtin_amdgcn_global_load_lds((const unsigned*)(Vg + (size_t)(kv0 + 16 * (pc & 1) + (lane >> 2)) * 2048 + (pc >> 1) * 32 + (lane & 3) * 8),
                                         (LAS unsigned*)(buf + KT + (pc >> 1) * 2048 + (pc & 1) * 1024), 16, 0, 0); }
}
DI void cross_unit(Ctx A_, LAS unsigned char* lds, int kvb, int hc, size_t row0, int nrows, int wave, int lane) {
    const int r = lane & 31, hh = lane >> 5, rg = wave & 3, dvh = wave >> 2;
    bf16* P = P_;
    const bf16* Kg = MKV_ + (size_t)kvb * NMEM * 2048 + hc * 256; const bf16* Vg = Kg + 1024;
    LAS float* wsf = (LAS float*)(lds + WSF_OFF) + wave * 128;
    const bool act = rg * 32 < nrows;
    load_tile(lds, Kg, Vg, 0, wave, lane);
    bf16x8 qr[16];
    { const bf16* Qg = P + (row0 + rg * 32 + r) * NIN + C_QC + hc * 256 + hh * 8;
#pragma unroll
      for (int d0 = 0; d0 < 16; ++d0) qr[d0] = *(const bf16x8*)(Qg + d0 * 16); }
    f32x16 o[4];
#pragma unroll
    for (int nb = 0; nb < 4; ++nb)
#pragma unroll
        for (int i = 0; i < 16; ++i) o[nb][i] = 0.f;
    float m = -INFINITY, l = 0.f;
    const int g16 = (lane >> 4) & 1, p4 = lane & 3, q4 = (lane & 15) >> 2;
#pragma unroll 1
    for (int t = 0; t < 8; ++t) {
        asm volatile("s_waitcnt vmcnt(0) lgkmcnt(0)" ::: "memory"); __builtin_amdgcn_s_barrier(); asm volatile("" ::: "memory");
        if (t + 1 < 8) load_tile(lds + ((t + 1) & 1) * BUF, Kg, Vg, (t + 1) * 32, wave, lane);
        if (act) {
            const LAS unsigned char* buf = lds + (t & 1) * BUF;
            const LAS unsigned char* kb = buf + hh * 512 + r * 16;
            f32x16 p0;
#pragma unroll
            for (int i = 0; i < 16; ++i) p0[i] = 0.f;
#pragma unroll
            for (int d0 = 0; d0 < 16; ++d0) p0 = __builtin_amdgcn_mfma_f32_32x32x16_bf16(*(const LAS bf16x8*)(kb + d0 * 1024), qr[d0], p0, 0, 0, 0);
            float tm = p0[0];
#pragma unroll
            for (int i = 1; i < 16; ++i) tm = fmaxf(tm, p0[i]);
            tm = fmaxf(tm, __shfl_xor(tm, 32));
            if (__any(tm > m)) {
                const float mn = fmaxf(m, tm), f = fexp2(m - mn); m = mn; l *= f;
                if (hh == 0) wsf[r] = f;
                float fr[16];
#pragma unroll
                for (int i = 0; i < 16; ++i) fr[i] = wsf[crow(i, hh)];
#pragma unroll
                for (int nb = 0; nb < 4; ++nb)
#pragma unroll
                    for (int i = 0; i < 16; ++i) o[nb][i] *= fr[i];
            }
            float ls = 0.f;
#pragma unroll
            for (int i = 0; i < 16; ++i) { p0[i] = fexp2(p0[i] - m); ls += p0[i]; }
            l += ls;
            const bf16x8 pf0 = pack8(p0, 0), pf1 = pack8(p0, 8);
            const LAS unsigned char* vp = buf + KT + dvh * 8192 + g16 * 32 + p4 * 8 + (4 * hh + q4) * 64;
#pragma unroll
            for (int ks = 0; ks < 2; ++ks)
#pragma unroll
                for (int nb = 0; nb < 4; ++nb) {
                    const s16x4 lo = vtr(vp + nb * 2048 + ks * 1024), hi = vtr(vp + nb * 2048 + ks * 1024 + 512);
                    const bf16x8 vf = __builtin_shufflevector(lo, hi, 0, 1, 2, 3, 4, 5, 6, 7);
                    o[nb] = __builtin_amdgcn_mfma_f32_32x32x16_bf16(ks == 0 ? pf0 : pf1, vf, o[nb], 0, 0, 0);
                }
        }
    }
    if (act) {
        l += __shfl_xor(l, 32);
        if (hh == 0) wsf[32 + r] = l;
        float rl[16];
#pragma unroll
        for (int i = 0; i < 16; ++i) rl[i] = 1.0f / wsf[32 + crow(i, hh)];
#pragma unroll
        for (int nb = 0; nb < 4; ++nb)
#pragma unroll
            for (int i = 0; i < 16; ++i) {
                const int q = rg * 32 + crow(i, hh);
                if (q < nrows) { bf16* zp = P + (row0 + q) * NIN + C_ZC + hc * 256 + dvh * 128 + nb * 32 + r; *zp = (bf16)f2bf(o[nb][i] * rl[i] * bf2f(*zp)); }
            }
    }
    asm volatile("s_waitcnt vmcnt(0) lgkmcnt(0)" ::: "memory"); __builtin_amdgcn_s_barrier(); asm volatile("" ::: "memory");
}
}

namespace da {
using fa::bf16x8; using fa::s16x4; using fa::f32x16; using fa::crow; using fa::pack8; using fa::vtr;
constexpr int CS = 528, KR = 16 * CS, PS = 2080, VR = 4 * PS, VOFF = 34816, WSF_OFF = RING_BYTES + 1024;
constexpr int EX_OFF = 0, MX_OFF = 65536, LX_OFF = 65536 + 1024, X2_OFF = 65536 + 2048;
static_assert(VOFF >= 4 * KR && VOFF + 4 * VR <= RING_BYTES && X2_OFF + 8192 <= RING_BYTES, "decode lds map");
#define DA_BAR() do { asm volatile("s_waitcnt lgkmcnt(0)" ::: "memory"); __builtin_amdgcn_s_barrier(); asm volatile("" ::: "memory"); } while (0)
DI void decode_unit(Ctx A_, LAS unsigned char* lds, int b, int h, float lam, int wave, int lane, int tid) {
    const int r = lane & 31, hh = lane >> 5, mp = wave >> 2, kr = wave & 3;
    bf16* P = P_;
    LAS float* wsf = (LAS float*)(lds + WSF_OFF) + wave * 128;
    const float* Kc = CACHE_K + ((size_t)b * PAST * 8 + h) * 128; const float* Vc = CACHE_V + ((size_t)b * PAST * 8 + h) * 128;
    const size_t rowq = (size_t)MP + b * DS;
    v4f kx[8], vx[8];
    const unsigned voff = (unsigned)((tid >> 5) * 1024 + (tid & 31) * 4);
#define DA_LOAD(st) do { const float* kb_ = Kc + (size_t)(st) * 131072; const float* vb_ = Vc + (size_t)(st) * 131072; \
        _Pragma("unroll") for (int i = 0; i < 8; ++i) { kx[i] = *(const v4f*)(kb_ + i * 16384 + voff); vx[i] = *(const v4f*)(vb_ + i * 16384 + voff); } } while (0)
    DA_LOAD(0);
    const int c4_ = tid & 31, kk_ = tid >> 5;
    LAS unsigned char* kw = lds + (c4_ >> 1) * CS + kk_ * 16 + (c4_ & 1) * 8;
    LAS unsigned char* vw = lds + VOFF + (c4_ >> 3) * PS + kk_ * 64 + (c4_ & 7) * 8;
    bf16x8 qr[4];
    { const bf16* Qg = P + (rowq + (r & 15)) * NIN + C_QA + h * 128 + mp * 64 + hh * 8;
#pragma unroll
      for (int d0 = 0; d0 < 4; ++d0) { const v4u w = *(const v4u*)(Qg + d0 * 16); const v4u z = {0u, 0u, 0u, 0u}; qr[d0] = __builtin_bit_cast(bf16x8, r < 16 ? w : z); } }
    f32x16 o[4];
#pragma unroll
    for (int nb = 0; nb < 4; ++nb)
#pragma unroll
        for (int i = 0; i < 16; ++i) o[nb][i] = 0.f;
    float m = -INFINITY, l = 0.f;
    const int g16 = (lane >> 4) & 1, p4 = lane & 3, q4 = (lane & 15) >> 2;
#pragma unroll 1
    for (int st = 0; st <= PAST / 128; ++st) {
        const bool last = st == PAST / 128;
        v4u nw = {0u, 0u, 0u, 0u};
        if (last) {
            const int t2 = tid & 255, key = t2 >> 4, c8 = t2 & 15;
            nw = *(const v4u*)(P + (rowq + key) * NIN + (tid < 256 ? C_KA : C_VA) + h * 128 + c8 * 8);
        }
        DA_BAR();
        if (!last) {
#pragma unroll
            for (int i = 0; i < 8; ++i) {
                *(LAS v2u*)(kw + (i >> 1) * KR + (i & 1) * 256) = (v2u){fa::cvtpk(kx[i].x, kx[i].y), fa::cvtpk(kx[i].z, kx[i].w)};
                *(LAS v2u*)(vw + (i >> 1) * VR + (i & 1) * 1024) = (v2u){fa::cvtpk(vx[i].x, vx[i].y), fa::cvtpk(vx[i].z, vx[i].w)}; }
            if (st + 1 < PAST / 128) DA_LOAD(st + 1);
        } else {
            const int t2 = tid & 255, key = t2 >> 4, c8 = t2 & 15;
            if (tid < 256) *(LAS v4u*)(lds + c8 * CS + key * 16) = nw;
            else *(LAS v4u*)(lds + VOFF + (c8 >> 2) * PS + key * 64 + (c8 & 3) * 16) = nw;
        }
        DA_BAR();
        if (!last || kr == 0) {
            const LAS unsigned char* kb = lds + kr * KR + (mp * 8 + hh) * CS + r * 16;
            f32x16 p0;
#pragma unroll
            for (int i = 0; i < 16; ++i) p0[i] = 0.f;
#pragma unroll
            for (int d0 = 0; d0 < 4; ++d0) p0 = __builtin_amdgcn_mfma_f32_32x32x16_bf16(*(const LAS bf16x8*)(kb + d0 * 2 * CS), qr[d0], p0, 0, 0, 0);
            if (last) {
#pragma unroll
                for (int i = 8; i < 16; ++i) p0[i] = -INFINITY;
            }
            float tm = p0[0];
#pragma unroll
            for (int i = 1; i < 16; ++i) tm = fmaxf(tm, p0[i]);
            tm = fmaxf(tm, __shfl_xor(tm, 32));
            if (__any(tm > m)) {
                const float mn = fmaxf(m, tm), f = fexp2(m - mn); m = mn; l *= f;
                if (hh == 0) wsf[r] = f;
                float fr[16];
#pragma unroll
                for (int i = 0; i < 16; ++i) fr[i] = wsf[crow(i, hh)];
#pragma unroll
                for (int nb = 0; nb < 4; ++nb)
#pragma unroll
                    for (int i = 0; i < 16; ++i) o[nb][i] *= fr[i];
            }
            float ls = 0.f;
#pragma unroll
            for (int i = 0; i < 16; ++i) { p0[i] = fexp2(p0[i] - m); ls += p0[i]; }
            l += ls;
            const bf16x8 pf0 = pack8(p0, 0), pf1 = pack8(p0, 8);
            const LAS unsigned char* vp = lds + VOFF + kr * VR + g16 * 32 + p4 * 8 + (4 * hh + q4) * 64;
#pragma unroll
            for (int ks = 0; ks < 2; ++ks)
#pragma unroll
                for (int nb = 0; nb < 4; ++nb) {
                    const s16x4 lo = vtr(vp + nb * PS + ks * 1024), hi = vtr(vp + nb * PS + ks * 1024 + 512);
                    const bf16x8 vf = __builtin_shufflevector(lo, hi, 0, 1, 2, 3, 4, 5, 6, 7);
                    o[nb] = __builtin_amdgcn_mfma_f32_32x32x16_bf16(ks == 0 ? pf0 : pf1, vf, o[nb], 0, 0, 0);
                }
        }
    }
    l += __shfl_xor(l, 32);
    DA_BAR();
    LAS float* MX = (LAS float*)(lds + MX_OFF); LAS float* LX = (LAS float*)(lds + LX_OFF); LAS float* EX = (LAS float*)(lds + EX_OFF);
    if (hh == 0) MX[wave * 32 + r] = m;
    DA_BAR();
    { const float mg = fmaxf(fmaxf(MX[(mp * 4 + 0) * 32 + r], MX[(mp * 4 + 1) * 32 + r]), fmaxf(MX[(mp * 4 + 2) * 32 + r], MX[(mp * 4 + 3) * 32 + r]));
      const float f = fexp2(m - mg); l *= f;
      if (hh == 0) { wsf[r] = f; LX[wave * 32 + r] = l; }
      float fr[8];
#pragma unroll
      for (int i = 0; i < 8; ++i) fr[i] = wsf[crow(i, hh)];
#pragma unroll
      for (int nb = 0; nb < 4; ++nb)
#pragma unroll
          for (int i = 0; i < 8; ++i) EX[wave * 2048 + (nb * 8 + i) * 64 + lane] = o[nb][i] * fr[i]; }
    DA_BAR();
    float acc[4][8];
    if (kr == 0) {
        float li[8];
#pragma unroll
        for (int i = 0; i < 8; ++i) { const int q = crow(i, hh); li[i] = (mp == 0 ? 1.0f : lam) / ((LX[(mp * 4 + 0) * 32 + q] + LX[(mp * 4 + 1) * 32 + q]) + (LX[(mp * 4 + 2) * 32 + q] + LX[(mp * 4 + 3) * 32 + q])); }
#pragma unroll
        for (int nb = 0; nb < 4; ++nb)
#pragma unroll
            for (int i = 0; i < 8; ++i) { const int e = (nb * 8 + i) * 64 + lane;
                acc[nb][i] = ((EX[(mp * 4 + 0) * 2048 + e] + EX[(mp * 4 + 1) * 2048 + e]) + (EX[(mp * 4 + 2) * 2048 + e] + EX[(mp * 4 + 3) * 2048 + e])) * li[i]; }
        if (mp == 1) {
#pragma unroll
            for (int nb = 0; nb < 4; ++nb)
#pragma unroll
                for (int i = 0; i < 8; ++i) *(LAS float*)(lds + X2_OFF + ((nb * 8 + i) * 64 + lane) * 4) = acc[nb][i];
        }
    }
    DA_BAR();
    if (kr == 0 && mp == 0) {
        float ssq[8];
#pragma unroll
        for (int i = 0; i < 8; ++i) ssq[i] = 0.f;
#pragma unroll
        for (int nb = 0; nb < 4; ++nb)
#pragma unroll
            for (int i = 0; i < 8; ++i) { const float d = acc[nb][i] - *(const LAS float*)(lds + X2_OFF + ((nb * 8 + i) * 64 + lane) * 4); acc[nb][i] = d; ssq[i] += d * d; }
#pragma unroll
        for (int i = 0; i < 8; ++i) { float v = ssq[i];
#pragma unroll
            for (int x = 1; x < 32; x <<= 1) v += __shfl_xor(v, x);
            ssq[i] = ONE_M_LAMINIT / sqrtf(v * (1.0f / 128.0f) + NORM_EPS); }
#pragma unroll
        for (int nb = 0; nb < 4; ++nb) { const float sn = SUB_NORM[nb * 32 + r];
#pragma unroll
            for (int i = 0; i < 8; ++i) { bf16* zp = P + (rowq + crow(i, hh)) * NIN + C_ZA + h * 128 + nb * 32 + r; *zp = (bf16)f2bf(acc[nb][i] * ssq[i] * sn * bf2f(*zp)); } }
    }
    DA_BAR();
#undef DA_LOAD
}
}

__global__ void __launch_bounds__(512, 2) fwd(Args args) {
    extern __shared__ __attribute__((aligned(16))) unsigned char lds_raw[];
    LAS unsigned char* lds = (LAS unsigned char*)lds_raw;
    const int tid = threadIdx.x, lane = tid & 63, wave = __builtin_amdgcn_readfirstlane(tid >> 6);
    const int G = gridDim.x, gw = blockIdx.x * 8 + wave, NGW = G * 8;
    const Args& A_ = args;
    const int lo = args.ph_lo, hi = args.ph_hi;
#define IN(k) (lo <= (k) && (k) < hi)
#define BOTH(k) (IN(k) && IN((k) + 1))

    for (int u = tid; u < (LDS_BYTES - LDSCTL_OFF) / 4; u += 512) ((LAS unsigned*)(lds + LDSCTL_OFF))[u] = 0u;
    __syncthreads();
    XcdBarrier bar; bar.bar = (unsigned*)WS_(WS_CTL) + CW_BAR + args.li * XCD_BAR_WORDS; bar.x = 0; bar.st = nullptr;
    if (hi - lo > 1) bar = xcd_barrier_post((unsigned*)WS_(WS_CTL) + CW_BAR + args.li * XCD_BAR_WORDS, (volatile LAS unsigned*)(lds + MISC_OFF) + 8);

    if (IN(0)) {
        LAS float* scr = (LAS float*)(lds + wave * 16384);
        constexpr int I_IN = 32 * 544, I_MK = 32 * 32, I_BR = 16 * 64, I_O = 32 * 64;
        constexpr int NIT = I_IN + 2 * I_MK + 3 * I_BR + I_O;
        for (int it = gw; it < NIT; it += NGW) {
            int r = it;
            if (r < I_IN) { p0_transpose_item(W_IN, D, NIN, WT_, 0, scr, r, lane); continue; } r -= I_IN;
            if (r < I_MK) { p0_transpose_item(W_MEM_K, D, 1024, WT_, NIN, scr, r, lane); continue; } r -= I_MK;
            if (r < I_MK) { p0_transpose_item(W_MEM_V, D, 1024, WT_, NIN + 1024, scr, r, lane); continue; } r -= I_MK;
            if (r < I_BR) { p0_transpose_item(W_A, 1024, D, WABC_, 0, scr, r, lane); continue; } r -= I_BR;
            if (r < I_BR) { p0_transpose_item(W_B, 1024, D, WABC_, 2048, scr, r, lane); continue; } r -= I_BR;
            if (r < I_BR) { p0_transpose_item(W_C, 1024, D, WABC_, 4096, scr, r, lane); continue; } r -= I_BR;
            p0_transpose_item(W_OUT, D, D, WO_, 0, scr, r, lane);
        }
        for (int m = gw; m < M + 2048; m += NGW) {
            const float* src = m < MP ? X_PROMPT + (size_t)m * D : (m < M ? X_SAMPLE + (size_t)(m - MP) * D : MEM_PROMPT + (size_t)(m - M) * D);
            p0_row_to_bf16(src, XB_ + (size_t)m * D, lane);
        }
        for (int i = blockIdx.x * 512 + tid; i < (PAST + DS) * 8; i += G * 512) p0_rope_entry(ROPE_, i);
        for (int it = gw; it < DB * NMEM * 2; it += NGW) {
            const int row = it >> 1, kv = it & 1;
            const v4f* src = (const v4f*)((kv ? CACHE_MV : CACHE_MK) + (size_t)row * 1024) + lane; v2u* dst = (v2u*)(MKV_ + (size_t)(2048 + row) * 2048 + kv * 1024) + lane;
#pragma unroll
            for (int j = 0; j < 4; ++j) { const v4f v = src[64 * j]; dst[64 * j] = (v2u){pk2(v.x, v.y), pk2(v.z, v.w)}; }
        }
        if (BOTH(0)) xcd_barrier(bar);
    }

    if (IN(1)) {
        pg8::GemmT<0, 0, 0> g{(const char*)XB_, (const char*)WT_, D, D, D, 0};
        InProjOrder S{G, (int)blockIdx.x};
        EpiIn E{P_, G_, OUT_, MKV_, LB_LOGITS, ROPE_};
        pg8::gemm_phase<EpiIn, InProjOrder, true, true>(lds, g, S, E);
        if (BOTH(1)) xcd_barrier(bar);
    }

    if (IN(2)) {
        const float lam = lam_of(A_, lane);
        fa::attn_phase(A_, lds, G, (int)blockIdx.x, lam, wave, lane);
#pragma unroll 1
        for (int u = (int)blockIdx.x; u < 64 + 256; u += G) {
            if (u < 64) hg::hgrn_unit(A_, lds, (u >> 3) * SEQ, 64, SEQ / 64, u & 7, nullptr, OUT_ + O_HP + (size_t)u * 16384, wave, lane, tid);
            else { const int s = u - 64; hg::hgrn_unit(A_, lds, MP + (s >> 3) * DS, DS, 1, s & 7, STATE_HGRN + (size_t)s * 16384, OUT_ + O_HS + (size_t)s * 16384, wave, lane, tid); }
        }
#pragma unroll 1
        for (int u = (int)blockIdx.x; u < DB * 8; u += G) da::decode_unit(A_, lds, u >> 3, u & 7, lam, wave, lane, tid);
#pragma unroll 1
        for (int u = (int)blockIdx.x; u < 1024 + 128; u += G) {
            if (u < 1024) { const int qb = u & 31, hc = (u >> 5) & 3, b = u >> 7; ca::cross_unit(A_, lds, b, hc, (size_t)b * SEQ + qb * 128, 128, wave, lane); }
            else { const int s = u - 1024, hc = s & 3, b = s >> 2; ca::cross_unit(A_, lds, 8 + b, hc, (size_t)MP + b * DS, DS, wave, lane); }
        }
        if (BOTH(2)) xcd_barrier(bar);
    }

    if (IN(3)) {
        pg8::GemmT<C_ZA, C_ZB, C_ZC> g{(const char*)P_, (const char*)WABC_, NIN, 1024, 1024, (size_t)2048 * 1024 * 2};
        MergeOrder S{G, (int)blockIdx.x};
        EpiMerge E{P_, MG_};
        pg8::gemm_phase<EpiMerge, MergeOrder, true, true>(lds, g, S, E);
        if (BOTH(3)) xcd_barrier(bar);
    }

    if (IN(4)) {
        pg8::GemmT<0, 0, 0> g{(const char*)MG_, (const char*)WO_, D, D, D, 0};
        OutOrder S{G, (int)blockIdx.x};
        EpiOut E{X_PROMPT, X_SAMPLE, OUT_};
        pg8::gemm_phase<EpiOut, OutOrder, true, true>(lds, g, S, E);
        if (BOTH(4)) xcd_barrier(bar);
    }

    if (IN(5)) { for (int m = gw; m < M; m += NGW) ln_row(A_, m, lane); }
#undef IN
#undef BOTH
}

extern "C" void kernel_launch(void* const* d_in, const int* in_sizes, int n_in, void* d_out, int out_size, void* d_ws, size_t ws_size, hipStream_t stream) {
    static int grid = 0;
    if (grid == 0) {
        if (n_in != 24 || (size_t)out_size != O_END || ws_size < WS_END) { fprintf(stderr, "kernel_launch: unexpected shapes (n_in %d out %d ws %zu, need ws %zu); nothing launched\n", n_in, out_size, ws_size, (size_t)WS_END); grid = -1; return; }
        int dev = 0, cus = 0;
        if (hipGetDevice(&dev) != hipSuccess || hipDeviceGetAttribute(&cus, hipDeviceAttributeMultiprocessorCount, dev) != hipSuccess) { grid = -1; return; }
        if (hipFuncSetAttribute((const void*)fwd, hipFuncAttributeMaxDynamicSharedMemorySize, LDS_BYTES) != hipSuccess) { fprintf(stderr, "kernel_launch: hipFuncSetAttribute failed\n"); grid = -1; return; }
        grid = cus > 0 ? cus : 256;
    }
    if (grid < 0) return;
    if (hipMemsetAsync((char*)d_ws + WS_CTL, 0, CTL_ZERO_BYTES, stream) != hipSuccess) return;
    Args a{};
    for (int i = 0; i < 24; ++i) a.in[i] = (const float*)d_in[i];
    a.out = (float*)d_out; a.ws = (unsigned char*)d_ws;
    a.ph_lo = 0; a.ph_hi = 6; a.li = 0; hipLaunchKernelGGL(fwd, dim3(grid), dim3(512), LDS_BYTES, stream, a);
    const hipError_t le = hipPeekAtLastError();
    if (le != hipSuccess) fprintf(stderr, "kernel_launch: launch failed: %s\n", hipGetErrorName(le));
}
```

```cpp
#include <hip/hip_runtime.h>
#include <cstdio>
#include <cstdint>

#define GAS __attribute__((address_space(1)))
#define LAS __attribute__((address_space(3)))
typedef unsigned short bf16;
typedef unsigned v4u __attribute__((ext_vector_type(4)));
typedef unsigned v2u __attribute__((ext_vector_type(2)));
typedef float v4f __attribute__((ext_vector_type(4)));
typedef float v2f __attribute__((ext_vector_type(2)));
#define DI __device__ __forceinline__

constexpr int D = 2048, NB = 8, SEQ = 4096, MP = NB * SEQ, DB = 32, DS = 16, MS = DB * DS, M = MP + MS, PAST = 4096, NMEM = 256;
constexpr int NIN = 17408;
constexpr int C_QA = 0, C_KA = 1024, C_VA = 2048, C_ZA = 3072, C_QB = 4096, C_FB = 5120, C_IB = 6144, C_OG = 7168, C_ZB = 8192, C_QC = 9216, C_ZC = 10240, C_GA = 11264, C_GB = 13312, C_GC = 15360;
constexpr int YLD = 3072, C_YA = 0, C_YB = 1024, C_YC = 2048;
constexpr float LOG2E = 1.4426950408889634f, LN2 = 0.6931471805599453f;
constexpr float QA_SCALE = 0.125f * LOG2E, QC_SCALE = 0.0625f * LOG2E;
constexpr float DN_ALPHA = 1.189207115002721f, NORM_EPS = 1e-5f, ONE_M_LAMINIT = 0.8f, LAM_INIT = 0.2f;
constexpr size_t O_YP = 0, O_YS = (size_t)MP * D, O_KP = O_YS + (size_t)MS * D, O_VP = O_KP + (size_t)MP * 1024, O_HP = O_VP + (size_t)MP * 1024,
                 O_MK = O_HP + (size_t)NB * 8 * 128 * 128, O_MV = O_MK + (size_t)NB * NMEM * 1024, O_KS = O_MV + (size_t)NB * NMEM * 1024, O_VS = O_KS + (size_t)MS * 1024,
                 O_HS = O_VS + (size_t)MS * 1024, O_END = O_HS + (size_t)DB * 8 * 128 * 128;
static_assert(O_END == 145752064ull, "output size");
constexpr size_t MiB = 1u << 20;
constexpr size_t WS_CTL = 0, CTL_ZERO_BYTES = 1 * MiB, WS_ROPE = 1 * MiB, WS_XB = 2 * MiB, WS_WT = 140 * MiB, WS_WABC = 216 * MiB, WS_WO = 228 * MiB, WS_MKV = 374 * MiB,
                 WS_G = 244 * MiB, WS_OB = 374 * MiB, WS_P = 504 * MiB, WS_END = 1609 * MiB, WS_MG = WS_XB, WS_PRE = WS_G, WS_Y = 1609 * MiB, WS_END2 = 1804 * MiB;
static_assert(WS_XB + (size_t)(M + 2048) * D * 2 <= WS_WT && WS_WT + (size_t)(NIN + 2048) * D * 2 <= WS_WABC && WS_G + (size_t)M * 1024 * 4 <= WS_OB && WS_OB + (size_t)M * 1024 * 4 <= WS_P && WS_P + (size_t)M * NIN * 2 <= WS_END, "ws map");
constexpr int CW_BAR = 4096, CW_QUEUE = 32768;
constexpr int RING_BYTES = 131072, LDSCTL_OFF = RING_BYTES, MISC_OFF = LDSCTL_OFF + 320, LDS_BYTES = 147456;

DI float bf2f(unsigned short u) { return __uint_as_float((unsigned)u << 16); }
DI float bflo(unsigned u) { return __uint_as_float(u << 16); }
DI float bfhi(unsigned u) { return __uint_as_float(u & 0xffff0000u); }
DI unsigned f2bf(float f) { unsigned u = __float_as_uint(f); return (u + 0x7fffu + ((u >> 16) & 1u)) >> 16; }
DI unsigned pk2(float lo, float hi) { return f2bf(lo) | (f2bf(hi) << 16); }
DI float fexp2(float x) { return __builtin_amdgcn_exp2f(x); }
DI float frcp(float x) { return __builtin_amdgcn_rcpf(x); }
DI float sigm(float x) { return frcp(1.0f + fexp2(-x * LOG2E)); }
DI float silu(float x) { return x * sigm(x); }
DI float wave_sum(float v) {
#pragma unroll
    for (int o = 1; o < 64; o <<= 1) v += __shfl_xor(v, o);
    return v;
}
DI float wave_max(float v) {
#pragma unroll
    for (int o = 1; o < 64; o <<= 1) v = fmaxf(v, __shfl_xor(v, o));
    return v;
}

#define XB_TMO      128
#define XB_XCNT(j)  (256  + 64 * (j))
#define XB_XSUB(j)  (1280 + 64 * (j))
#define XB_XGEN(j)  (2304 + 64 * (j))
#define XB_TOP      3328
#define XB_TOPGEN   3392
#define XCD_BAR_WORDS 3456
#define XB_SPIN_CAP (1u << 18)
DI unsigned xb_ld(unsigned* p)              { return __hip_atomic_load(p, __ATOMIC_RELAXED, __HIP_MEMORY_SCOPE_AGENT); }
DI unsigned xb_add(unsigned* p, unsigned v) { return __hip_atomic_fetch_add(p, v, __ATOMIC_RELAXED, __HIP_MEMORY_SCOPE_AGENT); }
DI unsigned xb_xcc_id() { return (unsigned)__builtin_amdgcn_s_getreg((3 << 11) | 20) & 0xFu; }
#define XB_SPIN(cond, bar) do { unsigned _sp = 0; while (cond) { __builtin_amdgcn_s_sleep(1); \
    if ((++_sp & 255u) == 0u) { if (xb_ld(&(bar)[XB_TMO])) break; if (_sp > XB_SPIN_CAP) { atomicAdd(&(bar)[XB_TMO], 1u); break; } } } } while (0)
struct XcdBarrier { unsigned* bar; unsigned x; volatile LAS unsigned* st; };
DI XcdBarrier xcd_barrier_post(unsigned* bar, volatile LAS unsigned* st) {
    XcdBarrier b; b.bar = bar; b.x = xb_xcc_id(); b.st = st;
    if (threadIdx.x == 0) (void)xb_add(&bar[XB_XCNT(b.x)], 1u);
    return b;
}
DI void xcd_barrier_complete(unsigned* bar, unsigned x, unsigned& nloc, unsigned& nx) {
    const unsigned G = gridDim.x * gridDim.y * gridDim.z;
    unsigned sum, cnt, mine, sp = 0u;
    for (;;) {
        sum = 0u; cnt = 0u; mine = 0u;
#pragma unroll
        for (unsigned j = 0; j < 16; ++j) { const unsigned c = xb_ld(&bar[XB_XCNT(j)]); sum += c; cnt += (c > 0u) ? 1u : 0u; mine = (j == x) ? c : mine; }
        if (sum == G) break;
        __builtin_amdgcn_s_sleep(1);
        if ((++sp & 255u) == 0u) { if (xb_ld(&bar[XB_TMO])) break; if (sp > XB_SPIN_CAP) { atomicAdd(&bar[XB_TMO], 1u); break; } }
    }
    nloc = mine > 0u ? mine : 1u; nx = cnt > 0u ? cnt : 1u;
}
DI void xcd_barrier(const XcdBarrier& b) {
    asm volatile("s_waitcnt vmcnt(0)" ::: "memory");
    __syncthreads();
    if (threadIdx.x == 0) {
        unsigned* bar = b.bar;
        __builtin_amdgcn_s_waitcnt(0);
        unsigned nloc = b.st[0], nx = b.st[1];
        if (nloc == 0u) { xcd_barrier_complete(bar, b.x, nloc, nx); b.st[0] = nloc; b.st[1] = nx; }
        const unsigned old = xb_add(&bar[XB_XSUB(b.x)], 1u);
        const unsigned gen = old / nloc;
        if (old + 1u == (gen + 1u) * nloc) {
            __builtin_amdgcn_fence(__ATOMIC_RELEASE, "agent");
            asm volatile("s_waitcnt vmcnt(0)" ::: "memory");
            const unsigned og = xb_add(&bar[XB_TOP], 1u);
            const unsigned tg = og / nx;
            if (og + 1u == (tg + 1u) * nx) xb_add(&bar[XB_TOPGEN], 1u);
            else XB_SPIN(xb_ld(&bar[XB_TOPGEN]) == tg, bar);
            __builtin_amdgcn_fence(__ATOMIC_ACQUIRE, "agent");
            xb_add(&bar[XB_XGEN(b.x)], 1u);
            asm volatile("s_waitcnt vmcnt(0)" ::: "memory");
        } else {
            XB_SPIN(xb_ld(&bar[XB_XGEN(b.x)]) == gen, bar);
            __builtin_amdgcn_fence(__ATOMIC_ACQUIRE, "agent");
            asm volatile("s_waitcnt vmcnt(0)" ::: "memory");
        }
    }
    __syncthreads();
}

#ifdef PROBE_PH
#define PROBE_E0() const unsigned pe0_ = (unsigned)__builtin_amdgcn_s_memrealtime();
#define PROBE_E1(slot) { const unsigned pd_ = (unsigned)__builtin_amdgcn_s_memrealtime() - pe0_; volatile LAS unsigned* pw_ = (volatile LAS unsigned*)(lds + 131072 + 512 + wid * 8 + (slot) * 4); *pw_ = *pw_ + pd_; }
#define PROBE_U0() const unsigned pu0_ = (unsigned)__builtin_amdgcn_s_memrealtime();
#define PROBE_U1(ui) { const unsigned pd_ = (unsigned)__builtin_amdgcn_s_memrealtime() - pu0_; if ((ui) < 8) { volatile LAS unsigned* pw_ = (volatile LAS unsigned*)(lds + 131072 + 640 + wid * 32 + (ui) * 4); *pw_ = pd_; } }
#else
#define PROBE_E0()
#define PROBE_E1(slot)
#define PROBE_U0()
#define PROBE_U1(ui)
#endif
namespace pg8 {
#define PG8_LAS __attribute__((address_space(3)))
typedef unsigned short bf16_t;
typedef short bf16x8 __attribute__((ext_vector_type(8)));
typedef float f32x4 __attribute__((ext_vector_type(4)));
typedef unsigned u32x4 __attribute__((ext_vector_type(4)));
constexpr int BM = 256, BK = 64, HALF = 128, HTB = HALF * BK * 2, STAGE_BYTES = 8 * HTB, NXCD = 8, WGM = 8;
__host__ __device__ __forceinline__ int lds_byte(int r, int c) { const int st = (r >> 4) * 2 + (c >> 5), rr = r & 15, cc = c & 31, ob = rr * 64 + cc * 2; return st * 1024 + (ob ^ (((ob >> 9) & 1) << 5)); }
__host__ __device__ __forceinline__ void stage_rc(int b, int& R, int& C) { const int st = b / 1024, sb = b % 1024, swz = sb ^ (((sb >> 9) & 1) << 5); R = (st >> 1) * 16 + swz / 64; C = (st & 1) * 32 + (swz % 64) / 2; }
__host__ __device__ __forceinline__ int perm32(int rho) { const int n = rho >> 4, i = rho & 15; return 8 * (i >> 2) + 4 * n + (i & 3); }
struct Unit { int pm, pn, br; };
template <int AC0, int AC1, int AC2>
struct GemmT {
    const char* A; const char* Bt; int lda, ldb, K; size_t b_br;
    __device__ __forceinline__ const char* a_ptr(const Unit& u) const { const int ac = u.br == 0 ? AC0 : (u.br == 1 ? AC1 : AC2); return A + ((size_t)u.pm * BM * lda + ac) * 2; }
    __device__ __forceinline__ const char* b_ptr(const Unit& u) const { return Bt + (size_t)u.br * b_br + (size_t)u.pn * BM * ldb * 2; }
};
template <int WGM_ = WGM>
__host__ __device__ __forceinline__ void tile_of(int L, int nM, int nN, int& pm, int& pn) {
    const int nwg = nM * nN; int wgid = L; { const int q = nwg / NXCD, r = nwg % NXCD, xcd = wgid % NXCD, off = wgid / NXCD; wgid = (xcd < r ? xcd * (q + 1) : r * (q + 1) + (xcd - r) * q) + off; }
    const int nig = WGM_ * nN, gid = wgid / nig, fm = gid * WGM_, gsz = (nM - fm) < WGM_ ? (nM - fm) : WGM_;
    pm = fm + ((wgid % nig) % gsz); pn = (wgid % nig) / gsz;
}
__device__ __forceinline__ unsigned cvt_pk_bf16(float lo, float hi) { unsigned r; asm volatile("v_cvt_pk_bf16_f32 %0, %1, %2" : "=v"(r) : "v"(lo), "v"(hi)); return r; }
template <class Epi, class Sched, bool ALIGN_EPI, bool SP2, class Gemm>
__device__ __forceinline__ void gemm_phase(PG8_LAS unsigned char* lds, const Gemm g, const Sched& S, const Epi& E) {
    const int tid = threadIdx.x, wid = __builtin_amdgcn_readfirstlane(tid >> 6), lane = tid & 63, wr = wid >> 2, wc = wid & 3, fr = lane & 15, fq = lane >> 4;
    const int K = g.K, nt = K / BK;
    unsigned voffA[2], voffB[2];
#pragma unroll
    for (int i = 0; i < 2; ++i) { int R, C; stage_rc(tid * 16 + i * 8192, R, C); const int Rb = Epi::PERM ? ((R & ~31) + perm32(R & 31)) : R;
        voffA[i] = (unsigned)(R * g.lda + C) * 2u; voffB[i] = (unsigned)(Rb * g.ldb + C) * 2u; }
    const size_t kstep = (size_t)(BK * 2);
    const size_t hA = (size_t)HALF * g.lda * 2, hB = (size_t)HALF * g.ldb * 2;
    const unsigned ldsw = (unsigned)wid * 1024u;
    const int aoff = lds_byte(wr * 64 + fr, fq * 8), boff = lds_byte(wc * 32 + fr, fq * 8);
#define PG8_SA(b, h) (((b) * 2 + (h)) * HTB)
#define PG8_SB(b, h) ((4 + (b) * 2 + (h)) * HTB)
#define PG8_STAGE(bufoff, gbase, voff) do { _Pragma("unroll") for (int _i = 0; _i < 2; ++_i) \
        __builtin_amdgcn_global_load_lds((const unsigned*)((const char*)(gbase) + (voff)[_i]), (PG8_LAS unsigned*)(lds + (bufoff) + ldsw + _i * 8192), 16, 0, 0); } while (0)
#define PG8_LDA(dst, b, h) do { _Pragma("unroll") for (int m = 0; m < 4; ++m) _Pragma("unroll") for (int k = 0; k < 2; ++k) dst[m][k] = *(const PG8_LAS bf16x8*)(lds + PG8_SA(b, h) + aoff + m * 2048 + k * 1024); } while (0)
#define PG8_LDB(dst, b, h) do { _Pragma("unroll") for (int n = 0; n < 2; ++n) _Pragma("unroll") for (int k = 0; k < 2; ++k) dst[n][k] = *(const PG8_LAS bf16x8*)(lds + PG8_SB(b, h) + boff + n * 2048 + k * 1024); } while (0)
#define PG8_MMA(ai, bj, At, Bt) do { __builtin_amdgcn_s_setprio(1); _Pragma("unroll") for (int m = 0; m < 4; ++m) _Pragma("unroll") for (int n = 0; n < 2; ++n) _Pragma("unroll") for (int k = 0; k < 2; ++k) \
        acc[ai][bj][m][n] = __builtin_amdgcn_mfma_f32_16x16x32_bf16(Bt[n][k], At[m][k], acc[ai][bj][m][n], 0, 0, 0); __builtin_amdgcn_s_setprio(0); } while (0)
#define PG8_WAIT_V(n) asm volatile("s_waitcnt vmcnt(" #n ")" ::: "memory")
#define PG8_WAIT_L(n) asm volatile("s_waitcnt lgkmcnt(" #n ")" ::: "memory")
#define PG8_BAR __builtin_amdgcn_s_barrier()
#define PG8_SCHED __builtin_amdgcn_sched_barrier(0)
    Unit cur, nxt; int ui = 0;
    if (!S.next(0, cur)) return;
    f32x4 acc[2][2][4][2];
#pragma unroll
    for (int a = 0; a < 2; ++a)
#pragma unroll
        for (int b = 0; b < 2; ++b)
#pragma unroll
            for (int m = 0; m < 4; ++m)
#pragma unroll
                for (int n = 0; n < 2; ++n) acc[a][b][m][n] = (f32x4){0.f, 0.f, 0.f, 0.f};
    bf16x8 At[4][2], B0[2][2], B1[2][2];
    const char* cA = g.a_ptr(cur); const char* cB = g.b_ptr(cur);
    S.a_ready(cur);
    if constexpr (SP2) {
        PG8_STAGE(PG8_SB(0, 0), cB, voffB); PG8_STAGE(PG8_SB(0, 1), cB + hB, voffB); PG8_STAGE(PG8_SA(0, 0), cA, voffA); PG8_STAGE(PG8_SA(0, 1), cA + hA, voffA);
        if (wr == 1) PG8_BAR;
        PG8_WAIT_V(2); PG8_BAR;
        PG8_STAGE(PG8_SB(1, 0), cB + kstep, voffB); PG8_STAGE(PG8_SA(1, 0), cA + kstep, voffA); PG8_STAGE(PG8_SB(1, 1), cB + hB + kstep, voffB);
        PG8_WAIT_V(6); PG8_BAR;
    } else {
        PG8_STAGE(PG8_SB(0, 0), cB, voffB); PG8_STAGE(PG8_SA(0, 0), cA, voffA); PG8_STAGE(PG8_SB(0, 1), cB + hB, voffB); PG8_STAGE(PG8_SA(0, 1), cA + hA, voffA);
        if (wr == 1) PG8_BAR;
        PG8_WAIT_V(4); PG8_BAR;
        PG8_STAGE(PG8_SB(1, 0), cB + kstep, voffB); PG8_STAGE(PG8_SA(1, 0), cA + kstep, voffA); PG8_STAGE(PG8_SB(1, 1), cB + hB + kstep, voffB);
        PG8_WAIT_V(6); PG8_BAR;
    }
    for (;;) {
        PROBE_U0()
        const bool has_next = S.next(ui + 1, nxt);
        const char* nA = has_next ? g.a_ptr(nxt) : cA; const char* nB = has_next ? g.b_ptr(nxt) : cB;
        for (int t = 0; t < nt; t += 2) {
            if constexpr (Epi::MIDHOOK) { if (t == 16 || t == 32) { PROBE_E0() E.mid(acc, cur, t, wr, wc, fr, fq); PROBE_E1(1) } }
            const bool last = (t == nt - 2);
            const char* a1 = cA + (size_t)(t + 1) * kstep;
            const char* a2 = last ? nA : cA + (size_t)(t + 2) * kstep; const char* b2 = last ? nB : cB + (size_t)(t + 2) * kstep;
            const char* a3 = a2 + kstep; const char* b3 = b2 + kstep;
            if (last && has_next) S.a_ready(nxt);
            if constexpr (SP2) {
            PG8_LDB(B0, 0, 0); PG8_LDB(B1, 0, 1); PG8_SCHED; PG8_LDA(At, 0, 0); PG8_STAGE(PG8_SA(1, 1), a1 + hA, voffA);
            PG8_WAIT_V(8); PG8_WAIT_L(0); PG8_BAR; PG8_MMA(0, 0, At, B0); PG8_MMA(0, 1, At, B1); PG8_BAR; PG8_SCHED;
            PG8_LDA(At, 0, 1); PG8_STAGE(PG8_SB(0, 0), b2, voffB); PG8_STAGE(PG8_SB(0, 1), b2 + hB, voffB); PG8_STAGE(PG8_SA(0, 0), a2, voffA);
            PG8_WAIT_V(8); PG8_WAIT_L(0); PG8_BAR; PG8_MMA(1, 0, At, B0); PG8_MMA(1, 1, At, B1); PG8_BAR; PG8_SCHED;
            PG8_LDB(B0, 1, 0); PG8_LDB(B1, 1, 1); PG8_SCHED; PG8_LDA(At, 1, 0); PG8_STAGE(PG8_SA(0, 1), a2 + hA, voffA);
            PG8_WAIT_V(8); PG8_WAIT_L(0); PG8_BAR; PG8_MMA(0, 0, At, B0); PG8_MMA(0, 1, At, B1); PG8_BAR; PG8_SCHED;
            PG8_LDA(At, 1, 1); PG8_STAGE(PG8_SB(1, 0), b3, voffB); PG8_STAGE(PG8_SB(1, 1), b3 + hB, voffB); PG8_STAGE(PG8_SA(1, 0), a3, voffA);
            PG8_WAIT_V(8); PG8_WAIT_L(0); PG8_BAR; PG8_MMA(1, 0, At, B0); PG8_MMA(1, 1, At, B1); PG8_BAR; PG8_SCHED;
            } else {
            PG8_LDB(B0, 0, 0); PG8_SCHED; PG8_LDA(At, 0, 0); PG8_STAGE(PG8_SA(1, 1), a1 + hA, voffA);
            PG8_WAIT_L(8); PG8_BAR; PG8_WAIT_L(0); PG8_MMA(0, 0, At, B0); PG8_BAR; PG8_SCHED;
            PG8_LDB(B1, 0, 1); PG8_STAGE(PG8_SB(0, 0), b2, voffB);
            PG8_BAR; PG8_WAIT_L(0); PG8_MMA(0, 1, At, B1); PG8_BAR;
            PG8_LDA(At, 0, 1); PG8_STAGE(PG8_SA(0, 0), a2, voffA);
            PG8_BAR; PG8_WAIT_L(0); PG8_MMA(1, 0, At, B0); PG8_BAR; PG8_SCHED;
            PG8_STAGE(PG8_SB(0, 1), b2 + hB, voffB);
            PG8_WAIT_V(6); PG8_BAR; PG8_MMA(1, 1, At, B1); PG8_BAR;
            PG8_LDB(B0, 1, 0); PG8_SCHED; PG8_LDA(At, 1, 0); PG8_STAGE(PG8_SA(0, 1), a2 + hA, voffA);
            PG8_WAIT_L(8); PG8_BAR; PG8_WAIT_L(0); PG8_MMA(0, 0, At, B0); PG8_BAR; PG8_SCHED;
            PG8_LDB(B1, 1, 1); PG8_STAGE(PG8_SB(1, 0), b3, voffB);
            PG8_BAR; PG8_WAIT_L(0); PG8_MMA(0, 1, At, B1); PG8_BAR;
            PG8_LDA(At, 1, 1); PG8_STAGE(PG8_SA(1, 0), a3, voffA);
            PG8_BAR; PG8_WAIT_L(0); PG8_MMA(1, 0, At, B0); PG8_BAR; PG8_SCHED;
            PG8_STAGE(PG8_SB(1, 1), b3 + hB, voffB);
            PG8_WAIT_V(6); PG8_BAR; PG8_MMA(1, 1, At, B1); PG8_BAR;
            }
        }
        if constexpr (ALIGN_EPI) { if (wr == 0) PG8_BAR; }
        if constexpr (!Epi::AFTER_DRAIN) { PROBE_E0() E(acc, cur, wr, wc, fr, fq); PROBE_E1(0) S.done(cur); }
        PROBE_U1(ui)
        if (!has_next) break;
#pragma unroll
        for (int a = 0; a < 2; ++a)
#pragma unroll
            for (int b = 0; b < 2; ++b)
#pragma unroll
                for (int m = 0; m < 4; ++m)
#pragma unroll
                    for (int n = 0; n < 2; ++n) acc[a][b][m][n] = (f32x4){0.f, 0.f, 0.f, 0.f};
        cur = nxt; cA = nA; cB = nB; ++ui;
        if constexpr (ALIGN_EPI) { if (wr == 1) PG8_BAR; }
    }
    PG8_WAIT_V(0);
    if constexpr (!ALIGN_EPI) { if (wr == 0) PG8_BAR; }
    PG8_BAR;
    if constexpr (Epi::AFTER_DRAIN) { E.fused(acc, cur, wr, wc, fr, fq, lds, wid, lane); S.done(cur); }
#undef PG8_SA
#undef PG8_SB
#undef PG8_STAGE
#undef PG8_LDA
#undef PG8_LDB
#undef PG8_MMA
#undef PG8_WAIT_V
#undef PG8_WAIT_L
#undef PG8_BAR
#undef PG8_SCHED
}
}

struct Args { const float* in[24]; float* out; unsigned char* ws; int ph_lo, ph_hi, li, pad; };
#define IN_(k) (A_.in[k])
#define X_PROMPT IN_(0)
#define X_SAMPLE IN_(1)
#define CACHE_K IN_(2)
#define CACHE_V IN_(3)
#define STATE_HGRN IN_(4)
#define CACHE_MK IN_(5)
#define CACHE_MV IN_(6)
#define MEM_PROMPT IN_(7)
#define W_IN IN_(8)
#define LQ1 IN_(9)
#define LK1 IN_(10)
#define LQ2 IN_(11)
#define LK2 IN_(12)
#define SUB_NORM IN_(13)
#define LB_LOGITS IN_(14)
#define HGRN_NORM IN_(15)
#define W_MEM_K IN_(16)
#define W_MEM_V IN_(17)
#define W_A IN_(18)
#define W_B IN_(19)
#define W_C IN_(20)
#define W_OUT IN_(21)
#define LN_G IN_(22)
#define LN_B IN_(23)
#define OUT_ (A_.out)
#define WS_(off) (A_.ws + (off))
#define XB_ ((bf16*)WS_(WS_XB))
#define WT_ ((bf16*)WS_(WS_WT))
#define WABC_ ((bf16*)WS_(WS_WABC))
#define WO_ ((bf16*)WS_(WS_WO))
#define MKV_ ((bf16*)WS_(WS_MKV))
#define P_ ((bf16*)WS_(WS_P))
#define MG_ ((bf16*)WS_(WS_MG))
#define G_ ((float*)WS_(WS_G))
#define PRE_ ((bf16*)WS_(WS_PRE))
#define Y_ ((bf16*)WS_(WS_Y))
#define OB_ ((float*)WS_(WS_OB))
#define ROPE_ ((v2f*)WS_(WS_ROPE))
typedef const Args& Ctx;

struct InProjOrder {
    int G, c;
    DI bool next(int i, pg8::Unit& u) const {
        const int L = i * G + c; u.br = 0;
        if (L < 130 * 68) { pg8::tile_of(L, 130, 68, u.pm, u.pn); return true; }
        const int l = L - 130 * 68; if (l >= 64) return false;
        u.pm = 130 + (l & 7); u.pn = 68 + (l >> 3); return true;
    }
    DI void a_ready(const pg8::Unit&) const {}
    DI void done(const pg8::Unit&) const {}
};
struct MergeOrder {
    int G, c;
    DI bool next(int i, pg8::Unit& u) const {
        const int T = i * G + c; if (T >= 130 * 8) return false;
        pg8::tile_of<4>(T, 130, 8, u.pm, u.pn); u.br = 0; return true;
    }
    DI void a_ready(const pg8::Unit&) const {}
    DI void done(const pg8::Unit&) const {}
};
struct OutOrder {
    int G, c;
    DI bool next(int i, pg8::Unit& u) const {
        const int L = i * G + c; if (L >= 130 * 8) return false;
        pg8::tile_of<4>(L, 130, 8, u.pm, u.pn); u.br = 0; return true;
    }
    DI void a_ready(const pg8::Unit&) const {}
    DI void done(const pg8::Unit&) const {}
};

DI void st8bf(bf16* p, const float (&v)[8]) {
    v4u w; w.x = pg8::cvt_pk_bf16(v[0], v[1]); w.y = pg8::cvt_pk_bf16(v[2], v[3]); w.z = pg8::cvt_pk_bf16(v[4], v[5]); w.w = pg8::cvt_pk_bf16(v[6], v[7]);
    *(v4u*)p = w;
}
DI void st8f(float* p, const float (&v)[8]) { *(v4f*)p = (v4f){v[0], v[1], v[2], v[3]}; *(v4f*)(p + 4) = (v4f){v[4], v[5], v[6], v[7]}; }
DI void ld8bf(const bf16* p, float (&f)[8]) {
    const v4u w = *(const v4u*)p;
    f[0] = bflo(w.x); f[1] = bfhi(w.x); f[2] = bflo(w.y); f[3] = bfhi(w.y); f[4] = bflo(w.z); f[5] = bfhi(w.z); f[6] = bflo(w.w); f[7] = bfhi(w.w);
}

struct EpiIn {
    static constexpr bool PERM = true, AFTER_DRAIN = false, MIDHOOK = false;
    bf16* P; float* G; float* out; bf16* MKV; const float* lbl; const v2f* rope;
    template <int MODE>
    DI void rows(const pg8::f32x4 (&acc)[2][2][4][2], const pg8::Unit& u, int wr, int wc, int fr, int fq) const {
        const int pn = u.pn, tc0 = wc * 32 + fq * 8;
        float lbv[2][8];
        if constexpr (MODE == 4) {
#pragma unroll
            for (int bj = 0; bj < 2; ++bj) { const int cf = (pn - 20) * 256 + bj * 128 + tc0;
#pragma unroll
                for (int i = 0; i < 8; ++i) lbv[bj][i] = sigm(lbl[cf + i] - lbl[1024 + cf + i]); }
        }
#pragma unroll
        for (int ai = 0; ai < 2; ++ai)
#pragma unroll
            for (int m = 0; m < 4; ++m) {
                const int row = u.pm * 256 + ai * 128 + wr * 64 + m * 16 + fr;
                v2f cs[8];
                if constexpr (MODE <= 1) {
                    const int pos = row < MP ? (row & (SEQ - 1)) : PAST + ((row - MP) & (DS - 1));
                    const v4f* rp = (const v4f*)(rope + (size_t)pos * 8);
#pragma unroll
                    for (int i = 0; i < 4; ++i) { const v4f t = rp[i]; cs[2 * i] = (v2f){t.x, t.y}; cs[2 * i + 1] = (v2f){t.z, t.w}; }
                }
#pragma unroll
                for (int bj = 0; bj < 2; ++bj) {
                    float v[8];
#pragma unroll
                    for (int i = 0; i < 4; ++i) { v[i] = acc[ai][bj][m][0][i]; v[4 + i] = acc[ai][bj][m][1][i]; }
                    const int col = pn * 256 + bj * 128 + tc0;
                    if constexpr (MODE <= 1) {
                        if ((wc & 1) == 0) {
                            const float sgn = fq == 0 ? -1.f : 1.f;
#pragma unroll
                            for (int i = 0; i < 8; ++i) { const float pr = __shfl_xor(v[i], 16); const float r = v[i] * cs[i].x + sgn * pr * cs[i].y; v[i] = fq < 2 ? r : v[i]; }
                        }
                        if constexpr (MODE == 0) {
#pragma unroll
                            for (int i = 0; i < 8; ++i) v[i] *= QA_SCALE;
                        }
                    }
                    if constexpr (MODE == 1 || MODE == 2) {
                        const int cs1 = (pn & 3) * 256 + bj * 128 + tc0;
                        float* dst = row < MP ? out + (MODE == 1 ? O_KP : O_VP) + (size_t)row * 1024 + cs1 : out + (MODE == 1 ? O_KS : O_VS) + (size_t)(row - MP) * 1024 + cs1;
                        st8f(dst, v);
                    }
                    if constexpr (MODE == 3) {
#pragma unroll
                        for (int i = 0; i < 8; ++i) v[i] = silu(v[i]);
                    }
                    if constexpr (MODE == 6) {
#pragma unroll
                        for (int i = 0; i < 8; ++i) v[i] = sigm(v[i]);
                    }
                    if constexpr (MODE == 7) {
#pragma unroll
                        for (int i = 0; i < 8; ++i) v[i] *= QC_SCALE;
                    }
                    if constexpr (MODE == 4) {
                        const int cf = (pn - 20) * 256 + bj * 128 + tc0;
#pragma unroll
                        for (int i = 0; i < 8; ++i) { const float lb = lbv[bj][i]; const float f = lb + (1.f - lb) * sigm(v[i]); v[i] = __builtin_amdgcn_logf(f) * LN2; }
                        st8f(G + (size_t)row * 1024 + cf, v);
                    } else if constexpr (MODE == 8) {
                        const int r = row - M, cm = (pn - 68) * 256 + bj * 128 + tc0;
                        float* dst = cm < 1024 ? out + O_MK + (size_t)r * 1024 + cm : out + O_MV + (size_t)r * 1024 + (cm - 1024);
                        st8f(dst, v);
                        st8bf(MKV + (size_t)r * 2048 + cm, v);
                    } else {
                        st8bf(P + (size_t)row * NIN + col, v);
                    }
                }
            }
    }
    DI void operator()(const pg8::f32x4 (&acc)[2][2][4][2], const pg8::Unit& u, int wr, int wc, int fr, int fq) const {
        const int pn = u.pn;
        int mode;
        if (pn >= 68) mode = 8;
        else if (pn >= 44) mode = 6;
        else { const int seg = pn >> 2; mode = seg == 0 ? 0 : seg == 1 ? 1 : seg == 2 ? 2 : seg == 5 ? 4 : seg == 6 ? 5 : seg == 7 ? 6 : seg == 9 ? 7 : 3; }
        switch (mode) {
            case 0: rows<0>(acc, u, wr, wc, fr, fq); break;
            case 1: rows<1>(acc, u, wr, wc, fr, fq); break;
            case 2: rows<2>(acc, u, wr, wc, fr, fq); break;
            case 3: rows<3>(acc, u, wr, wc, fr, fq); break;
            case 4: rows<4>(acc, u, wr, wc, fr, fq); break;
            case 5: rows<5>(acc, u, wr, wc, fr, fq); break;
            case 6: rows<6>(acc, u, wr, wc, fr, fq); break;
            case 7: rows<7>(acc, u, wr, wc, fr, fq); break;
            default: rows<8>(acc, u, wr, wc, fr, fq); break;
        }
    }
};

struct EpiMerge {
    static constexpr bool PERM = true, AFTER_DRAIN = false, MIDHOOK = true;
    const bf16* P; bf16* MG;
    DI void mid(pg8::f32x4 (&acc)[2][2][4][2], const pg8::Unit& u, int t, int wr, int wc, int fr, int fq) const {
        const int gp = t == 16 ? C_GA : C_GB, gn = t == 16 ? C_GB : C_GC;
        const float plo = t == 16 ? 0.f : 1e-6f, lo = 1e-6f;
        unsigned off0 = (unsigned)((u.pm * 256 + wr * 64 + fr) * NIN + u.pn * 256 + wc * 32 + fq * 8);
        asm volatile("" : "+v"(off0));
#pragma unroll
        for (int ai = 0; ai < 2; ++ai)
#pragma unroll
            for (int mh = 0; mh < 2; ++mh) {
                v4u a[2][2], b[2][2];
#pragma unroll
                for (int m2 = 0; m2 < 2; ++m2) { const unsigned ro = off0 + (unsigned)((ai * 128 + (mh * 2 + m2) * 16) * NIN);
#pragma unroll
                    for (int bj = 0; bj < 2; ++bj) { a[m2][bj] = *(const v4u*)(P + (ro + gp + bj * 128)); b[m2][bj] = *(const v4u*)(P + (ro + gn + bj * 128)); } }
#pragma unroll
                for (int m2 = 0; m2 < 2; ++m2)
#pragma unroll
                    for (int bj = 0; bj < 2; ++bj) { const v4u x = a[m2][bj], y = b[m2][bj];
#define RT(pa, pb) (fmaxf((pa), plo) * frcp(fmaxf((pb), lo)))
                        pg8::f32x4& a0 = acc[ai][bj][mh * 2 + m2][0]; pg8::f32x4& a1 = acc[ai][bj][mh * 2 + m2][1];
                        a0[0] *= RT(bflo(x.x), bflo(y.x)); a0[1] *= RT(bfhi(x.x), bfhi(y.x)); a0[2] *= RT(bflo(x.y), bflo(y.y)); a0[3] *= RT(bfhi(x.y), bfhi(y.y));
                        a1[0] *= RT(bflo(x.z), bflo(y.z)); a1[1] *= RT(bfhi(x.z), bfhi(y.z)); a1[2] *= RT(bflo(x.w), bflo(y.w)); a1[3] *= RT(bfhi(x.w), bfhi(y.w));
#undef RT
                    }
            }
    }
    DI void operator()(const pg8::f32x4 (&acc)[2][2][4][2], const pg8::Unit& u, int wr, int wc, int fr, int fq) const {
        const int tc0 = wc * 32 + fq * 8;
#pragma unroll
        for (int ai = 0; ai < 2; ++ai) {
            v4u gw[4][2];
#pragma unroll
            for (int m = 0; m < 4; ++m) { const int row = u.pm * 256 + ai * 128 + wr * 64 + m * 16 + fr;
#pragma unroll
                for (int bj = 0; bj < 2; ++bj) gw[m][bj] = *(const v4u*)(P + (size_t)row * NIN + C_GC + u.pn * 256 + bj * 128 + tc0); }
#pragma unroll
            for (int m = 0; m < 4; ++m) { const int row = u.pm * 256 + ai * 128 + wr * 64 + m * 16 + fr;
#pragma unroll
                for (int bj = 0; bj < 2; ++bj) { const int col = u.pn * 256 + bj * 128 + tc0;
                    const v4u g = gw[m][bj]; const pg8::f32x4 a0 = acc[ai][bj][m][0], a1 = acc[ai][bj][m][1]; const float lo = 1e-6f;
                    float v[8];
                    v[0] = a0[0] * fmaxf(bflo(g.x), lo); v[1] = a0[1] * fmaxf(bfhi(g.x), lo); v[2] = a0[2] * fmaxf(bflo(g.y), lo); v[3] = a0[3] * fmaxf(bfhi(g.y), lo);
                    v[4] = a1[0] * fmaxf(bflo(g.z), lo); v[5] = a1[1] * fmaxf(bfhi(g.z), lo); v[6] = a1[2] * fmaxf(bflo(g.w), lo); v[7] = a1[3] * fmaxf(bfhi(g.w), lo);
                    st8bf(MG + (size_t)row * D + col, v); } }
        }
    }
};

struct EpiOut {
    static constexpr bool PERM = true, AFTER_DRAIN = false, MIDHOOK = false;
    const float* xp; const float* xs; bf16* pre;
    DI void operator()(const pg8::f32x4 (&acc)[2][2][4][2], const pg8::Unit& u, int wr, int wc, int fr, int fq) const {
        const int tc0 = wc * 32 + fq * 8;
#pragma unroll
        for (int ai = 0; ai < 2; ++ai)
#pragma unroll
            for (int mh = 0; mh < 2; ++mh) {
                v4f xv[2][2][2];
#pragma unroll
                for (int m2 = 0; m2 < 2; ++m2) { const int row = u.pm * 256 + ai * 128 + wr * 64 + (mh * 2 + m2) * 16 + fr;
                    const float* xr = row < MP ? xp + (size_t)row * D : xs + (size_t)(row - MP) * D;
#pragma unroll
                    for (int bj = 0; bj < 2; ++bj)
#pragma unroll
                        for (int n = 0; n < 2; ++n) xv[m2][bj][n] = *(const v4f*)(xr + u.pn * 256 + bj * 128 + tc0 + 4 * n); }
#pragma unroll
                for (int m2 = 0; m2 < 2; ++m2) { const int m = mh * 2 + m2, row = u.pm * 256 + ai * 128 + wr * 64 + m * 16 + fr;
#pragma unroll
                    for (int bj = 0; bj < 2; ++bj) { const int col = u.pn * 256 + bj * 128 + tc0;
                        const v4f x0 = xv[m2][bj][0], x1 = xv[m2][bj][1]; const pg8::f32x4 a0 = acc[ai][bj][m][0], a1 = acc[ai][bj][m][1];
                        const float v[8] = {DN_ALPHA * x0.x + a0[0], DN_ALPHA * x0.y + a0[1], DN_ALPHA * x0.z + a0[2], DN_ALPHA * x0.w + a0[3],
                                            DN_ALPHA * x1.x + a1[0], DN_ALPHA * x1.y + a1[1], DN_ALPHA * x1.z + a1[2], DN_ALPHA * x1.w + a1[3]};
                        st8bf(pre + (size_t)row * D + col, v); } }
            }
    }
};

DI void p0_transpose_item(const float* W, int K, int N, bf16* WT, int row_off, LAS float* scr, int item, int lane, int ldw = 0, int coff = 0) {
    if (ldw == 0) ldw = K;
    const int nblk = N / 32, kb = item / nblk, nb = item % nblk, k0 = 64 * kb, n0 = 32 * nb;
#pragma unroll 8
    for (int i = 0; i < 32; ++i) { const int kk = 2 * i + (lane >> 5); scr[kk * 33 + (lane & 31)] = W[(size_t)(k0 + kk) * N + n0 + (lane & 31)]; }
    asm volatile("s_waitcnt lgkmcnt(0)" ::: "memory");
    const int c = lane & 7;
#pragma unroll
    for (int j = 0; j < 4; ++j) { const int n = (lane >> 3) + 8 * j; const LAS float* s = scr + (8 * c) * 33 + n;
        v4u o; o.x = pk2(s[0 * 33], s[1 * 33]); o.y = pk2(s[2 * 33], s[3 * 33]); o.z = pk2(s[4 * 33], s[5 * 33]); o.w = pk2(s[6 * 33], s[7 * 33]);
        *(v4u*)(WT + (size_t)(row_off + n0 + n) * ldw + coff + k0 + 8 * c) = o; }
    asm volatile("s_waitcnt lgkmcnt(0)" ::: "memory");
}
DI void p0_row_to_bf16(const float* xrow, bf16* orow, int lane) {
    const v4f* xr = (const v4f*)xrow + lane;
    v2u* o8 = (v2u*)orow + lane;
#pragma unroll
    for (int j = 0; j < 8; ++j) { const v4f v = xr[64 * j]; o8[64 * j] = (v2u){pk2(v.x, v.y), pk2(v.z, v.w)}; }
}
DI void p0_rope_entry(v2f* rope, int idx) {
    const int pos = idx >> 3, i = idx & 7;
    const float invf = i == 0 ? 1.0f : i == 1 ? 0.1939227432012558f : i == 2 ? 0.03760603070259094f : i == 3 ? 0.007292664609849453f : i == 4 ? 0.0014142135623842478f
                     : i == 5 ? 0.00027424818836152554f : i == 6 ? 5.318296098266728e-05f : 1.0313386155758053e-05f;
    const float ang = (float)pos * invf;
    const double x = (double)ang, twopi = 6.283185307179586476925286766559;
    const double k = __builtin_rint(x / twopi), r = x - k * twopi, r2 = r * r;
    double c = 1.0, s = 1.0;
#pragma unroll
    for (int n = 17; n >= 1; --n) { c = 1.0 - c * r2 / (double)((2 * n - 1) * (2 * n)); s = 1.0 - s * r2 / (double)((2 * n) * (2 * n + 1)); }
    rope[idx] = (v2f){(float)c, (float)(s * r)};
}

DI void ln_row(Ctx A_, int m, int lane) {
    const v4u* pr = (const v4u*)(PRE_ + (size_t)m * D) + lane;
    float v[4][8]; float s = 0.f;
#pragma unroll
    for (int j = 0; j < 4; ++j) { const v4u w = pr[64 * j];
        v[j][0] = bflo(w.x); v[j][1] = bfhi(w.x); v[j][2] = bflo(w.y); v[j][3] = bfhi(w.y); v[j][4] = bflo(w.z); v[j][5] = bfhi(w.z); v[j][6] = bflo(w.w); v[j][7] = bfhi(w.w);
#pragma unroll
        for (int e = 0; e < 8; ++e) s += v[j][e]; }
    const float mean = wave_sum(s) * (1.0f / D); float s2 = 0.f;
#pragma unroll
    for (int j = 0; j < 4; ++j)
#pragma unroll
        for (int e = 0; e < 8; ++e) { v[j][e] -= mean; s2 += v[j][e] * v[j][e]; }
    const float rstd = 1.0f / sqrtf(wave_sum(s2) * (1.0f / D) + NORM_EPS);
#pragma unroll
    for (int j = 0; j < 4; ++j) { const int c0 = 512 * j + 8 * lane;
        const v4f g0 = *(const v4f*)(LN_G + c0), g1 = *(const v4f*)(LN_G + c0 + 4), b0 = *(const v4f*)(LN_B + c0), b1 = *(const v4f*)(LN_B + c0 + 4);
        float* o = OUT_ + (size_t)m * D + c0;
        *(v4f*)o = (v4f){v[j][0] * rstd * g0.x + b0.x, v[j][1] * rstd * g0.y + b0.y, v[j][2] * rstd * g0.z + b0.z, v[j][3] * rstd * g0.w + b0.w};
        *(v4f*)(o + 4) = (v4f){v[j][4] * rstd * g1.x + b1.x, v[j][5] * rstd * g1.y + b1.y, v[j][6] * rstd * g1.z + b1.z, v[j][7] * rstd * g1.w + b1.w}; }
}


DI float lam_of(Ctx A_, int lane) {
    const float d1 = wave_sum(LQ1[lane] * LK1[lane]), d2 = wave_sum(LQ2[lane] * LK2[lane]);
    return __expf(d1) - __expf(d2) + LAM_INIT;
}
namespace fa {
typedef short bf16x8 __attribute__((ext_vector_type(8)));
typedef short s16x4 __attribute__((ext_vector_type(4)));
typedef float f32x16 __attribute__((ext_vector_type(16)));
typedef float f32x2_t __attribute__((ext_vector_type(2)));
typedef __bf16 bf16x2_t __attribute__((ext_vector_type(2)));
typedef short v4i16_t __attribute__((ext_vector_type(4)));
constexpr int KT = 16384, VT = 16384, BUF = KT + VT, NBUF = 3, WSF_OFF = NBUF * BUF;
DI int crow(int i, int hh) { return (i & 3) + 8 * (i >> 2) + 4 * hh; }
DI unsigned cvtpk(float lo, float hi) { f32x2_t v = {lo, hi}; bf16x2_t b = __builtin_convertvector(v, bf16x2_t); return __builtin_bit_cast(unsigned, b); }
DI bf16x8 pack8(const f32x16& x, int s8) {
    v4u p; p.x = cvtpk(x[s8], x[s8 + 1]); p.y = cvtpk(x[s8 + 2], x[s8 + 3]); p.z = cvtpk(x[s8 + 4], x[s8 + 5]); p.w = cvtpk(x[s8 + 6], x[s8 + 7]);
    return __builtin_bit_cast(bf16x8, p);
}
DI s16x4 vtr(const LAS unsigned char* p) { return __builtin_bit_cast(s16x4, __builtin_amdgcn_ds_read_tr16_b64_v4i16((LAS v4i16_t*)p)); }
DI void load_tile(LAS unsigned char* buf, const bf16* Kg, const bf16* Vg, int kv0, int wave, int lane) {
#pragma unroll
    for (int i = 0; i < 2; ++i) { const int c = 2 * wave + i;
        __builtin_amdgcn_global_load_lds((const unsigned*)(Kg + (size_t)(kv0 + lane) * NIN + c * 8), (LAS unsigned*)(buf + c * 1024), 16, 0, 0); }
#pragma unroll
    for (int i = 0; i < 2; ++i) { const int pc = 2 * wave + i;
        __builtin_amdgcn_global_load_lds((const unsigned*)(Vg + (size_t)(kv0 + 16 * (pc & 3) + (lane >> 2)) * NIN + (pc >> 2) * 32 + (lane & 3) * 8),
                                         (LAS unsigned*)(buf + KT + (pc >> 2) * 4096 + (pc & 3) * 1024), 16, 0, 0); }
}
DI void attn_unit(Ctx A_, LAS unsigned char* lds, int b, int h, int qb, float lam, int wave, int lane) {
    const int r = lane & 31, hh = lane >> 5, mp = wave >> 2, rg = wave & 3;
    bf16* P = P_;
    const size_t rowb = (size_t)b * SEQ;
    const bf16* Kg = P + rowb * NIN + C_KA + h * 128; const bf16* Vg = P + rowb * NIN + C_VA + h * 128;
    const int q0 = qb * 128 + rg * 32;
    const int NT = 2 * qb + 2, NTw = 2 * qb + 1 + (rg >> 1);
    LAS float* wsf = (LAS float*)(lds + WSF_OFF) + wave * 128;
    bf16x8 qr[4];
    { const bf16* Qg = P + (rowb + q0 + r) * NIN + C_QA + h * 128 + mp * 64 + hh * 8;
#pragma unroll
      for (int d0 = 0; d0 < 4; ++d0) qr[d0] = *(const bf16x8*)(Qg + d0 * 16); }
    load_tile(lds, Kg, Vg, 0, wave, lane);
    load_tile(lds + BUF, Kg, Vg, 64, wave, lane);
    f32x16 o[4];
#pragma unroll
    for (int nb = 0; nb < 4; ++nb)
#pragma unroll
        for (int i = 0; i < 16; ++i) o[nb][i] = 0.f;
    float m = -INFINITY, l = 0.f;
    const int g16 = (lane >> 4) & 1, p4 = lane & 3, q4 = (lane & 15) >> 2;
    int slot = 0;
    for (int t = 0; t < NT; ++t) {
        if (t + 1 < NT) asm volatile("s_waitcnt vmcnt(4) lgkmcnt(0)" ::: "memory"); else asm volatile("s_waitcnt vmcnt(0) lgkmcnt(0)" ::: "memory");
        __builtin_amdgcn_s_barrier(); asm volatile("" ::: "memory");
        if (t + 2 < NT) { const int s2 = slot == 0 ? 2 : slot - 1; load_tile(lds + s2 * BUF, Kg, Vg, (t + 2) * 64, wave, lane); }
        if (t < NTw) {
            const LAS unsigned char* buf = lds + slot * BUF;
            const LAS unsigned char* kb = buf + (mp * 8 + hh) * 1024 + r * 16;
            f32x16 p0, p1;
#pragma unroll
            for (int i = 0; i < 16; ++i) { p0[i] = 0.f; p1[i] = 0.f; }
#pragma unroll
            for (int d0 = 0; d0 < 4; ++d0) {
                const bf16x8 k0 = *(const LAS bf16x8*)(kb + d0 * 2048), k1 = *(const LAS bf16x8*)(kb + d0 * 2048 + 512);
                p0 = __builtin_amdgcn_mfma_f32_32x32x16_bf16(k0, qr[d0], p0, 0, 0, 0);
                p1 = __builtin_amdgcn_mfma_f32_32x32x16_bf16(k1, qr[d0], p1, 0, 0, 0);
            }
            float tm = fmaxf(p0[0], p1[0]);
#pragma unroll
            for (int i = 1; i < 16; ++i) tm = fmaxf(tm, fmaxf(p0[i], p1[i]));
            tm = fmaxf(tm, __shfl_xor(tm, 32));
            if (__any(tm > m)) {
                const float mn = fmaxf(m, tm), f = fexp2(m - mn); m = mn; l *= f;
                if (hh == 0) wsf[r] = f;
                float fr[16];
#pragma unroll
                for (int i = 0; i < 16; ++i) fr[i] = wsf[crow(i, hh)];
#pragma unroll
                for (int nb = 0; nb < 4; ++nb)
#pragma unroll
                    for (int i = 0; i < 16; ++i) o[nb][i] *= fr[i];
            }
            float ls = 0.f;
#pragma unroll
            for (int i = 0; i < 16; ++i) { p0[i] = fexp2(p0[i] - m); p1[i] = fexp2(p1[i] - m); ls += p0[i] + p1[i]; }
            l += ls;
            bf16x8 pf[4]; pf[0] = pack8(p0, 0); pf[1] = pack8(p0, 8); pf[2] = pack8(p1, 0); pf[3] = pack8(p1, 8);
            const LAS unsigned char* vp = buf + KT + g16 * 32 + p4 * 8 + (4 * hh + q4) * 64;
#pragma unroll
            for (int ks = 0; ks < 4; ++ks)
#pragma unroll
                for (int nb = 0; nb < 4; ++nb) {
                    const s16x4 lo = vtr(vp + nb * 4096 + ks * 1024), hi = vtr(vp + nb * 4096 + ks * 1024 + 512);
                    const bf16x8 vf = __builtin_shufflevector(lo, hi, 0, 1, 2, 3, 4, 5, 6, 7);
                    o[nb] = __builtin_amdgcn_mfma_f32_32x32x16_bf16(pf[ks], vf, o[nb], 0, 0, 0);
                }
        }
        slot = slot == 2 ? 0 : slot + 1;
    }
    l += __shfl_xor(l, 32);
    if (hh == 0) wsf[32 + r] = l;
    float rl[16];
#pragma unroll
    for (int i = 0; i < 16; ++i) rl[i] = 1.0f / wsf[32 + crow(i, hh)];
    const float sc = mp == 0 ? 1.0f : lam;
#pragma unroll
    for (int nb = 0; nb < 4; ++nb)
#pragma unroll
        for (int i = 0; i < 16; ++i) o[nb][i] *= rl[i] * sc;
    asm volatile("s_waitcnt vmcnt(0) lgkmcnt(0)" ::: "memory"); __builtin_amdgcn_s_barrier(); asm volatile("" ::: "memory");
    LAS float* X2 = (LAS float*)lds + rg * 4096 + lane;
    if (mp == 1) {
#pragma unroll
        for (int nb = 0; nb < 4; ++nb)
#pragma unroll
            for (int i = 0; i < 16; ++i) X2[(nb * 16 + i) * 64] = o[nb][i];
    }
    asm volatile("s_waitcnt lgkmcnt(0)" ::: "memory"); __builtin_amdgcn_s_barrier(); asm volatile("" ::: "memory");
    if (mp == 0) {
        float ssq[16];
#pragma unroll
        for (int i = 0; i < 16; ++i) ssq[i] = 0.f;
#pragma unroll
        for (int nb = 0; nb < 4; ++nb)
#pragma unroll
            for (int i = 0; i < 16; ++i) { const float d = o[nb][i] - X2[(nb * 16 + i) * 64]; o[nb][i] = d; ssq[i] += d * d; }
#pragma unroll
        for (int i = 0; i < 16; ++i) {
            float v = ssq[i];
#pragma unroll
            for (int x = 1; x < 32; x <<= 1) v += __shfl_xor(v, x);
            ssq[i] = ONE_M_LAMINIT / sqrtf(v * (1.0f / 128.0f) + NORM_EPS);
        }
#pragma unroll
        for (int nb = 0; nb < 4; ++nb) {
            const float sn = SUB_NORM[nb * 32 + r];
#pragma unroll
            for (int i = 0; i < 16; ++i) {
                const size_t rw = rowb + q0 + crow(i, hh);
                Y_[rw * YLD + C_YA + h * 128 + nb * 32 + r] = (bf16)f2bf(o[nb][i] * ssq[i] * sn * bf2f(P[rw * NIN + C_ZA + h * 128 + nb * 32 + r]));
            }
        }
    }
    asm volatile("s_waitcnt lgkmcnt(0)" ::: "memory"); __builtin_amdgcn_s_barrier(); asm volatile("" ::: "memory");
}
DI void attn_phase(Ctx A_, LAS unsigned char* lds, int G, int c, float lam, int wave, int lane) {
    if (G == 256) {
        const int bh = c >> 2, s = c & 3;
#pragma unroll 1
        for (int i = 0; i < 8; ++i) { const int base = 4 * (i >> 1) + s; const int qb = (i & 1) ? 31 - base : base;
            attn_unit(A_, lds, bh >> 3, bh & 7, qb, lam, wave, lane); }
    } else {
#pragma unroll 1
        for (int u = c; u < 2048; u += G) { const int qb = 31 - (u >> 6), bh = u & 63; attn_unit(A_, lds, bh >> 3, bh & 7, qb, lam, wave, lane); }
    }
}
}

namespace hg {
using fa::bf16x8; using fa::s16x4; using fa::f32x16; using fa::crow; using fa::pack8; using fa::vtr;
constexpr int RP = 272;
constexpr int OFF_QT = 0, OFF_KT = 17408, OFF_QS = 34816, OFF_KS = 52224, OFF_V = 69632, OFF_OX = 86016, OFF_SEG = 118784, OFF_DEC = 122880;
static_assert(OFF_DEC + 512 <= RING_BYTES, "hgrn lds map");
#define HG_BAR() do { asm volatile("s_waitcnt vmcnt(0) lgkmcnt(0)" ::: "memory"); __builtin_amdgcn_s_barrier(); asm volatile("" ::: "memory"); } while (0)
#define HG_LBAR() do { asm volatile("s_waitcnt lgkmcnt(0)" ::: "memory"); __builtin_amdgcn_s_barrier(); asm volatile("" ::: "memory"); } while (0)
DI void hgrn_unit(Ctx A_, LAS unsigned char* lds, int row0, int T, int NC, int h, const float* s0, float* sout, int wave, int lane, int tid) {
    bf16* P = P_; const float* G = G_;
    const int r = lane & 31, hh = lane >> 5, j = wave & 3, tb = wave >> 2;
    const int dkp = tid & 63, seg = wave;
    const int g16 = (lane >> 4) & 1, p4 = lane & 3, q4 = (lane & 15) >> 2;
    f32x16 S[4];
#pragma unroll
    for (int i = 0; i < 4; ++i)
#pragma unroll
        for (int e = 0; e < 16; ++e) S[i][e] = s0 ? s0[(size_t)(32 * i + crow(e, hh)) * 128 + 32 * j + r] : 0.f;
    v2f gx[8]; unsigned qx[8], vx[8];
#define HG_LOAD(c) do { _Pragma("unroll") for (int i = 0; i < 8; ++i) { const int t = 8 * seg + i; const size_t row = (size_t)row0 + 64 * (c) + t; \
        if (t < T) { gx[i] = *(const v2f*)(G + row * 1024 + h * 128 + 2 * dkp); qx[i] = *(const unsigned*)(P + row * NIN + C_QB + h * 128 + 2 * dkp); vx[i] = *(const unsigned*)(P + row * NIN + C_IB + h * 128 + 2 * dkp); } \
        else { gx[i] = (v2f){0.f, 0.f}; qx[i] = 0u; vx[i] = 0u; } } } while (0)
    HG_LOAD(0);
#pragma unroll 1
    for (int c = 0; c < NC; ++c) {
        float b0[8], b1[8]; float a0 = 0.f, a1 = 0.f;
#pragma unroll
        for (int i = 0; i < 8; ++i) { a0 += gx[i].x; a1 += gx[i].y; b0[i] = a0; b1[i] = a1; }
        *(LAS v2f*)(lds + OFF_SEG + (seg * 128 + 2 * dkp) * 4) = (v2f){a0, a1};
        HG_LBAR();
        float pre0 = 0.f, pre1 = 0.f, mid0 = 0.f, mid1 = 0.f, last0 = 0.f, last1 = 0.f;
#pragma unroll
        for (int sg = 0; sg < 8; ++sg) { const v2f sv = *(const LAS v2f*)(lds + OFF_SEG + (sg * 128 + 2 * dkp) * 4);
            if (sg < seg) { pre0 += sv.x; pre1 += sv.y; } if (sg < 4) { mid0 += sv.x; mid1 += sv.y; } last0 += sv.x; last1 += sv.y; }
#pragma unroll
        for (int i = 0; i < 8; ++i) {
            const int t = 8 * seg + i;
            const float bb0 = b0[i] + pre0, bb1 = b1[i] + pre1;
            const float k0 = 1.f - fexp2(gx[i].x * LOG2E), k1 = 1.f - fexp2(gx[i].y * LOG2E), q0 = bflo(qx[i]), q1 = bfhi(qx[i]);
            *(LAS unsigned*)(lds + OFF_QT + t * RP + 4 * dkp) = fa::cvtpk(q0 * fexp2((bb0 - mid0) * LOG2E), q1 * fexp2((bb1 - mid1) * LOG2E));
            *(LAS unsigned*)(lds + OFF_KT + t * RP + 4 * dkp) = fa::cvtpk(k0 * fexp2((mid0 - bb0) * LOG2E), k1 * fexp2((mid1 - bb1) * LOG2E));
            *(LAS unsigned*)(lds + OFF_QS + t * RP + 4 * dkp) = fa::cvtpk(q0 * fexp2(bb0 * LOG2E), q1 * fexp2(bb1 * LOG2E));
            *(LAS unsigned*)(lds + OFF_KS + t * RP + 4 * dkp) = fa::cvtpk(k0 * fexp2((last0 - bb0) * LOG2E), k1 * fexp2((last1 - bb1) * LOG2E));
            *(LAS unsigned*)(lds + OFF_V + (dkp >> 4) * 4096 + t * 64 + (dkp & 15) * 4) = vx[i];
        }
        if (seg == 0) *(LAS v2f*)(lds + OFF_DEC + 8 * dkp) = (v2f){fexp2(last0 * LOG2E), fexp2(last1 * LOG2E)};
        if (c + 1 < NC) HG_LOAD(c + 1);
        HG_LBAR();
        f32x16 X[2];
#pragma unroll
        for (int sb = 0; sb < 2; ++sb) {
#pragma unroll
            for (int e = 0; e < 16; ++e) X[sb][e] = 0.f;
            if (sb <= tb) {
#pragma unroll
                for (int d0 = 0; d0 < 8; ++d0) {
                    const bf16x8 ka = *(const LAS bf16x8*)(lds + OFF_KT + (32 * sb + r) * RP + (16 * d0 + 8 * hh) * 2);
                    const bf16x8 qb = *(const LAS bf16x8*)(lds + OFF_QT + (32 * tb + r) * RP + (16 * d0 + 8 * hh) * 2);
                    X[sb] = __builtin_amdgcn_mfma_f32_32x32x16_bf16(ka, qb, X[sb], 0, 0, 0);
                }
                if (sb == tb) {
#pragma unroll
                    for (int e = 0; e < 16; ++e) X[sb][e] = crow(e, hh) > r ? 0.f : X[sb][e];
                }
            }
        }
        f32x16 o;
#pragma unroll
        for (int e = 0; e < 16; ++e) o[e] = 0.f;
        { const LAS unsigned char* vp = lds + OFF_V + j * 4096 + g16 * 32 + p4 * 8 + (4 * hh + q4) * 64;
#pragma unroll
          for (int sb = 0; sb < 2; ++sb) if (sb <= tb) {
#pragma unroll
              for (int s2 = 0; s2 < 2; ++s2) {
                  const bf16x8 pf = pack8(X[sb], 8 * s2);
                  const s16x4 lo = vtr(vp + (32 * sb + 16 * s2) * 64), hi = vtr(vp + (32 * sb + 16 * s2) * 64 + 512);
                  const bf16x8 vf = __builtin_shufflevector(lo, hi, 0, 1, 2, 3, 4, 5, 6, 7);
                  o = __builtin_amdgcn_mfma_f32_32x32x16_bf16(pf, vf, o, 0, 0, 0);
              } } }
#pragma unroll
        for (int i = 0; i < 4; ++i)
#pragma unroll
            for (int s2 = 0; s2 < 2; ++s2) {
                const LAS unsigned char* ap = lds + OFF_QS + (32 * tb + r) * RP + (32 * i + 16 * s2 + 4 * hh) * 2;
                const v2u alo = *(const LAS v2u*)ap, ahi = *(const LAS v2u*)(ap + 16);
                const v4u a4 = {alo.x, alo.y, ahi.x, ahi.y};
                o = __builtin_amdgcn_mfma_f32_32x32x16_bf16(__builtin_bit_cast(bf16x8, a4), pack8(S[i], 8 * s2), o, 0, 0, 0);
            }
#pragma unroll
        for (int e = 0; e < 16; ++e) *(LAS float*)(lds + OFF_OX + ((32 * tb + crow(e, hh)) * 128 + 32 * j + r) * 4) = o[e];
#pragma unroll
        for (int i = 0; i < 4; ++i)
#pragma unroll
            for (int e = 0; e < 16; ++e) S[i][e] *= *(const LAS float*)(lds + OFF_DEC + (32 * i + crow(e, hh)) * 4);
#pragma unroll
        for (int ks = 0; ks < 4; ++ks) {
            const LAS unsigned char* vq = lds + OFF_V + j * 4096 + (16 * ks + 8 * hh + q4) * 64 + g16 * 32 + p4 * 8;
            const s16x4 vlo = vtr(vq), vhi = vtr(vq + 256);
            const bf16x8 vb = __builtin_shufflevector(vlo, vhi, 0, 1, 2, 3, 4, 5, 6, 7);
#pragma unroll
            for (int i = 0; i < 4; ++i) {
                const LAS unsigned char* kq = lds + OFF_KS + (16 * ks + 8 * hh + q4) * RP + (32 * i + 16 * g16 + 4 * p4) * 2;
                const s16x4 klo = vtr(kq), khi = vtr(kq + 4 * RP);
                const bf16x8 ka = __builtin_shufflevector(klo, khi, 0, 1, 2, 3, 4, 5, 6, 7);
                S[i] = __builtin_amdgcn_mfma_f32_32x32x16_bf16(ka, vb, S[i], 0, 0, 0);
            }
        }
        HG_LBAR();
        {
            const int t = tid >> 3, cg = tid & 7;
            const LAS v4f* ox = (const LAS v4f*)(lds + OFF_OX + (t * 128 + 16 * cg) * 4);
            const v4f x0 = ox[0], x1 = ox[1], x2 = ox[2], x3 = ox[3];
            float ss = (x0.x * x0.x + x0.y * x0.y + x0.z * x0.z + x0.w * x0.w) + (x1.x * x1.x + x1.y * x1.y + x1.z * x1.z + x1.w * x1.w)
                     + (x2.x * x2.x + x2.y * x2.y + x2.z * x2.z + x2.w * x2.w) + (x3.x * x3.x + x3.y * x3.y + x3.z * x3.z + x3.w * x3.w);
            ss += __shfl_xor(ss, 1); ss += __shfl_xor(ss, 2); ss += __shfl_xor(ss, 4);
            if (t < T) {
                const float inv = 1.0f / sqrtf(ss * (1.0f / 128.0f) + NORM_EPS);
                const size_t row = (size_t)row0 + 64 * c + t;
                const float* gn = HGRN_NORM + h * 128 + 16 * cg;
                const bf16* ogp = P + row * NIN + C_OG + h * 128 + 16 * cg; const bf16* zp = P + row * NIN + C_ZB + h * 128 + 16 * cg; bf16* yp = Y_ + row * YLD + C_YB + h * 128 + 16 * cg;
                float og[16], z[16]; ld8bf(ogp, *(float(*)[8])og); ld8bf(ogp + 8, *(float(*)[8])(og + 8)); ld8bf(zp, *(float(*)[8])z); ld8bf(zp + 8, *(float(*)[8])(z + 8));
                const float xv[16] = {x0.x, x0.y, x0.z, x0.w, x1.x, x1.y, x1.z, x1.w, x2.x, x2.y, x2.z, x2.w, x3.x, x3.y, x3.z, x3.w};
                float y[16];
#pragma unroll
                for (int e = 0; e < 16; ++e) y[e] = xv[e] * inv * gn[e] * og[e] * z[e];
                st8bf(yp, *(float(*)[8])y); st8bf(yp + 8, *(float(*)[8])(y + 8));
            }
        }
    }
    if (tb == 0) {
#pragma unroll
        for (int i = 0; i < 4; ++i)
#pragma unroll
            for (int e = 0; e < 16; ++e) sout[(size_t)(32 * i + crow(e, hh)) * 128 + 32 * j + r] = S[i][e];
    }
    HG_BAR();
#undef HG_LOAD
}
}

namespace ca {
using fa::bf16x8; using fa::s16x4; using fa::f32x16; using fa::crow; using fa::pack8; using fa::vtr;
constexpr int KT = 16384, BUF = 32768, WSF_OFF = RING_BYTES + 1024;
DI void load_tile(LAS unsigned char* buf, const bf16* Kg, const bf16* Vg, int kv0, int wave, int lane) {
#pragma unroll
    for (int i = 0; i < 2; ++i) { const int pc = 2 * wave + i;
        __builtin_amdgcn_global_load_lds((const unsigned*)(Kg + (size_t)(kv0 + (lane & 31)) * 2048 + (2 * pc + (lane >> 5)) * 8), (LAS unsigned*)(buf + pc * 1024), 16, 0, 0); }
#pragma unroll
    for (int i = 0; i < 2; ++i) { const int pc = 2 * wave + i;
        __builtin_amdgcn_global_load_lds((const unsigned*)(Vg + (size_t)(kv0 + 16 * (pc & 1) + (lane >> 2)) * 2048 + (pc >> 1) * 32 + (lane & 3) * 8),
                                         (LAS unsigned*)(buf + KT + (pc >> 1) * 2048 + (pc & 1) * 1024), 16, 0, 0); }
}
DI void cross_unit(Ctx A_, LAS unsigned char* lds, int kvb, int hc, size_t row0, int nrows, int wave, int lane) {
    const int r = lane & 31, hh = lane >> 5, rg = wave & 3, dvh = wave >> 2;
    bf16* P = P_;
    const bf16* Kg = MKV_ + (size_t)kvb * NMEM * 2048 + hc * 256; const bf16* Vg = Kg + 1024;
    LAS float* wsf = (LAS float*)(lds + WSF_OFF) + wave * 128;
    const bool act = rg * 32 < nrows;
    load_tile(lds, Kg, Vg, 0, wave, lane);
    bf16x8 qr[16];
    { const bf16* Qg = P + (row0 + rg * 32 + r) * NIN + C_QC + hc * 256 + hh * 8;
#pragma unroll
      for (int d0 = 0; d0 < 16; ++d0) qr[d0] = *(const bf16x8*)(Qg + d0 * 16); }
    f32x16 o[4];
#pragma unroll
    for (int nb = 0; nb < 4; ++nb)
#pragma unroll
        for (int i = 0; i < 16; ++i) o[nb][i] = 0.f;
    float m = -INFINITY, l = 0.f;
    const int g16 = (lane >> 4) & 1, p4 = lane & 3, q4 = (lane & 15) >> 2;
#pragma unroll 1
    for (int t = 0; t < 8; ++t) {
        asm volatile("s_waitcnt vmcnt(0) lgkmcnt(0)" ::: "memory"); __builtin_amdgcn_s_barrier(); asm volatile("" ::: "memory");
        if (t + 1 < 8) load_tile(lds + ((t + 1) & 1) * BUF, Kg, Vg, (t + 1) * 32, wave, lane);
        if (act) {
            const LAS unsigned char* buf = lds + (t & 1) * BUF;
            const LAS unsigned char* kb = buf + hh * 512 + r * 16;
            f32x16 p0;
#pragma unroll
            for (int i = 0; i < 16; ++i) p0[i] = 0.f;
#pragma unroll
            for (int d0 = 0; d0 < 16; ++d0) p0 = __builtin_amdgcn_mfma_f32_32x32x16_bf16(*(const LAS bf16x8*)(kb + d0 * 1024), qr[d0], p0, 0, 0, 0);
            float tm = p0[0];
#pragma unroll
            for (int i = 1; i < 16; ++i) tm = fmaxf(tm, p0[i]);
            tm = fmaxf(tm, __shfl_xor(tm, 32));
            if (__any(tm > m)) {
                const float mn = fmaxf(m, tm), f = fexp2(m - mn); m = mn; l *= f;
                if (hh == 0) wsf[r] = f;
                float fr[16];
#pragma unroll
                for (int i = 0; i < 16; ++i) fr[i] = wsf[crow(i, hh)];
#pragma unroll
                for (int nb = 0; nb < 4; ++nb)
#pragma unroll
                    for (int i = 0; i < 16; ++i) o[nb][i] *= fr[i];
            }
            float ls = 0.f;
#pragma unroll
            for (int i = 0; i < 16; ++i) { p0[i] = fexp2(p0[i] - m); ls += p0[i]; }
            l += ls;
            const bf16x8 pf0 = pack8(p0, 0), pf1 = pack8(p0, 8);
            const LAS unsigned char* vp = buf + KT + dvh * 8192 + g16 * 32 + p4 * 8 + (4 * hh + q4) * 64;
#pragma unroll
            for (int ks = 0; ks < 2; ++ks)
#pragma unroll
                for (int nb = 0; nb < 4; ++nb) {
                    const s16x4 lo = vtr(vp + nb * 2048 + ks * 1024), hi = vtr(vp + nb * 2048 + ks * 1024 + 512);
                    const bf16x8 vf = __builtin_shufflevector(lo, hi, 0, 1, 2, 3, 4, 5, 6, 7);
                    o[nb] = __builtin_amdgcn_mfma_f32_32x32x16_bf16(ks == 0 ? pf0 : pf1, vf, o[nb], 0, 0, 0);
                }
        }
    }
    if (act) {
        l += __shfl_xor(l, 32);
        if (hh == 0) wsf[32 + r] = l;
        float rl[16];
#pragma unroll
        for (int i = 0; i < 16; ++i) rl[i] = 1.0f / wsf[32 + crow(i, hh)];
#pragma unroll
        for (int nb = 0; nb < 4; ++nb)
#pragma unroll
            for (int i = 0; i < 16; ++i) {
                const int q = rg * 32 + crow(i, hh);
                if (q < nrows) { const size_t eo = (row0 + q) * NIN + hc * 256 + dvh * 128 + nb * 32 + r; Y_[(row0 + q) * YLD + C_YC + hc * 256 + dvh * 128 + nb * 32 + r] = (bf16)f2bf(o[nb][i] * rl[i] * bf2f(P[eo + C_ZC])); }
            }
    }
    asm volatile("s_waitcnt vmcnt(0) lgkmcnt(0)" ::: "memory"); __builtin_amdgcn_s_barrier(); asm volatile("" ::: "memory");
}
}

namespace da {
using fa::bf16x8; using fa::s16x4; using fa::f32x16; using fa::crow; using fa::pack8; using fa::vtr;
constexpr int CS = 528, KR = 16 * CS, PS = 2080, VR = 4 * PS, VOFF = 34816, WSF_OFF = RING_BYTES + 1024;
constexpr int EX_OFF = 0, MX_OFF = 65536, LX_OFF = 65536 + 1024, X2_OFF = 65536 + 2048;
static_assert(VOFF >= 4 * KR && VOFF + 4 * VR <= RING_BYTES && X2_OFF + 8192 <= RING_BYTES, "decode lds map");
#define DA_BAR() do { asm volatile("s_waitcnt lgkmcnt(0)" ::: "memory"); __builtin_amdgcn_s_barrier(); asm volatile("" ::: "memory"); } while (0)
DI void decode_unit(Ctx A_, LAS unsigned char* lds, int b, int h, float lam, int wave, int lane, int tid) {
    const int r = lane & 31, hh = lane >> 5, mp = wave >> 2, kr = wave & 3;
    bf16* P = P_;
    LAS float* wsf = (LAS float*)(lds + WSF_OFF) + wave * 128;
    const float* Kc = CACHE_K + ((size_t)b * PAST * 8 + h) * 128; const float* Vc = CACHE_V + ((size_t)b * PAST * 8 + h) * 128;
    const size_t rowq = (size_t)MP + b * DS;
    v4f kx[8], vx[8];
    const unsigned voff = (unsigned)((tid >> 5) * 1024 + (tid & 31) * 4);
#define DA_LOAD(st) do { const float* kb_ = Kc + (size_t)(st) * 131072; const float* vb_ = Vc + (size_t)(st) * 131072; \
        _Pragma("unroll") for (int i = 0; i < 8; ++i) { kx[i] = *(const v4f*)(kb_ + i * 16384 + voff); vx[i] = *(const v4f*)(vb_ + i * 16384 + voff); } } while (0)
    DA_LOAD(0);
    const int c4_ = tid & 31, kk_ = tid >> 5;
    LAS unsigned char* kw = lds + (c4_ >> 1) * CS + kk_ * 16 + (c4_ & 1) * 8;
    LAS unsigned char* vw = lds + VOFF + (c4_ >> 3) * PS + kk_ * 64 + (c4_ & 7) * 8;
    bf16x8 qr[4];
    { const bf16* Qg = P + (rowq + (r & 15)) * NIN + C_QA + h * 128 + mp * 64 + hh * 8;
#pragma unroll
      for (int d0 = 0; d0 < 4; ++d0) { const v4u w = *(const v4u*)(Qg + d0 * 16); const v4u z = {0u, 0u, 0u, 0u}; qr[d0] = __builtin_bit_cast(bf16x8, r < 16 ? w : z); } }
    f32x16 o[4];
#pragma unroll
    for (int nb = 0; nb < 4; ++nb)
#pragma unroll
        for (int i = 0; i < 16; ++i) o[nb][i] = 0.f;
    float m = -INFINITY, l = 0.f;
    const int g16 = (lane >> 4) & 1, p4 = lane & 3, q4 = (lane & 15) >> 2;
#pragma unroll 1
    for (int st = 0; st <= PAST / 128; ++st) {
        const bool last = st == PAST / 128;
        v4u nw = {0u, 0u, 0u, 0u};
        if (last) {
            const int t2 = tid & 255, key = t2 >> 4, c8 = t2 & 15;
            nw = *(const v4u*)(P + (rowq + key) * NIN + (tid < 256 ? C_KA : C_VA) + h * 128 + c8 * 8);
        }
        DA_BAR();
        if (!last) {
#pragma unroll
            for (int i = 0; i < 8; ++i) {
                *(LAS v2u*)(kw + (i >> 1) * KR + (i & 1) * 256) = (v2u){fa::cvtpk(kx[i].x, kx[i].y), fa::cvtpk(kx[i].z, kx[i].w)};
                *(LAS v2u*)(vw + (i >> 1) * VR + (i & 1) * 1024) = (v2u){fa::cvtpk(vx[i].x, vx[i].y), fa::cvtpk(vx[i].z, vx[i].w)}; }
            if (st + 1 < PAST / 128) DA_LOAD(st + 1);
        } else {
            const int t2 = tid & 255, key = t2 >> 4, c8 = t2 & 15;
            if (tid < 256) *(LAS v4u*)(lds + c8 * CS + key * 16) = nw;
            else *(LAS v4u*)(lds + VOFF + (c8 >> 2) * PS + key * 64 + (c8 & 3) * 16) = nw;
        }
        DA_BAR();
        if (!last || kr == 0) {
            const LAS unsigned char* kb = lds + kr * KR + (mp * 8 + hh) * CS + r * 16;
            f32x16 p0;
#pragma unroll
            for (int i = 0; i < 16; ++i) p0[i] = 0.f;
#pragma unroll
            for (int d0 = 0; d0 < 4; ++d0) p0 = __builtin_amdgcn_mfma_f32_32x32x16_bf16(*(const LAS bf16x8*)(kb + d0 * 2 * CS), qr[d0], p0, 0, 0, 0);
            if (last) {
#pragma unroll
                for (int i = 8; i < 16; ++i) p0[i] = -INFINITY;
            }
            float tm = p0[0];
#pragma unroll
            for (int i = 1; i < 16; ++i) tm = fmaxf(tm, p0[i]);
            tm = fmaxf(tm, __shfl_xor(tm, 32));
            if (__any(tm > m)) {
                const float mn = fmaxf(m, tm), f = fexp2(m - mn); m = mn; l *= f;
                if (hh == 0) wsf[r] = f;
                float fr[16];
#pragma unroll
                for (int i = 0; i < 16; ++i) fr[i] = wsf[crow(i, hh)];
#pragma unroll
                for (int nb = 0; nb < 4; ++nb)
#pragma unroll
                    for (int i = 0; i < 16; ++i) o[nb][i] *= fr[i];
            }
            float ls = 0.f;
#pragma unroll
            for (int i = 0; i < 16; ++i) { p0[i] = fexp2(p0[i] - m); ls += p0[i]; }
            l += ls;
            const bf16x8 pf0 = pack8(p0, 0), pf1 = pack8(p0, 8);
            const LAS unsigned char* vp = lds + VOFF + kr * VR + g16 * 32 + p4 * 8 + (4 * hh + q4) * 64;
#pragma unroll
            for (int ks = 0; ks < 2; ++ks)
#pragma unroll
                for (int nb = 0; nb < 4; ++nb) {
                    const s16x4 lo = vtr(vp + nb * PS + ks * 1024), hi = vtr(vp + nb * PS + ks * 1024 + 512);
                    const bf16x8 vf = __builtin_shufflevector(lo, hi, 0, 1, 2, 3, 4, 5, 6, 7);
                    o[nb] = __builtin_amdgcn_mfma_f32_32x32x16_bf16(ks == 0 ? pf0 : pf1, vf, o[nb], 0, 0, 0);
                }
        }
    }
    l += __shfl_xor(l, 32);
    DA_BAR();
    LAS float* MX = (LAS float*)(lds + MX_OFF); LAS float* LX = (LAS float*)(lds + LX_OFF); LAS float* EX = (LAS float*)(lds + EX_OFF);
    if (hh == 0) MX[wave * 32 + r] = m;
    DA_BAR();
    { const float mg = fmaxf(fmaxf(MX[(mp * 4 + 0) * 32 + r], MX[(mp * 4 + 1) * 32 + r]), fmaxf(MX[(mp * 4 + 2) * 32 + r], MX[(mp * 4 + 3) * 32 + r]));
      const float f = fexp2(m - mg); l *= f;
      if (hh == 0) { wsf[r] = f; LX[wave * 32 + r] = l; }
      float fr[8];
#pragma unroll
      for (int i = 0; i < 8; ++i) fr[i] = wsf[crow(i, hh)];
#pragma unroll
      for (int nb = 0; nb < 4; ++nb)
#pragma unroll
          for (int i = 0; i < 8; ++i) EX[wave * 2048 + (nb * 8 + i) * 64 + lane] = o[nb][i] * fr[i]; }
    DA_BAR();
    float acc[4][8];
    if (kr == 0) {
        float li[8];
#pragma unroll
        for (int i = 0; i < 8; ++i) { const int q = crow(i, hh); li[i] = (mp == 0 ? 1.0f : lam) / ((LX[(mp * 4 + 0) * 32 + q] + LX[(mp * 4 + 1) * 32 + q]) + (LX[(mp * 4 + 2) * 32 + q] + LX[(mp * 4 + 3) * 32 + q])); }
#pragma unroll
        for (int nb = 0; nb < 4; ++nb)
#pragma unroll
            for (int i = 0; i < 8; ++i) { const int e = (nb * 8 + i) * 64 + lane;
                acc[nb][i] = ((EX[(mp * 4 + 0) * 2048 + e] + EX[(mp * 4 + 1) * 2048 + e]) + (EX[(mp * 4 + 2) * 2048 + e] + EX[(mp * 4 + 3) * 2048 + e])) * li[i]; }
        if (mp == 1) {
#pragma unroll
            for (int nb = 0; nb < 4; ++nb)
#pragma unroll
                for (int i = 0; i < 8; ++i) *(LAS float*)(lds + X2_OFF + ((nb * 8 + i) * 64 + lane) * 4) = acc[nb][i];
        }
    }
    DA_BAR();
    if (kr == 0 && mp == 0) {
        float ssq[8];
#pragma unroll
        for (int i = 0; i < 8; ++i) ssq[i] = 0.f;
#pragma unroll
        for (int nb = 0; nb < 4; ++nb)
#pragma unroll
            for (int i = 0; i < 8; ++i) { const float d = acc[nb][i] - *(const LAS float*)(lds + X2_OFF + ((nb * 8 + i) * 64 + lane) * 4); acc[nb][i] = d; ssq[i] += d * d; }
#pragma unroll
        for (int i = 0; i < 8; ++i) { float v = ssq[i];
#pragma unroll
            for (int x = 1; x < 32; x <<= 1) v += __shfl_xor(v, x);
            ssq[i] = ONE_M_LAMINIT / sqrtf(v * (1.0f / 128.0f) + NORM_EPS); }
#pragma unroll
        for (int nb = 0; nb < 4; ++nb) { const float sn = SUB_NORM[nb * 32 + r];
#pragma unroll
            for (int i = 0; i < 8; ++i) { const size_t rw = rowq + crow(i, hh); Y_[rw * YLD + C_YA + h * 128 + nb * 32 + r] = (bf16)f2bf(acc[nb][i] * ssq[i] * sn * bf2f(P[rw * NIN + C_ZA + h * 128 + nb * 32 + r])); } }
    }
    DA_BAR();
#undef DA_LOAD
}
}

DI int tid_now() { int t; asm volatile("v_mov_b32 %0, %1" : "=v"(t) : "v"((int)threadIdx.x)); return t; }
__global__ void __launch_bounds__(512, 2) fwd(Args args) {
    extern __shared__ __attribute__((aligned(16))) unsigned char lds_raw[];
    LAS unsigned char* lds = (LAS unsigned char*)lds_raw;
    const int G = gridDim.x, NGW = G * 8;
    const Args& A_ = args;
#define TIDS() const int tid = tid_now(), lane = tid & 63, wave = __builtin_amdgcn_readfirstlane(tid >> 6), gw = blockIdx.x * 8 + wave; (void)lane; (void)gw;
    const int lo = args.ph_lo, hi = args.ph_hi;
#define IN(k) (lo <= (k) && (k) < hi)
#ifdef PROBE_PH
#define PROBE_T0(k) unsigned long long pt0_ = 0; if ((k) == PROBE_PH) pt0_ = __builtin_amdgcn_s_memrealtime();
#define PROBE_SPIN_EPI(code, slot) if ((code) == PROBE_PH) { const unsigned ticks_ = *(volatile LAS unsigned*)(lds + 131072 + 512 + wave * 8 + (slot) * 4); const unsigned long long ps_ = __builtin_amdgcn_s_memrealtime(); while (__builtin_amdgcn_s_memrealtime() - ps_ < ticks_) __builtin_amdgcn_s_sleep(16); }
#define PROBE_SPIN_U(code, slot) if ((code) == PROBE_PH) { const unsigned ticks_ = *(volatile LAS unsigned*)(lds + 131072 + 640 + wave * 32 + (slot) * 4); const unsigned long long ps_ = __builtin_amdgcn_s_memrealtime(); while (__builtin_amdgcn_s_memrealtime() - ps_ < ticks_) __builtin_amdgcn_s_sleep(16); }
#define PROBE_ZERO() { for (int z_ = 0; z_ < 8; ++z_) *(volatile LAS unsigned*)(lds + 131072 + 640 + wave * 32 + z_ * 4) = 0u;  *(volatile LAS unsigned*)(lds + 131072 + 512 + wave * 8) = 0u; *(volatile LAS unsigned*)(lds + 131072 + 512 + wave * 8 + 4) = 0u; }
#define PROBE_T1(k) if ((k) == PROBE_PH) { const unsigned long long pt1_ = __builtin_amdgcn_s_memrealtime(); while (__builtin_amdgcn_s_memrealtime() - pt1_ < pt1_ - pt0_) __builtin_amdgcn_s_sleep(16); }
#else
#define PROBE_T0(k)
#define PROBE_T1(k)
#define PROBE_SPIN_EPI(code, slot)
#define PROBE_SPIN_U(code, slot)
#define PROBE_ZERO()
#endif
#define BOTH(k) (IN(k) && IN((k) + 1))

    for (int u = threadIdx.x; u < (LDS_BYTES - LDSCTL_OFF) / 4; u += 512) ((LAS unsigned*)(lds + LDSCTL_OFF))[u] = 0u;
    __syncthreads();
    XcdBarrier bar; bar.bar = (unsigned*)WS_(WS_CTL) + CW_BAR + args.li * XCD_BAR_WORDS; bar.x = 0; bar.st = nullptr;
    if (hi - lo > 1) bar = xcd_barrier_post((unsigned*)WS_(WS_CTL) + CW_BAR + args.li * XCD_BAR_WORDS, (volatile LAS unsigned*)(lds + MISC_OFF) + 8);

    if (IN(0)) { PROBE_T0(0) TIDS()
        LAS float* scr = (LAS float*)(lds + wave * 16384);
        constexpr int I_IN = 32 * 544, I_MK = 32 * 32, I_BR = 16 * 64, I_O = 32 * 64;
        constexpr int NIT = I_IN + 2 * I_MK + 3 * I_BR + I_O;
        for (int it = gw; it < NIT; it += NGW) {
            int r = it;
            if (r < I_IN) { p0_transpose_item(W_IN, D, NIN, WT_, 0, scr, r, lane); continue; } r -= I_IN;
            if (r < I_MK) { p0_transpose_item(W_MEM_K, D, 1024, WT_, NIN, scr, r, lane); continue; } r -= I_MK;
            if (r < I_MK) { p0_transpose_item(W_MEM_V, D, 1024, WT_, NIN + 1024, scr, r, lane); continue; } r -= I_MK;
            if (r < I_BR) { p0_transpose_item(W_A, 1024, D, WABC_, 0, scr, r, lane, 3072, 0); continue; } r -= I_BR;
            if (r < I_BR) { p0_transpose_item(W_B, 1024, D, WABC_, 0, scr, r, lane, 3072, 1024); continue; } r -= I_BR;
            if (r < I_BR) { p0_transpose_item(W_C, 1024, D, WABC_, 0, scr, r, lane, 3072, 2048); continue; } r -= I_BR;
            p0_transpose_item(W_OUT, D, D, WO_, 0, scr, r, lane);
        }
        for (int m = gw; m < M + 2048; m += NGW) {
            const float* src = m < MP ? X_PROMPT + (size_t)m * D : (m < M ? X_SAMPLE + (size_t)(m - MP) * D : MEM_PROMPT + (size_t)(m - M) * D);
            p0_row_to_bf16(src, XB_ + (size_t)m * D, lane);
        }
        for (int i = blockIdx.x * 512 + tid; i < (PAST + DS) * 8; i += G * 512) p0_rope_entry(ROPE_, i);
        for (int it = gw; it < DB * NMEM * 2; it += NGW) {
            const int row = it >> 1, kv = it & 1;
            const v4f* src = (const v4f*)((kv ? CACHE_MV : CACHE_MK) + (size_t)row * 1024) + lane; v2u* dst = (v2u*)(MKV_ + (size_t)(2048 + row) * 2048 + kv * 1024) + lane;
#pragma unroll
            for (int j = 0; j < 4; ++j) { const v4f v = src[64 * j]; dst[64 * j] = (v2u){pk2(v.x, v.y), pk2(v.z, v.w)}; }
        }
        PROBE_T1(0)
        if (BOTH(0)) xcd_barrier(bar);
    }

    if (IN(1)) {
        pg8::GemmT<0, 0, 0> g{(const char*)XB_, (const char*)WT_, D, D, D, 0};
        InProjOrder S{G, (int)blockIdx.x};
        EpiIn E{P_, G_, OUT_, MKV_, LB_LOGITS, ROPE_};
        { const int wave = __builtin_amdgcn_readfirstlane(threadIdx.x >> 6); (void)wave; PROBE_ZERO() PROBE_T0(1) pg8::gemm_phase<EpiIn, InProjOrder, true, true>(lds, g, S, E); PROBE_T1(1) PROBE_SPIN_EPI(13, 0) }
        if (BOTH(1)) xcd_barrier(bar);
    }

    if (IN(2)) { TIDS()
        const float lam = __int_as_float(__builtin_amdgcn_readfirstlane(__float_as_int(lam_of(A_, lane))));
        PROBE_T0(2)
        unsigned* qctr = (unsigned*)WS_(WS_CTL) + CW_QUEUE;
        volatile LAS unsigned* qw = (volatile LAS unsigned*)(lds + LDSCTL_OFF + 64);
        int qit = 0;
#define Q_NEXT(k, id) do { if (tid == 0) qw[qit & 1] = __hip_atomic_fetch_add(qctr + 64 * (k), 1u, __ATOMIC_RELAXED, __HIP_MEMORY_SCOPE_AGENT); __syncthreads(); \
        id = __builtin_amdgcn_readfirstlane((int)qw[qit & 1]); ++qit; } while (0)
        { PROBE_T0(21)
#pragma unroll 1
        for (;;) { int id; Q_NEXT(0, id); if (id >= 64 + 256) break;
            const bool pr = id < 64; const int sidx = id - 64;
            hg::hgrn_unit(A_, lds, pr ? (id >> 3) * SEQ : MP + (sidx >> 3) * DS, pr ? 64 : DS, pr ? SEQ / 64 : 1, id & 7, pr ? (const float*)nullptr : STATE_HGRN + (size_t)sidx * 16384,
                          pr ? OUT_ + O_HP + (size_t)id * 16384 : OUT_ + O_HS + (size_t)sidx * 16384, wave, lane, tid); }
        PROBE_T1(21) }
        { PROBE_T0(22)
#pragma unroll 1
        for (;;) { int id; Q_NEXT(1, id); if (id >= 256) break; da::decode_unit(A_, lds, id >> 3, id & 7, lam, wave, lane, tid); }
        PROBE_T1(22) }
        { PROBE_T0(20)
#pragma unroll 1
        for (;;) { int id; Q_NEXT(2, id); if (id >= 2048) break; fa::attn_unit(A_, lds, (id & 63) >> 3, id & 7, 31 - (id >> 6), lam, wave, lane); }
        PROBE_T1(20) }
        { PROBE_T0(23)
#pragma unroll 1
        for (;;) { int id; Q_NEXT(3, id); if (id >= 1152) break;
            if (id < 1024) { const int qb = id & 31, hc = (id >> 5) & 3, b = id >> 7; ca::cross_unit(A_, lds, b, hc, (size_t)b * SEQ + qb * 128, 128, wave, lane); }
            else { const int sidx = id - 1024, hc = sidx & 3, b = sidx >> 2; ca::cross_unit(A_, lds, 8 + b, hc, (size_t)MP + b * DS, DS, wave, lane); } }
        PROBE_T1(23) }
#undef Q_NEXT
        PROBE_T1(2)
        if (BOTH(2)) xcd_barrier(bar);
    }

    if (IN(3)) {
        pg8::GemmT<0, 0, 0> g{(const char*)Y_, (const char*)WABC_, YLD, 3072, 3072, 0};
        MergeOrder S{G, (int)blockIdx.x};
        EpiMerge E{P_, MG_};
        { const int wave = __builtin_amdgcn_readfirstlane(threadIdx.x >> 6); (void)wave; PROBE_ZERO() PROBE_T0(3) pg8::gemm_phase<EpiMerge, MergeOrder, true, true>(lds, g, S, E); PROBE_T1(3) PROBE_SPIN_EPI(33, 0) PROBE_SPIN_EPI(34, 1) PROBE_SPIN_U(35, 0) PROBE_SPIN_U(36, 1) PROBE_SPIN_U(37, 2) PROBE_SPIN_U(38, 3) PROBE_SPIN_U(39, 4) }
        if (BOTH(3)) xcd_barrier(bar);
    }

    if (IN(4)) {
        pg8::GemmT<0, 0, 0> g{(const char*)MG_, (const char*)WO_, D, D, D, 0};
        OutOrder S{G, (int)blockIdx.x};
        EpiOut E{X_PROMPT, X_SAMPLE, PRE_};
        { const int wave = __builtin_amdgcn_readfirstlane(threadIdx.x >> 6); (void)wave; PROBE_ZERO() PROBE_T0(4) pg8::gemm_phase<EpiOut, OutOrder, true, true>(lds, g, S, E); PROBE_T1(4) PROBE_SPIN_EPI(43, 0) PROBE_SPIN_U(45, 0) PROBE_SPIN_U(46, 1) PROBE_SPIN_U(47, 2) PROBE_SPIN_U(48, 3) PROBE_SPIN_U(49, 4) }
        if (BOTH(4)) xcd_barrier(bar);
    }

    if (IN(5)) { TIDS() PROBE_T0(5) for (int m = gw; m < M; m += NGW) ln_row(A_, m, lane); PROBE_T1(5) }
#undef IN
#undef BOTH
}

extern "C" void kernel_launch(void* const* d_in, const int* in_sizes, int n_in, void* d_out, int out_size, void* d_ws, size_t ws_size, hipStream_t stream) {
    static int grid = 0;
    if (grid == 0) {
        if (n_in != 24 || (size_t)out_size != O_END || ws_size < WS_END2) { fprintf(stderr, "kernel_launch: unexpected shapes (n_in %d out %d ws %zu, need ws %zu); nothing launched\n", n_in, out_size, ws_size, (size_t)WS_END2); grid = -1; return; }
        int dev = 0, cus = 0;
        if (hipGetDevice(&dev) != hipSuccess || hipDeviceGetAttribute(&cus, hipDeviceAttributeMultiprocessorCount, dev) != hipSuccess) { grid = -1; return; }
        if (hipFuncSetAttribute((const void*)fwd, hipFuncAttributeMaxDynamicSharedMemorySize, LDS_BYTES) != hipSuccess) { fprintf(stderr, "kernel_launch: hipFuncSetAttribute failed\n"); grid = -1; return; }
        grid = cus > 0 ? cus : 256;
    }
    if (grid < 0) return;
    if (hipMemsetAsync((char*)d_ws + WS_CTL, 0, CTL_ZERO_BYTES, stream) != hipSuccess) return;
    Args a{};
    for (int i = 0; i < 24; ++i) a.in[i] = (const float*)d_in[i];
    a.out = (float*)d_out; a.ws = (unsigned char*)d_ws;
    a.ph_lo = 0; a.ph_hi = 6; a.li = 0; hipLaunchKernelGGL(fwd, dim3(grid), dim3(512), LDS_BYTES, stream, a);
    const hipError_t le = hipPeekAtLastError();
    if (le != hipSuccess) fprintf(stderr, "kernel_launch: launch failed: %s\n", hipGetErrorName(le));
}
```

```cpp
#include <hip/hip_runtime.h>
#include <cstdio>
#include <cstdint>

#define GAS __attribute__((address_space(1)))
#define LAS __attribute__((address_space(3)))
typedef unsigned short bf16;
typedef unsigned v4u __attribute__((ext_vector_type(4)));
typedef unsigned v2u __attribute__((ext_vector_type(2)));
typedef float v4f __attribute__((ext_vector_type(4)));
typedef float v2f __attribute__((ext_vector_type(2)));
#define DI __device__ __forceinline__

constexpr int D = 2048, NB = 8, SEQ = 4096, MP = NB * SEQ, DB = 32, DS = 16, MS = DB * DS, M = MP + MS, PAST = 4096, NMEM = 256;
constexpr int NIN = 17408;
constexpr int C_QA = 0, C_KA = 1024, C_VA = 2048, C_ZA = 3072, C_QB = 4096, C_FB = 5120, C_IB = 6144, C_OG = 7168, C_ZB = 8192, C_QC = 9216, C_ZC = 10240, C_GA = 11264, C_GB = 13312, C_GC = 15360;
constexpr int YLD = 3072, C_YA = 0, C_YB = 1024, C_YC = 2048;
constexpr float LOG2E = 1.4426950408889634f, LN2 = 0.6931471805599453f;
constexpr float QA_SCALE = 0.125f * LOG2E, QC_SCALE = 0.0625f * LOG2E;
constexpr float DN_ALPHA = 1.189207115002721f, NORM_EPS = 1e-5f, ONE_M_LAMINIT = 0.8f, LAM_INIT = 0.2f;
constexpr size_t O_YP = 0, O_YS = (size_t)MP * D, O_KP = O_YS + (size_t)MS * D, O_VP = O_KP + (size_t)MP * 1024, O_HP = O_VP + (size_t)MP * 1024,
                 O_MK = O_HP + (size_t)NB * 8 * 128 * 128, O_MV = O_MK + (size_t)NB * NMEM * 1024, O_KS = O_MV + (size_t)NB * NMEM * 1024, O_VS = O_KS + (size_t)MS * 1024,
                 O_HS = O_VS + (size_t)MS * 1024, O_END = O_HS + (size_t)DB * 8 * 128 * 128;
static_assert(O_END == 145752064ull, "output size");
constexpr size_t MiB = 1u << 20;
constexpr size_t WS_CTL = 0, CTL_ZERO_BYTES = 1 * MiB, WS_ROPE = 1 * MiB, WS_XB = 2 * MiB, WS_WT = 140 * MiB, WS_WABC = 216 * MiB, WS_WO = 228 * MiB, WS_MKV = 374 * MiB,
                 WS_G = 244 * MiB, WS_OB = 374 * MiB, WS_P = 504 * MiB, WS_END = 1609 * MiB, WS_MG = WS_XB, WS_PRE = WS_G, WS_Y = 1609 * MiB, WS_KC = 1804 * MiB, WS_VC = 1868 * MiB, WS_END2 = 1932 * MiB;
static_assert(WS_XB + (size_t)(M + 2048) * D * 2 <= WS_WT && WS_WT + (size_t)(NIN + 2048) * D * 2 <= WS_WABC && WS_G + (size_t)M * 1024 * 4 <= WS_OB && WS_OB + (size_t)M * 1024 * 4 <= WS_P && WS_P + (size_t)M * NIN * 2 <= WS_END, "ws map");
constexpr int CW_BAR = 4096, CW_QUEUE = 32768;
constexpr int RING_BYTES = 131072, LDSCTL_OFF = RING_BYTES, MISC_OFF = LDSCTL_OFF + 320, LDS_BYTES = 147456;

DI float bf2f(unsigned short u) { return __uint_as_float((unsigned)u << 16); }
DI float bflo(unsigned u) { return __uint_as_float(u << 16); }
DI float bfhi(unsigned u) { return __uint_as_float(u & 0xffff0000u); }
DI unsigned f2bf(float f) { unsigned u = __float_as_uint(f); return (u + 0x7fffu + ((u >> 16) & 1u)) >> 16; }
DI unsigned pk2(float lo, float hi) { return f2bf(lo) | (f2bf(hi) << 16); }
DI float fexp2(float x) { return __builtin_amdgcn_exp2f(x); }
DI float frcp(float x) { return __builtin_amdgcn_rcpf(x); }
DI float sigm(float x) { return frcp(1.0f + fexp2(-x * LOG2E)); }
DI float silu(float x) { return x * sigm(x); }
DI float wave_sum(float v) {
#pragma unroll
    for (int o = 1; o < 64; o <<= 1) v += __shfl_xor(v, o);
    return v;
}
DI float wave_max(float v) {
#pragma unroll
    for (int o = 1; o < 64; o <<= 1) v = fmaxf(v, __shfl_xor(v, o));
    return v;
}

#define XB_TMO      128
#define XB_XCNT(j)  (256  + 64 * (j))
#define XB_XSUB(j)  (1280 + 64 * (j))
#define XB_XGEN(j)  (2304 + 64 * (j))
#define XB_TOP      3328
#define XB_TOPGEN   3392
#define XCD_BAR_WORDS 3456
#define XB_SPIN_CAP (1u << 18)
DI unsigned xb_ld(unsigned* p)              { return __hip_atomic_load(p, __ATOMIC_RELAXED, __HIP_MEMORY_SCOPE_AGENT); }
DI unsigned xb_add(unsigned* p, unsigned v) { return __hip_atomic_fetch_add(p, v, __ATOMIC_RELAXED, __HIP_MEMORY_SCOPE_AGENT); }
DI unsigned xb_xcc_id() { return (unsigned)__builtin_amdgcn_s_getreg((3 << 11) | 20) & 0xFu; }
#define XB_SPIN(cond, bar) do { unsigned _sp = 0; while (cond) { __builtin_amdgcn_s_sleep(1); \
    if ((++_sp & 255u) == 0u) { if (xb_ld(&(bar)[XB_TMO])) break; if (_sp > XB_SPIN_CAP) { atomicAdd(&(bar)[XB_TMO], 1u); break; } } } } while (0)
struct XcdBarrier { unsigned* bar; unsigned x; volatile LAS unsigned* st; };
DI XcdBarrier xcd_barrier_post(unsigned* bar, volatile LAS unsigned* st) {
    XcdBarrier b; b.bar = bar; b.x = xb_xcc_id(); b.st = st;
    if (threadIdx.x == 0) (void)xb_add(&bar[XB_XCNT(b.x)], 1u);
    return b;
}
DI void xcd_barrier_complete(unsigned* bar, unsigned x, unsigned& nloc, unsigned& nx) {
    const unsigned G = gridDim.x * gridDim.y * gridDim.z;
    unsigned sum, cnt, mine, sp = 0u;
    for (;;) {
        sum = 0u; cnt = 0u; mine = 0u;
#pragma unroll
        for (unsigned j = 0; j < 16; ++j) { const unsigned c = xb_ld(&bar[XB_XCNT(j)]); sum += c; cnt += (c > 0u) ? 1u : 0u; mine = (j == x) ? c : mine; }
        if (sum == G) break;
        __builtin_amdgcn_s_sleep(1);
        if ((++sp & 255u) == 0u) { if (xb_ld(&bar[XB_TMO])) break; if (sp > XB_SPIN_CAP) { atomicAdd(&bar[XB_TMO], 1u); break; } }
    }
    nloc = mine > 0u ? mine : 1u; nx = cnt > 0u ? cnt : 1u;
}
DI void xcd_barrier(const XcdBarrier& b) {
    asm volatile("s_waitcnt vmcnt(0)" ::: "memory");
    __syncthreads();
    if (threadIdx.x == 0) {
        unsigned* bar = b.bar;
        __builtin_amdgcn_s_waitcnt(0);
        unsigned nloc = b.st[0], nx = b.st[1];
        if (nloc == 0u) { xcd_barrier_complete(bar, b.x, nloc, nx); b.st[0] = nloc; b.st[1] = nx; }
        const unsigned old = xb_add(&bar[XB_XSUB(b.x)], 1u);
        const unsigned gen = old / nloc;
        if (old + 1u == (gen + 1u) * nloc) {
            __builtin_amdgcn_fence(__ATOMIC_RELEASE, "agent");
            asm volatile("s_waitcnt vmcnt(0)" ::: "memory");
            const unsigned og = xb_add(&bar[XB_TOP], 1u);
            const unsigned tg = og / nx;
            if (og + 1u == (tg + 1u) * nx) xb_add(&bar[XB_TOPGEN], 1u);
            else XB_SPIN(xb_ld(&bar[XB_TOPGEN]) == tg, bar);
            __builtin_amdgcn_fence(__ATOMIC_ACQUIRE, "agent");
            xb_add(&bar[XB_XGEN(b.x)], 1u);
            asm volatile("s_waitcnt vmcnt(0)" ::: "memory");
        } else {
            XB_SPIN(xb_ld(&bar[XB_XGEN(b.x)]) == gen, bar);
            __builtin_amdgcn_fence(__ATOMIC_ACQUIRE, "agent");
            asm volatile("s_waitcnt vmcnt(0)" ::: "memory");
        }
    }
    __syncthreads();
}

#ifdef PROBE_PH
#define PROBE_E0() const unsigned pe0_ = (unsigned)__builtin_amdgcn_s_memrealtime();
#define PROBE_E1(slot) { const unsigned pd_ = (unsigned)__builtin_amdgcn_s_memrealtime() - pe0_; volatile LAS unsigned* pw_ = (volatile LAS unsigned*)(lds + 131072 + 512 + wid * 8 + (slot) * 4); *pw_ = *pw_ + pd_; }
#define PROBE_U0() const unsigned pu0_ = (unsigned)__builtin_amdgcn_s_memrealtime();
#define PROBE_U1(ui) { const unsigned pd_ = (unsigned)__builtin_amdgcn_s_memrealtime() - pu0_; if ((ui) < 8) { volatile LAS unsigned* pw_ = (volatile LAS unsigned*)(lds + 131072 + 640 + wid * 32 + (ui) * 4); *pw_ = pd_; } }
#else
#define PROBE_E0()
#define PROBE_E1(slot)
#define PROBE_U0()
#define PROBE_U1(ui)
#endif
namespace pg8 {
#define PG8_LAS __attribute__((address_space(3)))
typedef unsigned short bf16_t;
typedef short bf16x8 __attribute__((ext_vector_type(8)));
typedef float f32x4 __attribute__((ext_vector_type(4)));
typedef unsigned u32x4 __attribute__((ext_vector_type(4)));
constexpr int BM = 256, BK = 64, HALF = 128, HTB = HALF * BK * 2, STAGE_BYTES = 8 * HTB, NXCD = 8, WGM = 8;
__host__ __device__ __forceinline__ int lds_byte(int r, int c) { const int st = (r >> 4) * 2 + (c >> 5), rr = r & 15, cc = c & 31, ob = rr * 64 + cc * 2; return st * 1024 + (ob ^ (((ob >> 9) & 1) << 5)); }
__host__ __device__ __forceinline__ void stage_rc(int b, int& R, int& C) { const int st = b / 1024, sb = b % 1024, swz = sb ^ (((sb >> 9) & 1) << 5); R = (st >> 1) * 16 + swz / 64; C = (st & 1) * 32 + (swz % 64) / 2; }
__host__ __device__ __forceinline__ int perm32(int rho) { const int n = rho >> 4, i = rho & 15; return 8 * (i >> 2) + 4 * n + (i & 3); }
struct Unit { int pm, pn, br; };
template <int AC0, int AC1, int AC2>
struct GemmT {
    const char* A; const char* Bt; int lda, ldb, K; size_t b_br;
    __device__ __forceinline__ const char* a_ptr(const Unit& u) const { const int ac = u.br == 0 ? AC0 : (u.br == 1 ? AC1 : AC2); return A + ((size_t)u.pm * BM * lda + ac) * 2; }
    __device__ __forceinline__ const char* b_ptr(const Unit& u) const { return Bt + (size_t)u.br * b_br + (size_t)u.pn * BM * ldb * 2; }
};
template <int WGM_ = WGM>
__host__ __device__ __forceinline__ void tile_of(int L, int nM, int nN, int& pm, int& pn) {
    const int nwg = nM * nN; int wgid = L; { const int q = nwg / NXCD, r = nwg % NXCD, xcd = wgid % NXCD, off = wgid / NXCD; wgid = (xcd < r ? xcd * (q + 1) : r * (q + 1) + (xcd - r) * q) + off; }
    const int nig = WGM_ * nN, gid = wgid / nig, fm = gid * WGM_, gsz = (nM - fm) < WGM_ ? (nM - fm) : WGM_;
    pm = fm + ((wgid % nig) % gsz); pn = (wgid % nig) / gsz;
}
__device__ __forceinline__ unsigned cvt_pk_bf16(float lo, float hi) { unsigned r; asm volatile("v_cvt_pk_bf16_f32 %0, %1, %2" : "=v"(r) : "v"(lo), "v"(hi)); return r; }
template <class Epi, class Sched, bool ALIGN_EPI, bool SP2, class Gemm>
__device__ __forceinline__ void gemm_phase(PG8_LAS unsigned char* lds, const Gemm g, const Sched& S, const Epi& E) {
    const int tid = threadIdx.x, wid = __builtin_amdgcn_readfirstlane(tid >> 6), lane = tid & 63, wr = wid >> 2, wc = wid & 3, fr = lane & 15, fq = lane >> 4;
    const int K = g.K, nt = K / BK;
    unsigned voffA[2], voffB[2];
#pragma unroll
    for (int i = 0; i < 2; ++i) { int R, C; stage_rc(tid * 16 + i * 8192, R, C); const int Rb = Epi::PERM ? ((R & ~31) + perm32(R & 31)) : R;
        voffA[i] = (unsigned)(R * g.lda + C) * 2u; voffB[i] = (unsigned)(Rb * g.ldb + C) * 2u; }
    const size_t kstep = (size_t)(BK * 2);
    const size_t hA = (size_t)HALF * g.lda * 2, hB = (size_t)HALF * g.ldb * 2;
    const unsigned ldsw = (unsigned)wid * 1024u;
    const int aoff = lds_byte(wr * 64 + fr, fq * 8), boff = lds_byte(wc * 32 + fr, fq * 8);
#define PG8_SA(b, h) (((b) * 2 + (h)) * HTB)
#define PG8_SB(b, h) ((4 + (b) * 2 + (h)) * HTB)
#define PG8_STAGE(bufoff, gbase, voff) do { _Pragma("unroll") for (int _i = 0; _i < 2; ++_i) \
        __builtin_amdgcn_global_load_lds((const unsigned*)((const char*)(gbase) + (voff)[_i]), (PG8_LAS unsigned*)(lds + (bufoff) + ldsw + _i * 8192), 16, 0, 0); } while (0)
#define PG8_LDA(dst, b, h) do { _Pragma("unroll") for (int m = 0; m < 4; ++m) _Pragma("unroll") for (int k = 0; k < 2; ++k) dst[m][k] = *(const PG8_LAS bf16x8*)(lds + PG8_SA(b, h) + aoff + m * 2048 + k * 1024); } while (0)
#define PG8_LDB(dst, b, h) do { _Pragma("unroll") for (int n = 0; n < 2; ++n) _Pragma("unroll") for (int k = 0; k < 2; ++k) dst[n][k] = *(const PG8_LAS bf16x8*)(lds + PG8_SB(b, h) + boff + n * 2048 + k * 1024); } while (0)
#define PG8_MMA(ai, bj, At, Bt) do { __builtin_amdgcn_s_setprio(1); _Pragma("unroll") for (int m = 0; m < 4; ++m) _Pragma("unroll") for (int n = 0; n < 2; ++n) _Pragma("unroll") for (int k = 0; k < 2; ++k) \
        acc[ai][bj][m][n] = __builtin_amdgcn_mfma_f32_16x16x32_bf16(Bt[n][k], At[m][k], acc[ai][bj][m][n], 0, 0, 0); __builtin_amdgcn_s_setprio(0); } while (0)
#define PG8_WAIT_V(n) asm volatile("s_waitcnt vmcnt(" #n ")" ::: "memory")
#define PG8_WAIT_L(n) asm volatile("s_waitcnt lgkmcnt(" #n ")" ::: "memory")
#define PG8_BAR __builtin_amdgcn_s_barrier()
#define PG8_SCHED __builtin_amdgcn_sched_barrier(0)
    Unit cur, nxt; int ui = 0;
    if (!S.next(0, cur)) return;
    f32x4 acc[2][2][4][2];
#pragma unroll
    for (int a = 0; a < 2; ++a)
#pragma unroll
        for (int b = 0; b < 2; ++b)
#pragma unroll
            for (int m = 0; m < 4; ++m)
#pragma unroll
                for (int n = 0; n < 2; ++n) acc[a][b][m][n] = (f32x4){0.f, 0.f, 0.f, 0.f};
    bf16x8 At[4][2], B0[2][2], B1[2][2];
    const char* cA = g.a_ptr(cur); const char* cB = g.b_ptr(cur);
    S.a_ready(cur);
    if constexpr (SP2) {
        PG8_STAGE(PG8_SB(0, 0), cB, voffB); PG8_STAGE(PG8_SB(0, 1), cB + hB, voffB); PG8_STAGE(PG8_SA(0, 0), cA, voffA); PG8_STAGE(PG8_SA(0, 1), cA + hA, voffA);
        if (wr == 1) PG8_BAR;
        PG8_WAIT_V(2); PG8_BAR;
        PG8_STAGE(PG8_SB(1, 0), cB + kstep, voffB); PG8_STAGE(PG8_SA(1, 0), cA + kstep, voffA); PG8_STAGE(PG8_SB(1, 1), cB + hB + kstep, voffB);
        PG8_WAIT_V(6); PG8_BAR;
    } else {
        PG8_STAGE(PG8_SB(0, 0), cB, voffB); PG8_STAGE(PG8_SA(0, 0), cA, voffA); PG8_STAGE(PG8_SB(0, 1), cB + hB, voffB); PG8_STAGE(PG8_SA(0, 1), cA + hA, voffA);
        if (wr == 1) PG8_BAR;
        PG8_WAIT_V(4); PG8_BAR;
        PG8_STAGE(PG8_SB(1, 0), cB + kstep, voffB); PG8_STAGE(PG8_SA(1, 0), cA + kstep, voffA); PG8_STAGE(PG8_SB(1, 1), cB + hB + kstep, voffB);
        PG8_WAIT_V(6); PG8_BAR;
    }
    for (;;) {
        PROBE_U0()
        const bool has_next = S.next(ui + 1, nxt);
        const char* nA = has_next ? g.a_ptr(nxt) : cA; const char* nB = has_next ? g.b_ptr(nxt) : cB;
        for (int t = 0; t < nt; t += 2) {
            if constexpr (Epi::MIDHOOK) { if (t == 16 || t == 32) { PROBE_E0() E.mid(acc, cur, t, wr, wc, fr, fq); PROBE_E1(1) } }
            const bool last = (t == nt - 2);
            const char* a1 = cA + (size_t)(t + 1) * kstep;
            const char* a2 = last ? nA : cA + (size_t)(t + 2) * kstep; const char* b2 = last ? nB : cB + (size_t)(t + 2) * kstep;
            const char* a3 = a2 + kstep; const char* b3 = b2 + kstep;
            if (last && has_next) S.a_ready(nxt);
            if constexpr (SP2) {
            PG8_LDB(B0, 0, 0); PG8_LDB(B1, 0, 1); PG8_SCHED; PG8_LDA(At, 0, 0); PG8_STAGE(PG8_SA(1, 1), a1 + hA, voffA);
            PG8_WAIT_V(8); PG8_WAIT_L(0); PG8_BAR; PG8_MMA(0, 0, At, B0); PG8_MMA(0, 1, At, B1); PG8_BAR; PG8_SCHED;
            PG8_LDA(At, 0, 1); PG8_STAGE(PG8_SB(0, 0), b2, voffB); PG8_STAGE(PG8_SB(0, 1), b2 + hB, voffB); PG8_STAGE(PG8_SA(0, 0), a2, voffA);
            PG8_WAIT_V(8); PG8_WAIT_L(0); PG8_BAR; PG8_MMA(1, 0, At, B0); PG8_MMA(1, 1, At, B1); PG8_BAR; PG8_SCHED;
            PG8_LDB(B0, 1, 0); PG8_LDB(B1, 1, 1); PG8_SCHED; PG8_LDA(At, 1, 0); PG8_STAGE(PG8_SA(0, 1), a2 + hA, voffA);
            PG8_WAIT_V(8); PG8_WAIT_L(0); PG8_BAR; PG8_MMA(0, 0, At, B0); PG8_MMA(0, 1, At, B1); PG8_BAR; PG8_SCHED;
            PG8_LDA(At, 1, 1); PG8_STAGE(PG8_SB(1, 0), b3, voffB); PG8_STAGE(PG8_SB(1, 1), b3 + hB, voffB); PG8_STAGE(PG8_SA(1, 0), a3, voffA);
            PG8_WAIT_V(8); PG8_WAIT_L(0); PG8_BAR; PG8_MMA(1, 0, At, B0); PG8_MMA(1, 1, At, B1); PG8_BAR; PG8_SCHED;
            } else {
            PG8_LDB(B0, 0, 0); PG8_SCHED; PG8_LDA(At, 0, 0); PG8_STAGE(PG8_SA(1, 1), a1 + hA, voffA);
            PG8_WAIT_L(8); PG8_BAR; PG8_WAIT_L(0); PG8_MMA(0, 0, At, B0); PG8_BAR; PG8_SCHED;
            PG8_LDB(B1, 0, 1); PG8_STAGE(PG8_SB(0, 0), b2, voffB);
            PG8_BAR; PG8_WAIT_L(0); PG8_MMA(0, 1, At, B1); PG8_BAR;
            PG8_LDA(At, 0, 1); PG8_STAGE(PG8_SA(0, 0), a2, voffA);
            PG8_BAR; PG8_WAIT_L(0); PG8_MMA(1, 0, At, B0); PG8_BAR; PG8_SCHED;
            PG8_STAGE(PG8_SB(0, 1), b2 + hB, voffB);
            PG8_WAIT_V(6); PG8_BAR; PG8_MMA(1, 1, At, B1); PG8_BAR;
            PG8_LDB(B0, 1, 0); PG8_SCHED; PG8_LDA(At, 1, 0); PG8_STAGE(PG8_SA(0, 1), a2 + hA, voffA);
            PG8_WAIT_L(8); PG8_BAR; PG8_WAIT_L(0); PG8_MMA(0, 0, At, B0); PG8_BAR; PG8_SCHED;
            PG8_LDB(B1, 1, 1); PG8_STAGE(PG8_SB(1, 0), b3, voffB);
            PG8_BAR; PG8_WAIT_L(0); PG8_MMA(0, 1, At, B1); PG8_BAR;
            PG8_LDA(At, 1, 1); PG8_STAGE(PG8_SA(1, 0), a3, voffA);
            PG8_BAR; PG8_WAIT_L(0); PG8_MMA(1, 0, At, B0); PG8_BAR; PG8_SCHED;
            PG8_STAGE(PG8_SB(1, 1), b3 + hB, voffB);
            PG8_WAIT_V(6); PG8_BAR; PG8_MMA(1, 1, At, B1); PG8_BAR;
            }
        }
        if constexpr (ALIGN_EPI) { if (wr == 0) PG8_BAR; }
        if constexpr (!Epi::AFTER_DRAIN) { PROBE_E0() E(acc, cur, wr, wc, fr, fq); PROBE_E1(0) S.done(cur); }
        PROBE_U1(ui)
        if (!has_next) break;
#pragma unroll
        for (int a = 0; a < 2; ++a)
#pragma unroll
            for (int b = 0; b < 2; ++b)
#pragma unroll
                for (int m = 0; m < 4; ++m)
#pragma unroll
                    for (int n = 0; n < 2; ++n) acc[a][b][m][n] = (f32x4){0.f, 0.f, 0.f, 0.f};
        cur = nxt; cA = nA; cB = nB; ++ui;
        if constexpr (ALIGN_EPI) { if (wr == 1) PG8_BAR; }
    }
    PG8_WAIT_V(0);
    if constexpr (!ALIGN_EPI) { if (wr == 0) PG8_BAR; }
    PG8_BAR;
    if constexpr (Epi::AFTER_DRAIN) { E.fused(acc, cur, wr, wc, fr, fq, lds, wid, lane); S.done(cur); }
#undef PG8_SA
#undef PG8_SB
#undef PG8_STAGE
#undef PG8_LDA
#undef PG8_LDB
#undef PG8_MMA
#undef PG8_WAIT_V
#undef PG8_WAIT_L
#undef PG8_BAR
#undef PG8_SCHED
}
}

struct Args { const float* in[24]; float* out; unsigned char* ws; int ph_lo, ph_hi, li, pad; };
#define IN_(k) (A_.in[k])
#define X_PROMPT IN_(0)
#define X_SAMPLE IN_(1)
#define CACHE_K IN_(2)
#define CACHE_V IN_(3)
#define STATE_HGRN IN_(4)
#define CACHE_MK IN_(5)
#define CACHE_MV IN_(6)
#define MEM_PROMPT IN_(7)
#define W_IN IN_(8)
#define LQ1 IN_(9)
#define LK1 IN_(10)
#define LQ2 IN_(11)
#define LK2 IN_(12)
#define SUB_NORM IN_(13)
#define LB_LOGITS IN_(14)
#define HGRN_NORM IN_(15)
#define W_MEM_K IN_(16)
#define W_MEM_V IN_(17)
#define W_A IN_(18)
#define W_B IN_(19)
#define W_C IN_(20)
#define W_OUT IN_(21)
#define LN_G IN_(22)
#define LN_B IN_(23)
#define OUT_ (A_.out)
#define WS_(off) (A_.ws + (off))
#define XB_ ((bf16*)WS_(WS_XB))
#define WT_ ((bf16*)WS_(WS_WT))
#define WABC_ ((bf16*)WS_(WS_WABC))
#define WO_ ((bf16*)WS_(WS_WO))
#define MKV_ ((bf16*)WS_(WS_MKV))
#define P_ ((bf16*)WS_(WS_P))
#define MG_ ((bf16*)WS_(WS_MG))
#define G_ ((float*)WS_(WS_G))
#define PRE_ ((bf16*)WS_(WS_PRE))
#define Y_ ((bf16*)WS_(WS_Y))
#define KC_ ((bf16*)WS_(WS_KC))
#define VC_ ((bf16*)WS_(WS_VC))
#define OB_ ((float*)WS_(WS_OB))
#define ROPE_ ((v2f*)WS_(WS_ROPE))
typedef const Args& Ctx;

struct InProjOrder {
    int G, c;
    DI bool next(int i, pg8::Unit& u) const {
        const int L = i * G + c; u.br = 0;
        if (L < 130 * 68) { pg8::tile_of(L, 130, 68, u.pm, u.pn); return true; }
        const int l = L - 130 * 68; if (l >= 64) return false;
        u.pm = 130 + (l & 7); u.pn = 68 + (l >> 3); return true;
    }
    DI void a_ready(const pg8::Unit&) const {}
    DI void done(const pg8::Unit&) const {}
};
struct MergeOrder {
    int G, c;
    DI bool next(int i, pg8::Unit& u) const {
        const int T = i * G + c; if (T >= 130 * 8) return false;
        pg8::tile_of<4>(T, 130, 8, u.pm, u.pn); u.br = 0; return true;
    }
    DI void a_ready(const pg8::Unit&) const {}
    DI void done(const pg8::Unit&) const {}
};
struct OutOrder {
    int G, c;
    DI bool next(int i, pg8::Unit& u) const {
        const int L = i * G + c; if (L >= 130 * 8) return false;
        pg8::tile_of<4>(L, 130, 8, u.pm, u.pn); u.br = 0; return true;
    }
    DI void a_ready(const pg8::Unit&) const {}
    DI void done(const pg8::Unit&) const {}
};

DI void st8bf(bf16* p, const float (&v)[8]) {
    v4u w; w.x = pg8::cvt_pk_bf16(v[0], v[1]); w.y = pg8::cvt_pk_bf16(v[2], v[3]); w.z = pg8::cvt_pk_bf16(v[4], v[5]); w.w = pg8::cvt_pk_bf16(v[6], v[7]);
    *(v4u*)p = w;
}
DI void st8f(float* p, const float (&v)[8]) { *(v4f*)p = (v4f){v[0], v[1], v[2], v[3]}; *(v4f*)(p + 4) = (v4f){v[4], v[5], v[6], v[7]}; }
DI void ld8bf(const bf16* p, float (&f)[8]) {
    const v4u w = *(const v4u*)p;
    f[0] = bflo(w.x); f[1] = bfhi(w.x); f[2] = bflo(w.y); f[3] = bfhi(w.y); f[4] = bflo(w.z); f[5] = bfhi(w.z); f[6] = bflo(w.w); f[7] = bfhi(w.w);
}

struct EpiIn {
    static constexpr bool PERM = true, AFTER_DRAIN = false, MIDHOOK = false;
    bf16* P; float* G; float* out; bf16* MKV; const float* lbl; const v2f* rope; bf16* KC; bf16* VC;
    template <int MODE>
    DI void rows(const pg8::f32x4 (&acc)[2][2][4][2], const pg8::Unit& u, int wr, int wc, int fr, int fq) const {
        const int pn = u.pn, tc0 = wc * 32 + fq * 8;
        float lbv[2][8];
        if constexpr (MODE == 4) {
#pragma unroll
            for (int bj = 0; bj < 2; ++bj) { const int cf = (pn - 20) * 256 + bj * 128 + tc0;
#pragma unroll
                for (int i = 0; i < 8; ++i) lbv[bj][i] = sigm(lbl[cf + i] - lbl[1024 + cf + i]); }
        }
#pragma unroll
        for (int ai = 0; ai < 2; ++ai)
#pragma unroll
            for (int m = 0; m < 4; ++m) {
                const int row = u.pm * 256 + ai * 128 + wr * 64 + m * 16 + fr;
                v2f cs[8];
                if constexpr (MODE <= 1) {
                    const int pos = row < MP ? (row & (SEQ - 1)) : PAST + ((row - MP) & (DS - 1));
                    const v4f* rp = (const v4f*)(rope + (size_t)pos * 8);
#pragma unroll
                    for (int i = 0; i < 4; ++i) { const v4f t = rp[i]; cs[2 * i] = (v2f){t.x, t.y}; cs[2 * i + 1] = (v2f){t.z, t.w}; }
                }
#pragma unroll
                for (int bj = 0; bj < 2; ++bj) {
                    float v[8];
#pragma unroll
                    for (int i = 0; i < 4; ++i) { v[i] = acc[ai][bj][m][0][i]; v[4 + i] = acc[ai][bj][m][1][i]; }
                    const int col = pn * 256 + bj * 128 + tc0;
                    if constexpr (MODE <= 1) {
                        if ((wc & 1) == 0) {
                            const float sgn = fq == 0 ? -1.f : 1.f;
#pragma unroll
                            for (int i = 0; i < 8; ++i) { const float pr = __shfl_xor(v[i], 16); const float r = v[i] * cs[i].x + sgn * pr * cs[i].y; v[i] = fq < 2 ? r : v[i]; }
                        }
                        if constexpr (MODE == 0) {
#pragma unroll
                            for (int i = 0; i < 8; ++i) v[i] *= QA_SCALE;
                        }
                    }
                    if constexpr (MODE == 1 || MODE == 2) {
                        const int cs1 = (pn & 3) * 256 + bj * 128 + tc0;
                        float* dst = row < MP ? out + (MODE == 1 ? O_KP : O_VP) + (size_t)row * 1024 + cs1 : out + (MODE == 1 ? O_KS : O_VS) + (size_t)(row - MP) * 1024 + cs1;
                        st8f(dst, v);
                    }
                    if constexpr (MODE == 3) {
#pragma unroll
                        for (int i = 0; i < 8; ++i) v[i] = silu(v[i]);
                    }
                    if constexpr (MODE == 6) {
#pragma unroll
                        for (int i = 0; i < 8; ++i) v[i] = sigm(v[i]);
                    }
                    if constexpr (MODE == 7) {
#pragma unroll
                        for (int i = 0; i < 8; ++i) v[i] *= QC_SCALE;
                    }
                    if constexpr (MODE == 4) {
                        const int cf = (pn - 20) * 256 + bj * 128 + tc0;
#pragma unroll
                        for (int i = 0; i < 8; ++i) { const float lb = lbv[bj][i]; const float f = lb + (1.f - lb) * sigm(v[i]); v[i] = __builtin_amdgcn_logf(f) * LN2; }
                        st8f(G + (size_t)row * 1024 + cf, v);
                    } else if constexpr (MODE == 8) {
                        const int r = row - M, cm = (pn - 68) * 256 + bj * 128 + tc0;
                        float* dst = cm < 1024 ? out + O_MK + (size_t)r * 1024 + cm : out + O_MV + (size_t)r * 1024 + (cm - 1024);
                        st8f(dst, v);
                        st8bf(MKV + (size_t)r * 2048 + cm, v);
                    } else if constexpr (MODE == 1 || MODE == 2) {
                        if (row < MP) {
                            const int cc = (pn & 3) * 256 + bj * 128 + tc0, hd = cc >> 7;
                            st8bf((MODE == 1 ? KC : VC) + ((size_t)((row >> 12) * 8 + hd) * SEQ + (row & (SEQ - 1))) * 128 + (cc & 127), v);
                        } else st8bf(P + (size_t)row * NIN + col, v);
                    } else {
                        st8bf(P + (size_t)row * NIN + col, v);
                    }
                }
            }
    }
    DI void operator()(const pg8::f32x4 (&acc)[2][2][4][2], const pg8::Unit& u, int wr, int wc, int fr, int fq) const {
        const int pn = u.pn;
        int mode;
        if (pn >= 68) mode = 8;
        else if (pn >= 44) mode = 6;
        else { const int seg = pn >> 2; mode = seg == 0 ? 0 : seg == 1 ? 1 : seg == 2 ? 2 : seg == 5 ? 4 : seg == 6 ? 5 : seg == 7 ? 6 : seg == 9 ? 7 : 3; }
        switch (mode) {
            case 0: rows<0>(acc, u, wr, wc, fr, fq); break;
            case 1: rows<1>(acc, u, wr, wc, fr, fq); break;
            case 2: rows<2>(acc, u, wr, wc, fr, fq); break;
            case 3: rows<3>(acc, u, wr, wc, fr, fq); break;
            case 4: rows<4>(acc, u, wr, wc, fr, fq); break;
            case 5: rows<5>(acc, u, wr, wc, fr, fq); break;
            case 6: rows<6>(acc, u, wr, wc, fr, fq); break;
            case 7: rows<7>(acc, u, wr, wc, fr, fq); break;
            default: rows<8>(acc, u, wr, wc, fr, fq); break;
        }
    }
};

struct EpiMerge {
    static constexpr bool PERM = true, AFTER_DRAIN = false, MIDHOOK = true;
    const bf16* P; bf16* MG;
    DI void mid(pg8::f32x4 (&acc)[2][2][4][2], const pg8::Unit& u, int t, int wr, int wc, int fr, int fq) const {
        const int gp = t == 16 ? C_GA : C_GB, gn = t == 16 ? C_GB : C_GC;
        const float plo = t == 16 ? 0.f : 1e-6f, lo = 1e-6f;
        unsigned off0 = (unsigned)((u.pm * 256 + wr * 64 + fr) * NIN + u.pn * 256 + wc * 32 + fq * 8);
        asm volatile("" : "+v"(off0));
#pragma unroll
        for (int ai = 0; ai < 2; ++ai)
#pragma unroll
            for (int mh = 0; mh < 2; ++mh) {
                v4u a[2][2], b[2][2];
#pragma unroll
                for (int m2 = 0; m2 < 2; ++m2) { const unsigned ro = off0 + (unsigned)((ai * 128 + (mh * 2 + m2) * 16) * NIN);
#pragma unroll
                    for (int bj = 0; bj < 2; ++bj) { a[m2][bj] = __builtin_nontemporal_load((const v4u*)(P + (ro + gp + bj * 128))); b[m2][bj] = __builtin_nontemporal_load((const v4u*)(P + (ro + gn + bj * 128))); } }
#pragma unroll
                for (int m2 = 0; m2 < 2; ++m2)
#pragma unroll
                    for (int bj = 0; bj < 2; ++bj) { const v4u x = a[m2][bj], y = b[m2][bj];
#define RT(pa, pb) (fmaxf((pa), plo) * frcp(fmaxf((pb), lo)))
                        pg8::f32x4& a0 = acc[ai][bj][mh * 2 + m2][0]; pg8::f32x4& a1 = acc[ai][bj][mh * 2 + m2][1];
                        a0[0] *= RT(bflo(x.x), bflo(y.x)); a0[1] *= RT(bfhi(x.x), bfhi(y.x)); a0[2] *= RT(bflo(x.y), bflo(y.y)); a0[3] *= RT(bfhi(x.y), bfhi(y.y));
                        a1[0] *= RT(bflo(x.z), bflo(y.z)); a1[1] *= RT(bfhi(x.z), bfhi(y.z)); a1[2] *= RT(bflo(x.w), bflo(y.w)); a1[3] *= RT(bfhi(x.w), bfhi(y.w));
#undef RT
                    }
            }
    }
    DI void operator()(const pg8::f32x4 (&acc)[2][2][4][2], const pg8::Unit& u, int wr, int wc, int fr, int fq) const {
        const int tc0 = wc * 32 + fq * 8;
#pragma unroll
        for (int ai = 0; ai < 2; ++ai) {
            v4u gw[4][2];
#pragma unroll
            for (int m = 0; m < 4; ++m) { const int row = u.pm * 256 + ai * 128 + wr * 64 + m * 16 + fr;
#pragma unroll
                for (int bj = 0; bj < 2; ++bj) gw[m][bj] = __builtin_nontemporal_load((const v4u*)(P + (size_t)row * NIN + C_GC + u.pn * 256 + bj * 128 + tc0)); }
#pragma unroll
            for (int m = 0; m < 4; ++m) { const int row = u.pm * 256 + ai * 128 + wr * 64 + m * 16 + fr;
#pragma unroll
                for (int bj = 0; bj < 2; ++bj) { const int col = u.pn * 256 + bj * 128 + tc0;
                    const v4u g = gw[m][bj]; const pg8::f32x4 a0 = acc[ai][bj][m][0], a1 = acc[ai][bj][m][1]; const float lo = 1e-6f;
                    float v[8];
                    v[0] = a0[0] * fmaxf(bflo(g.x), lo); v[1] = a0[1] * fmaxf(bfhi(g.x), lo); v[2] = a0[2] * fmaxf(bflo(g.y), lo); v[3] = a0[3] * fmaxf(bfhi(g.y), lo);
                    v[4] = a1[0] * fmaxf(bflo(g.z), lo); v[5] = a1[1] * fmaxf(bfhi(g.z), lo); v[6] = a1[2] * fmaxf(bflo(g.w), lo); v[7] = a1[3] * fmaxf(bfhi(g.w), lo);
                    st8bf(MG + (size_t)row * D + col, v); } }
        }
    }
};

struct EpiOut {
    static constexpr bool PERM = true, AFTER_DRAIN = false, MIDHOOK = false;
    const float* xp; const float* xs; bf16* pre;
    DI void operator()(const pg8::f32x4 (&acc)[2][2][4][2], const pg8::Unit& u, int wr, int wc, int fr, int fq) const {
        const int tc0 = wc * 32 + fq * 8;
#pragma unroll
        for (int ai = 0; ai < 2; ++ai)
#pragma unroll
            for (int mh = 0; mh < 2; ++mh) {
                v4f xv[2][2][2];
#pragma unroll
                for (int m2 = 0; m2 < 2; ++m2) { const int row = u.pm * 256 + ai * 128 + wr * 64 + (mh * 2 + m2) * 16 + fr;
                    const float* xr = row < MP ? xp + (size_t)row * D : xs + (size_t)(row - MP) * D;
#pragma unroll
                    for (int bj = 0; bj < 2; ++bj)
#pragma unroll
                        for (int n = 0; n < 2; ++n) xv[m2][bj][n] = __builtin_nontemporal_load((const v4f*)(xr + u.pn * 256 + bj * 128 + tc0 + 4 * n)); }
#pragma unroll
                for (int m2 = 0; m2 < 2; ++m2) { const int m = mh * 2 + m2, row = u.pm * 256 + ai * 128 + wr * 64 + m * 16 + fr;
#pragma unroll
                    for (int bj = 0; bj < 2; ++bj) { const int col = u.pn * 256 + bj * 128 + tc0;
                        const v4f x0 = xv[m2][bj][0], x1 = xv[m2][bj][1]; const pg8::f32x4 a0 = acc[ai][bj][m][0], a1 = acc[ai][bj][m][1];
                        const float v[8] = {DN_ALPHA * x0.x + a0[0], DN_ALPHA * x0.y + a0[1], DN_ALPHA * x0.z + a0[2], DN_ALPHA * x0.w + a0[3],
                                            DN_ALPHA * x1.x + a1[0], DN_ALPHA * x1.y + a1[1], DN_ALPHA * x1.z + a1[2], DN_ALPHA * x1.w + a1[3]};
                        st8bf(pre + (size_t)row * D + col, v); } }
            }
    }
};

DI void p0_transpose_item(const float* W, int K, int N, bf16* WT, int row_off, LAS float* scr, int item, int lane, int ldw = 0, int coff = 0) {
    if (ldw == 0) ldw = K;
    const int nblk = N / 32, kb = item / nblk, nb = item % nblk, k0 = 64 * kb, n0 = 32 * nb;
#pragma unroll 8
    for (int i = 0; i < 32; ++i) { const int kk = 2 * i + (lane >> 5); scr[kk * 33 + (lane & 31)] = W[(size_t)(k0 + kk) * N + n0 + (lane & 31)]; }
    asm volatile("s_waitcnt lgkmcnt(0)" ::: "memory");
    const int c = lane & 7;
#pragma unroll
    for (int j = 0; j < 4; ++j) { const int n = (lane >> 3) + 8 * j; const LAS float* s = scr + (8 * c) * 33 + n;
        v4u o; o.x = pk2(s[0 * 33], s[1 * 33]); o.y = pk2(s[2 * 33], s[3 * 33]); o.z = pk2(s[4 * 33], s[5 * 33]); o.w = pk2(s[6 * 33], s[7 * 33]);
        *(v4u*)(WT + (size_t)(row_off + n0 + n) * ldw + coff + k0 + 8 * c) = o; }
    asm volatile("s_waitcnt lgkmcnt(0)" ::: "memory");
}
DI void p0_row_to_bf16(const float* xrow, bf16* orow, int lane) {
    const v4f* xr = (const v4f*)xrow + lane;
    v2u* o8 = (v2u*)orow + lane;
#pragma unroll
    for (int j = 0; j < 8; ++j) { const v4f v = xr[64 * j]; o8[64 * j] = (v2u){pk2(v.x, v.y), pk2(v.z, v.w)}; }
}
DI void p0_rope_entry(v2f* rope, int idx) {
    const int pos = idx >> 3, i = idx & 7;
    const float invf = i == 0 ? 1.0f : i == 1 ? 0.1939227432012558f : i == 2 ? 0.03760603070259094f : i == 3 ? 0.007292664609849453f : i == 4 ? 0.0014142135623842478f
                     : i == 5 ? 0.00027424818836152554f : i == 6 ? 5.318296098266728e-05f : 1.0313386155758053e-05f;
    const float ang = (float)pos * invf;
    const double x = (double)ang, twopi = 6.283185307179586476925286766559;
    const double k = __builtin_rint(x / twopi), r = x - k * twopi, r2 = r * r;
    double c = 1.0, s = 1.0;
#pragma unroll
    for (int n = 17; n >= 1; --n) { c = 1.0 - c * r2 / (double)((2 * n - 1) * (2 * n)); s = 1.0 - s * r2 / (double)((2 * n) * (2 * n + 1)); }
    rope[idx] = (v2f){(float)c, (float)(s * r)};
}

DI void ln_row(Ctx A_, int m, int lane) {
    const v4u* pr = (const v4u*)(PRE_ + (size_t)m * D) + lane;
    float v[4][8]; float s = 0.f;
#pragma unroll
    for (int j = 0; j < 4; ++j) { const v4u w = pr[64 * j];
        v[j][0] = bflo(w.x); v[j][1] = bfhi(w.x); v[j][2] = bflo(w.y); v[j][3] = bfhi(w.y); v[j][4] = bflo(w.z); v[j][5] = bfhi(w.z); v[j][6] = bflo(w.w); v[j][7] = bfhi(w.w);
#pragma unroll
        for (int e = 0; e < 8; ++e) s += v[j][e]; }
    const float mean = wave_sum(s) * (1.0f / D); float s2 = 0.f;
#pragma unroll
    for (int j = 0; j < 4; ++j)
#pragma unroll
        for (int e = 0; e < 8; ++e) { v[j][e] -= mean; s2 += v[j][e] * v[j][e]; }
    const float rstd = 1.0f / sqrtf(wave_sum(s2) * (1.0f / D) + NORM_EPS);
#pragma unroll
    for (int j = 0; j < 4; ++j) { const int c0 = 512 * j + 8 * lane;
        const v4f g0 = *(const v4f*)(LN_G + c0), g1 = *(const v4f*)(LN_G + c0 + 4), b0 = *(const v4f*)(LN_B + c0), b1 = *(const v4f*)(LN_B + c0 + 4);
        float* o = OUT_ + (size_t)m * D + c0;
        *(v4f*)o = (v4f){v[j][0] * rstd * g0.x + b0.x, v[j][1] * rstd * g0.y + b0.y, v[j][2] * rstd * g0.z + b0.z, v[j][3] * rstd * g0.w + b0.w};
        *(v4f*)(o + 4) = (v4f){v[j][4] * rstd * g1.x + b1.x, v[j][5] * rstd * g1.y + b1.y, v[j][6] * rstd * g1.z + b1.z, v[j][7] * rstd * g1.w + b1.w}; }
}


DI void glds16(const void* gsrc, unsigned lds_dst) { unsigned keep;
    asm volatile("s_mov_b32 %0, m0\n\ts_mov_b32 m0, %2\n\ts_nop 0\n\tglobal_load_lds_dwordx4 %1, off\n\ts_mov_b32 m0, %0" : "=&s"(keep) : "v"(gsrc), "s"(lds_dst) : "memory"); }
DI unsigned lds_addr(const LAS void* p) { return (unsigned)__builtin_amdgcn_readfirstlane((int)(unsigned)(size_t)p); }
constexpr float RESC_THR = 8.0f;
DI float lam_of(Ctx A_, int lane) {
    const float d1 = wave_sum(LQ1[lane] * LK1[lane]), d2 = wave_sum(LQ2[lane] * LK2[lane]);
    return __expf(d1) - __expf(d2) + LAM_INIT;
}
namespace fa {
typedef short bf16x8 __attribute__((ext_vector_type(8)));
typedef short s16x4 __attribute__((ext_vector_type(4)));
typedef float f32x16 __attribute__((ext_vector_type(16)));
typedef float f32x2_t __attribute__((ext_vector_type(2)));
typedef __bf16 bf16x2_t __attribute__((ext_vector_type(2)));
typedef short v4i16_t __attribute__((ext_vector_type(4)));
constexpr int KT = 16384, VT = 16384, BUF = KT + VT, NBUF = 3, WSF_OFF = NBUF * BUF;
DI int crow(int i, int hh) { return (i & 3) + 8 * (i >> 2) + 4 * hh; }
DI unsigned cvtpk(float lo, float hi) { f32x2_t v = {lo, hi}; bf16x2_t b = __builtin_convertvector(v, bf16x2_t); return __builtin_bit_cast(unsigned, b); }
DI bf16x8 pack8(const f32x16& x, int s8) {
    v4u p; p.x = cvtpk(x[s8], x[s8 + 1]); p.y = cvtpk(x[s8 + 2], x[s8 + 3]); p.z = cvtpk(x[s8 + 4], x[s8 + 5]); p.w = cvtpk(x[s8 + 6], x[s8 + 7]);
    return __builtin_bit_cast(bf16x8, p);
}
DI s16x4 vtr(const LAS unsigned char* p) { return __builtin_bit_cast(s16x4, __builtin_amdgcn_ds_read_tr16_b64_v4i16((LAS v4i16_t*)p)); }
DI void load_tile(LAS unsigned char* buf, const bf16* Kg, const bf16* Vg, int kv0, int wave, int lane) {
#pragma unroll
    for (int i = 0; i < 2; ++i) { const int c = 2 * wave + i;
        glds16(Kg + (size_t)(kv0 + lane) * 128 + c * 8, lds_addr(buf + c * 1024)); }
#pragma unroll
    for (int i = 0; i < 2; ++i) { const int pc = 2 * wave + i;
        glds16(Vg + (size_t)(kv0 + 16 * (pc & 3) + (lane >> 2)) * 128 + (pc >> 2) * 32 + (lane & 3) * 8, lds_addr(buf + KT + (pc >> 2) * 4096 + (pc & 3) * 1024)); }
}
DI void attn_unit(Ctx A_, LAS unsigned char* lds, int b, int h, int qb, float lam, int wave, int lane) {
    const int r = lane & 31, hh = lane >> 5, mp = wave >> 2, rg = wave & 3;
    bf16* P = P_;
    const size_t rowb = (size_t)b * SEQ;
    const bf16* Kg = KC_ + (size_t)(b * 8 + h) * SEQ * 128; const bf16* Vg = VC_ + (size_t)(b * 8 + h) * SEQ * 128;
    const int q0 = qb * 128 + rg * 32;
    const int NT = 2 * qb + 2, NTw = 2 * qb + 1 + (rg >> 1);
    LAS float* wsf = (LAS float*)(lds + WSF_OFF) + wave * 128;
    bf16x8 qr[4];
    { const bf16* Qg = P + (rowb + q0 + r) * NIN + C_QA + h * 128 + mp * 64 + hh * 8;
#pragma unroll
      for (int d0 = 0; d0 < 4; ++d0) qr[d0] = *(const bf16x8*)(Qg + d0 * 16); }
    load_tile(lds, Kg, Vg, 0, wave, lane);
    load_tile(lds + BUF, Kg, Vg, 64, wave, lane);
    asm volatile("" : "+v"(qr[0]), "+v"(qr[1]), "+v"(qr[2]), "+v"(qr[3]));
    f32x16 o[4];
#pragma unroll
    for (int nb = 0; nb < 4; ++nb)
#pragma unroll
        for (int i = 0; i < 16; ++i) o[nb][i] = 0.f;
    float m = 0.f, l = 0.f;
    const int g16 = (lane >> 4) & 1, p4 = lane & 3, q4 = (lane & 15) >> 2;
    int slot = 0;
    for (int t = 0; t < NT; ++t) {
        if (t + 1 < NT) asm volatile("s_waitcnt vmcnt(4) lgkmcnt(0)" ::: "memory"); else asm volatile("s_waitcnt vmcnt(0) lgkmcnt(0)" ::: "memory");
        __builtin_amdgcn_s_barrier(); asm volatile("" ::: "memory");
        if (t + 2 < NT) { const int s2 = slot == 0 ? 2 : slot - 1; load_tile(lds + s2 * BUF, Kg, Vg, (t + 2) * 64, wave, lane); }
        if (t < NTw) {
            const LAS unsigned char* buf = lds + slot * BUF;
            const LAS unsigned char* kb = buf + (mp * 8 + hh) * 1024 + r * 16;
            const bool first = t == 0;
            const float mi = first ? 0.f : m;
            f32x16 p0, p1;
#pragma unroll
            for (int i = 0; i < 16; ++i) { p0[i] = -mi; p1[i] = -mi; }
            { bf16x8 kf[8];
#pragma unroll
              for (int d0 = 0; d0 < 4; ++d0) { kf[2 * d0] = *(const LAS bf16x8*)(kb + d0 * 2048); kf[2 * d0 + 1] = *(const LAS bf16x8*)(kb + d0 * 2048 + 512); }
              __builtin_amdgcn_sched_barrier(0);
              __builtin_amdgcn_s_setprio(1);
#pragma unroll
              for (int d0 = 0; d0 < 4; ++d0) {
                  p0 = __builtin_amdgcn_mfma_f32_32x32x16_bf16(kf[2 * d0], qr[d0], p0, 0, 0, 0);
                  p1 = __builtin_amdgcn_mfma_f32_32x32x16_bf16(kf[2 * d0 + 1], qr[d0], p1, 0, 0, 0);
              }
              __builtin_amdgcn_s_setprio(0);
              __builtin_amdgcn_sched_barrier(0); }
#define MX3(a, b, c) __builtin_fmaxf(__builtin_fmaxf((a), (b)), (c))
            float ta = MX3(p0[0], p0[1], p1[0]), tb2 = MX3(p0[2], p0[3], p1[1]); ta = MX3(ta, p1[2], p1[3]);
#pragma unroll
            for (int i = 4; i < 16; i += 4) { ta = MX3(ta, p0[i], p0[i + 1]); tb2 = MX3(tb2, p0[i + 2], p0[i + 3]); ta = MX3(ta, p1[i], p1[i + 1]); tb2 = MX3(tb2, p1[i + 2], p1[i + 3]); }
#undef MX3
            float tm = fmaxf(ta, tb2);
            { const auto rr = __builtin_amdgcn_permlane32_swap(__float_as_uint(tm), __float_as_uint(tm), false, false); tm = fmaxf(__uint_as_float(rr[0]), __uint_as_float(rr[1])); }
            if (first || __any(tm > RESC_THR)) {
                const float dl = first ? tm : fmaxf(tm, 0.f), f = fexp2(-dl); m = mi + dl; l *= f;
#pragma unroll
                for (int i = 0; i < 16; ++i) { p0[i] -= dl; p1[i] -= dl; }
                if (hh == 0) wsf[r] = f;
                float fr[16];
#pragma unroll
                for (int i = 0; i < 16; ++i) fr[i] = wsf[crow(i, hh)];
#pragma unroll
                for (int nb = 0; nb < 4; ++nb)
#pragma unroll
                    for (int i = 0; i < 16; ++i) o[nb][i] *= fr[i];
            }
            float ls = 0.f;
#pragma unroll
            for (int i = 0; i < 16; ++i) { p0[i] = fexp2(p0[i]); p1[i] = fexp2(p1[i]); ls += p0[i] + p1[i]; }
            l += ls;
            bf16x8 pf[4]; pf[0] = pack8(p0, 0); pf[1] = pack8(p0, 8); pf[2] = pack8(p1, 0); pf[3] = pack8(p1, 8);
            const LAS unsigned char* vp = buf + KT + g16 * 32 + p4 * 8 + (4 * hh + q4) * 64;
            { bf16x8 fa4[4], fb4[4];
#define LOADV(f, ks) _Pragma("unroll") for (int nb = 0; nb < 4; ++nb) { const s16x4 lo = vtr(vp + nb * 4096 + (ks) * 1024), hi = vtr(vp + nb * 4096 + (ks) * 1024 + 512); f[nb] = __builtin_shufflevector(lo, hi, 0, 1, 2, 3, 4, 5, 6, 7); }
#define MMV(f, ks) __builtin_amdgcn_s_setprio(1); _Pragma("unroll") for (int nb = 0; nb < 4; ++nb) o[nb] = __builtin_amdgcn_mfma_f32_32x32x16_bf16(pf[ks], f[nb], o[nb], 0, 0, 0); __builtin_amdgcn_s_setprio(0);
              LOADV(fa4, 0) LOADV(fb4, 1) __builtin_amdgcn_sched_barrier(0);
              MMV(fa4, 0) LOADV(fa4, 2) __builtin_amdgcn_sched_barrier(0);
              MMV(fb4, 1) LOADV(fb4, 3) __builtin_amdgcn_sched_barrier(0);
              MMV(fa4, 2) MMV(fb4, 3) __builtin_amdgcn_sched_barrier(0);
#undef LOADV
#undef MMV
            }
        }
        slot = slot == 2 ? 0 : slot + 1;
    }
    l += __shfl_xor(l, 32);
    if (hh == 0) wsf[32 + r] = l;
    float rl[16];
#pragma unroll
    for (int i = 0; i < 16; ++i) rl[i] = 1.0f / wsf[32 + crow(i, hh)];
    float lam_e = lam; asm volatile("" : "+v"(lam_e));
    const float sc = mp == 0 ? 1.0f : lam_e;
#pragma unroll
    for (int nb = 0; nb < 4; ++nb)
#pragma unroll
        for (int i = 0; i < 16; ++i) o[nb][i] *= rl[i] * sc;
    asm volatile("s_waitcnt vmcnt(0) lgkmcnt(0)" ::: "memory"); __builtin_amdgcn_s_barrier(); asm volatile("" ::: "memory");
    int r_e = r, hh_e = hh; asm volatile("" : "+v"(r_e), "+v"(hh_e));
    int rowq_e = (int)rowb + q0, h_e = h; asm volatile("" : "+s"(rowq_e), "+s"(h_e));
    LAS float* X2 = (LAS float*)lds + rg * 4096 + (hh_e * 32 + r_e);
    if (mp == 1) {
#pragma unroll
        for (int nb = 0; nb < 4; ++nb)
#pragma unroll
            for (int i = 0; i < 16; ++i) X2[(nb * 16 + i) * 64] = o[nb][i];
    }
    asm volatile("s_waitcnt lgkmcnt(0)" ::: "memory"); __builtin_amdgcn_s_barrier(); asm volatile("" ::: "memory");
    if (mp == 0) {
        float ssq[16];
#pragma unroll
        for (int i = 0; i < 16; ++i) ssq[i] = 0.f;
#pragma unroll
        for (int nb = 0; nb < 4; ++nb)
#pragma unroll
            for (int i = 0; i < 16; ++i) { const float d = o[nb][i] - X2[(nb * 16 + i) * 64]; o[nb][i] = d; ssq[i] += d * d; }
#pragma unroll
        for (int i = 0; i < 16; ++i) {
            float v = ssq[i];
#pragma unroll
            for (int x = 1; x < 32; x <<= 1) v += __shfl_xor(v, x);
            ssq[i] = ONE_M_LAMINIT / sqrtf(v * (1.0f / 128.0f) + NORM_EPS);
        }
#pragma unroll
        for (int nb = 0; nb < 4; ++nb) {
            const float sn = SUB_NORM[nb * 32 + r_e];
#pragma unroll
            for (int i = 0; i < 16; ++i) {
                const size_t rw = (size_t)(rowq_e + crow(i, hh_e));
                Y_[rw * YLD + C_YA + h_e * 128 + nb * 32 + r_e] = (bf16)f2bf(o[nb][i] * ssq[i] * sn * bf2f(P[rw * NIN + C_ZA + h_e * 128 + nb * 32 + r_e]));
            }
        }
    }
    asm volatile("s_waitcnt lgkmcnt(0)" ::: "memory"); __builtin_amdgcn_s_barrier(); asm volatile("" ::: "memory");
}
DI void attn_phase(Ctx A_, LAS unsigned char* lds, int G, int c, float lam, int wave, int lane) {
    if (G == 256) {
        const int bh = c >> 2, s = c & 3;
#pragma unroll 1
        for (int i = 0; i < 8; ++i) { const int base = 4 * (i >> 1) + s; const int qb = (i & 1) ? 31 - base : base;
            attn_unit(A_, lds, bh >> 3, bh & 7, qb, lam, wave, lane); }
    } else {
#pragma unroll 1
        for (int u = c; u < 2048; u += G) { const int qb = 31 - (u >> 6), bh = u & 63; attn_unit(A_, lds, bh >> 3, bh & 7, qb, lam, wave, lane); }
    }
}
}

namespace hg {
using fa::bf16x8; using fa::s16x4; using fa::f32x16; using fa::crow; using fa::pack8; using fa::vtr;
constexpr int RP = 272;
constexpr int OFF_QT = 0, OFF_KT = 17408, OFF_QS = 34816, OFF_KS = 52224, OFF_V = 69632, OFF_OX = 86016, OFF_SEG = 118784, OFF_DEC = 122880;
static_assert(OFF_DEC + 512 <= RING_BYTES, "hgrn lds map");
#define HG_BAR() do { asm volatile("s_waitcnt vmcnt(0) lgkmcnt(0)" ::: "memory"); __builtin_amdgcn_s_barrier(); asm volatile("" ::: "memory"); } while (0)
#define HG_LBAR() do { asm volatile("s_waitcnt lgkmcnt(0)" ::: "memory"); __builtin_amdgcn_s_barrier(); asm volatile("" ::: "memory"); } while (0)
DI void hgrn_unit(Ctx A_, LAS unsigned char* lds, int row0, int T, int NC, int h, const float* s0, float* sout, int wave, int lane, int tid) {
    bf16* P = P_; const float* G = G_;
    const int r = lane & 31, hh = lane >> 5, j = wave & 3, tb = wave >> 2;
    const int dkp = tid & 63, seg = wave;
    const int g16 = (lane >> 4) & 1, p4 = lane & 3, q4 = (lane & 15) >> 2;
    f32x16 S[4];
#pragma unroll
    for (int i = 0; i < 4; ++i)
#pragma unroll
        for (int e = 0; e < 16; ++e) S[i][e] = s0 ? s0[(size_t)(32 * i + crow(e, hh)) * 128 + 32 * j + r] : 0.f;
    v2f gx[8]; unsigned qx[8], vx[8];
#define HG_LOAD(c) do { _Pragma("unroll") for (int i = 0; i < 8; ++i) { const int t = 8 * seg + i; const size_t row = (size_t)row0 + 64 * (c) + t; \
        if (t < T) { gx[i] = *(const v2f*)(G + row * 1024 + h * 128 + 2 * dkp); qx[i] = *(const unsigned*)(P + row * NIN + C_QB + h * 128 + 2 * dkp); vx[i] = *(const unsigned*)(P + row * NIN + C_IB + h * 128 + 2 * dkp); } \
        else { gx[i] = (v2f){0.f, 0.f}; qx[i] = 0u; vx[i] = 0u; } } } while (0)
    HG_LOAD(0);
#pragma unroll 1
    for (int c = 0; c < NC; ++c) {
        float b0[8], b1[8]; float a0 = 0.f, a1 = 0.f;
#pragma unroll
        for (int i = 0; i < 8; ++i) { a0 += gx[i].x; a1 += gx[i].y; b0[i] = a0; b1[i] = a1; }
        *(LAS v2f*)(lds + OFF_SEG + (seg * 128 + 2 * dkp) * 4) = (v2f){a0, a1};
        HG_LBAR();
        float pre0 = 0.f, pre1 = 0.f, mid0 = 0.f, mid1 = 0.f, last0 = 0.f, last1 = 0.f;
#pragma unroll
        for (int sg = 0; sg < 8; ++sg) { const v2f sv = *(const LAS v2f*)(lds + OFF_SEG + (sg * 128 + 2 * dkp) * 4);
            if (sg < seg) { pre0 += sv.x; pre1 += sv.y; } if (sg < 4) { mid0 += sv.x; mid1 += sv.y; } last0 += sv.x; last1 += sv.y; }
#pragma unroll
        for (int i = 0; i < 8; ++i) {
            const int t = 8 * seg + i;
            const float bb0 = b0[i] + pre0, bb1 = b1[i] + pre1;
            const float k0 = 1.f - fexp2(gx[i].x * LOG2E), k1 = 1.f - fexp2(gx[i].y * LOG2E), q0 = bflo(qx[i]), q1 = bfhi(qx[i]);
            *(LAS unsigned*)(lds + OFF_QT + t * RP + 4 * dkp) = fa::cvtpk(q0 * fexp2((bb0 - mid0) * LOG2E), q1 * fexp2((bb1 - mid1) * LOG2E));
            *(LAS unsigned*)(lds + OFF_KT + t * RP + 4 * dkp) = fa::cvtpk(k0 * fexp2((mid0 - bb0) * LOG2E), k1 * fexp2((mid1 - bb1) * LOG2E));
            *(LAS unsigned*)(lds + OFF_QS + t * RP + 4 * dkp) = fa::cvtpk(q0 * fexp2(bb0 * LOG2E), q1 * fexp2(bb1 * LOG2E));
            *(LAS unsigned*)(lds + OFF_KS + t * RP + 4 * dkp) = fa::cvtpk(k0 * fexp2((last0 - bb0) * LOG2E), k1 * fexp2((last1 - bb1) * LOG2E));
            *(LAS unsigned*)(lds + OFF_V + (dkp >> 4) * 4096 + t * 64 + (dkp & 15) * 4) = vx[i];
        }
        if (seg == 0) *(LAS v2f*)(lds + OFF_DEC + 8 * dkp) = (v2f){fexp2(last0 * LOG2E), fexp2(last1 * LOG2E)};
        if (c + 1 < NC) HG_LOAD(c + 1);
        HG_LBAR();
        v4u ogw0 = {0u, 0u, 0u, 0u}, ogw1 = ogw0, zw0 = ogw0, zw1 = ogw0;
        { const int tc = tid >> 3, cgc = tid & 7;
          if (tc < T) { const size_t rowc = (size_t)row0 + 64 * c + tc; const v4u* ogq = (const v4u*)(P + rowc * NIN + C_OG + h * 128 + 16 * cgc); const v4u* zq = (const v4u*)(P + rowc * NIN + C_ZB + h * 128 + 16 * cgc);
              ogw0 = ogq[0]; ogw1 = ogq[1]; zw0 = zq[0]; zw1 = zq[1]; } }
        f32x16 X[2];
#pragma unroll
        for (int sb = 0; sb < 2; ++sb) {
#pragma unroll
            for (int e = 0; e < 16; ++e) X[sb][e] = 0.f;
            if (sb <= tb) {
#pragma unroll
                for (int d0 = 0; d0 < 8; ++d0) {
                    const bf16x8 ka = *(const LAS bf16x8*)(lds + OFF_KT + (32 * sb + r) * RP + (16 * d0 + 8 * hh) * 2);
                    const bf16x8 qb = *(const LAS bf16x8*)(lds + OFF_QT + (32 * tb + r) * RP + (16 * d0 + 8 * hh) * 2);
                    X[sb] = __builtin_amdgcn_mfma_f32_32x32x16_bf16(ka, qb, X[sb], 0, 0, 0);
                }
                if (sb == tb) {
#pragma unroll
                    for (int e = 0; e < 16; ++e) X[sb][e] = crow(e, hh) > r ? 0.f : X[sb][e];
                }
            }
        }
        f32x16 o;
#pragma unroll
        for (int e = 0; e < 16; ++e) o[e] = 0.f;
        { const LAS unsigned char* vp = lds + OFF_V + j * 4096 + g16 * 32 + p4 * 8 + (4 * hh + q4) * 64;
#pragma unroll
          for (int sb = 0; sb < 2; ++sb) if (sb <= tb) {
#pragma unroll
              for (int s2 = 0; s2 < 2; ++s2) {
                  const bf16x8 pf = pack8(X[sb], 8 * s2);
                  const s16x4 lo = vtr(vp + (32 * sb + 16 * s2) * 64), hi = vtr(vp + (32 * sb + 16 * s2) * 64 + 512);
                  const bf16x8 vf = __builtin_shufflevector(lo, hi, 0, 1, 2, 3, 4, 5, 6, 7);
                  o = __builtin_amdgcn_mfma_f32_32x32x16_bf16(pf, vf, o, 0, 0, 0);
              } } }
#pragma unroll
        for (int i = 0; i < 4; ++i)
#pragma unroll
            for (int s2 = 0; s2 < 2; ++s2) {
                const LAS unsigned char* ap = lds + OFF_QS + (32 * tb + r) * RP + (32 * i + 16 * s2 + 4 * hh) * 2;
                const v2u alo = *(const LAS v2u*)ap, ahi = *(const LAS v2u*)(ap + 16);
                const v4u a4 = {alo.x, alo.y, ahi.x, ahi.y};
                o = __builtin_amdgcn_mfma_f32_32x32x16_bf16(__builtin_bit_cast(bf16x8, a4), pack8(S[i], 8 * s2), o, 0, 0, 0);
            }
#pragma unroll
        for (int e = 0; e < 16; ++e) *(LAS float*)(lds + OFF_OX + ((32 * tb + crow(e, hh)) * 128 + 32 * j + r) * 4) = o[e];
#pragma unroll
        for (int i = 0; i < 4; ++i)
#pragma unroll
            for (int k4 = 0; k4 < 4; ++k4) { const v4f dq = *(const LAS v4f*)(lds + OFF_DEC + (32 * i + 8 * k4 + 4 * hh) * 4);
                S[i][4 * k4] *= dq.x; S[i][4 * k4 + 1] *= dq.y; S[i][4 * k4 + 2] *= dq.z; S[i][4 * k4 + 3] *= dq.w; }
#pragma unroll
        for (int ks = 0; ks < 4; ++ks) {
            const LAS unsigned char* vq = lds + OFF_V + j * 4096 + (16 * ks + 8 * hh + q4) * 64 + g16 * 32 + p4 * 8;
            const s16x4 vlo = vtr(vq), vhi = vtr(vq + 256);
            const bf16x8 vb = __builtin_shufflevector(vlo, vhi, 0, 1, 2, 3, 4, 5, 6, 7);
#pragma unroll
            for (int i = 0; i < 4; ++i) {
                const LAS unsigned char* kq = lds + OFF_KS + (16 * ks + 8 * hh + q4) * RP + (32 * i + 16 * g16 + 4 * p4) * 2;
                const s16x4 klo = vtr(kq), khi = vtr(kq + 4 * RP);
                const bf16x8 ka = __builtin_shufflevector(klo, khi, 0, 1, 2, 3, 4, 5, 6, 7);
                S[i] = __builtin_amdgcn_mfma_f32_32x32x16_bf16(ka, vb, S[i], 0, 0, 0);
            }
        }
        HG_LBAR();
        {
            const int t = tid >> 3, cg = tid & 7;
            const LAS v4f* ox = (const LAS v4f*)(lds + OFF_OX + (t * 128 + 16 * cg) * 4);
            const v4f x0 = ox[0], x1 = ox[1], x2 = ox[2], x3 = ox[3];
            float ss = (x0.x * x0.x + x0.y * x0.y + x0.z * x0.z + x0.w * x0.w) + (x1.x * x1.x + x1.y * x1.y + x1.z * x1.z + x1.w * x1.w)
                     + (x2.x * x2.x + x2.y * x2.y + x2.z * x2.z + x2.w * x2.w) + (x3.x * x3.x + x3.y * x3.y + x3.z * x3.z + x3.w * x3.w);
            ss += __shfl_xor(ss, 1); ss += __shfl_xor(ss, 2); ss += __shfl_xor(ss, 4);
            if (t < T) {
                const float inv = 1.0f / sqrtf(ss * (1.0f / 128.0f) + NORM_EPS);
                const size_t row = (size_t)row0 + 64 * c + t;
                const float* gn = HGRN_NORM + h * 128 + 16 * cg;
                bf16* yp = Y_ + row * YLD + C_YB + h * 128 + 16 * cg;
                const float og[16] = {bflo(ogw0.x), bfhi(ogw0.x), bflo(ogw0.y), bfhi(ogw0.y), bflo(ogw0.z), bfhi(ogw0.z), bflo(ogw0.w), bfhi(ogw0.w), bflo(ogw1.x), bfhi(ogw1.x), bflo(ogw1.y), bfhi(ogw1.y), bflo(ogw1.z), bfhi(ogw1.z), bflo(ogw1.w), bfhi(ogw1.w)};
                const float z[16] = {bflo(zw0.x), bfhi(zw0.x), bflo(zw0.y), bfhi(zw0.y), bflo(zw0.z), bfhi(zw0.z), bflo(zw0.w), bfhi(zw0.w), bflo(zw1.x), bfhi(zw1.x), bflo(zw1.y), bfhi(zw1.y), bflo(zw1.z), bfhi(zw1.z), bflo(zw1.w), bfhi(zw1.w)};
                const float xv[16] = {x0.x, x0.y, x0.z, x0.w, x1.x, x1.y, x1.z, x1.w, x2.x, x2.y, x2.z, x2.w, x3.x, x3.y, x3.z, x3.w};
                float y[16];
#pragma unroll
                for (int e = 0; e < 16; ++e) y[e] = xv[e] * inv * gn[e] * og[e] * z[e];
                st8bf(yp, *(float(*)[8])y); st8bf(yp + 8, *(float(*)[8])(y + 8));
            }
        }
    }
    if (tb == 0) {
#pragma unroll
        for (int i = 0; i < 4; ++i)
#pragma unroll
            for (int e = 0; e < 16; ++e) sout[(size_t)(32 * i + crow(e, hh)) * 128 + 32 * j + r] = S[i][e];
    }
    HG_BAR();
#undef HG_LOAD
}
}

namespace ca {
using fa::bf16x8; using fa::s16x4; using fa::f32x16; using fa::crow; using fa::pack8; using fa::vtr;
constexpr int KT = 16384, BUF = 32768, WSF_OFF = RING_BYTES + 1024;
DI void load_tile(LAS unsigned char* buf, const bf16* Kg, const bf16* Vg, int kv0, int wave, int lane) {
#pragma unroll
    for (int i = 0; i < 2; ++i) { const int pc = 2 * wave + i;
        glds16(Kg + (size_t)(kv0 + (lane & 31)) * 2048 + (2 * pc + (lane >> 5)) * 8, lds_addr(buf + pc * 1024)); }
#pragma unroll
    for (int i = 0; i < 2; ++i) { const int pc = 2 * wave + i;
        glds16(Vg + (size_t)(kv0 + 16 * (pc & 1) + (lane >> 2)) * 2048 + (pc >> 1) * 32 + (lane & 3) * 8, lds_addr(buf + KT + (pc >> 1) * 2048 + (pc & 1) * 1024)); }
}
DI void cross_unit(Ctx A_, LAS unsigned char* lds, int kvb, int hc, size_t row0, int nrows, int wave, int lane) {
    const int r = lane & 31, hh = lane >> 5, rg = wave & 3, dvh = wave >> 2;
    bf16* P = P_;
    const bf16* Kg = MKV_ + (size_t)kvb * NMEM * 2048 + hc * 256; const bf16* Vg = Kg + 1024;
    LAS float* wsf = (LAS float*)(lds + WSF_OFF) + wave * 128;
    const bool act = rg * 32 < nrows;
    load_tile(lds, Kg, Vg, 0, wave, lane);
    bf16x8 qr[16];
    { const bf16* Qg = P + (row0 + rg * 32 + r) * NIN + C_QC + hc * 256 + hh * 8;
#pragma unroll
      for (int d0 = 0; d0 < 16; ++d0) qr[d0] = *(const bf16x8*)(Qg + d0 * 16); }
    asm volatile("" : "+v"(qr[0]), "+v"(qr[1]), "+v"(qr[2]), "+v"(qr[3]), "+v"(qr[4]), "+v"(qr[5]), "+v"(qr[6]), "+v"(qr[7]), "+v"(qr[8]), "+v"(qr[9]), "+v"(qr[10]), "+v"(qr[11]), "+v"(qr[12]), "+v"(qr[13]), "+v"(qr[14]), "+v"(qr[15]));
    f32x16 o[4];
#pragma unroll
    for (int nb = 0; nb < 4; ++nb)
#pragma unroll
        for (int i = 0; i < 16; ++i) o[nb][i] = 0.f;
    float m = -INFINITY, l = 0.f;
    const int g16 = (lane >> 4) & 1, p4 = lane & 3, q4 = (lane & 15) >> 2;
#pragma unroll 1
    for (int t = 0; t < 8; ++t) {
        asm volatile("s_waitcnt vmcnt(0) lgkmcnt(0)" ::: "memory"); __builtin_amdgcn_s_barrier(); asm volatile("" ::: "memory");
        if (t + 1 < 8) load_tile(lds + ((t + 1) & 1) * BUF, Kg, Vg, (t + 1) * 32, wave, lane);
        if (act) {
            const LAS unsigned char* buf = lds + (t & 1) * BUF;
            const LAS unsigned char* kb = buf + hh * 512 + r * 16;
            f32x16 p0;
#pragma unroll
            for (int i = 0; i < 16; ++i) p0[i] = 0.f;
#pragma unroll
            for (int d0 = 0; d0 < 16; ++d0) p0 = __builtin_amdgcn_mfma_f32_32x32x16_bf16(*(const LAS bf16x8*)(kb + d0 * 1024), qr[d0], p0, 0, 0, 0);
            float tm = p0[0];
#pragma unroll
            for (int i = 1; i < 16; ++i) tm = fmaxf(tm, p0[i]);
            tm = fmaxf(tm, __shfl_xor(tm, 32));
            if (__any(tm > m + RESC_THR)) {
                const float mn = fmaxf(m, tm), f = fexp2(m - mn); m = mn; l *= f;
                if (hh == 0) wsf[r] = f;
                float fr[16];
#pragma unroll
                for (int i = 0; i < 16; ++i) fr[i] = wsf[crow(i, hh)];
#pragma unroll
                for (int nb = 0; nb < 4; ++nb)
#pragma unroll
                    for (int i = 0; i < 16; ++i) o[nb][i] *= fr[i];
            }
            float ls = 0.f;
#pragma unroll
            for (int i = 0; i < 16; ++i) { p0[i] = fexp2(p0[i] - m); ls += p0[i]; }
            l += ls;
            const bf16x8 pf0 = pack8(p0, 0), pf1 = pack8(p0, 8);
            const LAS unsigned char* vp = buf + KT + dvh * 8192 + g16 * 32 + p4 * 8 + (4 * hh + q4) * 64;
#pragma unroll
            for (int ks = 0; ks < 2; ++ks)
#pragma unroll
                for (int nb = 0; nb < 4; ++nb) {
                    const s16x4 lo = vtr(vp + nb * 2048 + ks * 1024), hi = vtr(vp + nb * 2048 + ks * 1024 + 512);
                    const bf16x8 vf = __builtin_shufflevector(lo, hi, 0, 1, 2, 3, 4, 5, 6, 7);
                    o[nb] = __builtin_amdgcn_mfma_f32_32x32x16_bf16(ks == 0 ? pf0 : pf1, vf, o[nb], 0, 0, 0);
                }
        }
    }
    if (act) {
        l += __shfl_xor(l, 32);
        if (hh == 0) wsf[32 + r] = l;
        float rl[16];
#pragma unroll
        for (int i = 0; i < 16; ++i) rl[i] = 1.0f / wsf[32 + crow(i, hh)];
#pragma unroll
        for (int nb = 0; nb < 4; ++nb)
#pragma unroll
            for (int i = 0; i < 16; ++i) {
                const int q = rg * 32 + crow(i, hh);
                if (q < nrows) { const size_t eo = (row0 + q) * NIN + hc * 256 + dvh * 128 + nb * 32 + r; Y_[(row0 + q) * YLD + C_YC + hc * 256 + dvh * 128 + nb * 32 + r] = (bf16)f2bf(o[nb][i] * rl[i] * bf2f(P[eo + C_ZC])); }
            }
    }
    asm volatile("s_waitcnt vmcnt(0) lgkmcnt(0)" ::: "memory"); __builtin_amdgcn_s_barrier(); asm volatile("" ::: "memory");
}
}

namespace da {
using fa::bf16x8; using fa::s16x4; using fa::f32x16; using fa::crow; using fa::pack8; using fa::vtr;
constexpr int CS = 528, KR = 16 * CS, PS = 2080, VR = 4 * PS, VOFF = 34816, WSF_OFF = RING_BYTES + 1024;
constexpr int EX_OFF = 0, MX_OFF = 65536, LX_OFF = 65536 + 1024, X2_OFF = 65536 + 2048;
static_assert(VOFF >= 4 * KR && VOFF + 4 * VR <= RING_BYTES && X2_OFF + 8192 <= RING_BYTES, "decode lds map");
#define DA_BAR() do { asm volatile("s_waitcnt lgkmcnt(0)" ::: "memory"); __builtin_amdgcn_s_barrier(); asm volatile("" ::: "memory"); } while (0)
DI void decode_unit(Ctx A_, LAS unsigned char* lds, int b, int h, float lam, int wave, int lane, int tid) {
    const int r = lane & 31, hh = lane >> 5, mp = wave >> 2, kr = wave & 3;
    bf16* P = P_;
    LAS float* wsf = (LAS float*)(lds + WSF_OFF) + wave * 128;
    const float* Kc = CACHE_K + ((size_t)b * PAST * 8 + h) * 128; const float* Vc = CACHE_V + ((size_t)b * PAST * 8 + h) * 128;
    const size_t rowq = (size_t)MP + b * DS;
    v4f kx[8], vx[8];
    const unsigned voff = (unsigned)((tid >> 5) * 1024 + (tid & 31) * 4);
#define DA_LOAD(st) do { const float* kb_ = Kc + (size_t)(st) * 131072; const float* vb_ = Vc + (size_t)(st) * 131072; \
        _Pragma("unroll") for (int i = 0; i < 8; ++i) { kx[i] = __builtin_nontemporal_load((const v4f*)(kb_ + i * 16384 + voff)); vx[i] = __builtin_nontemporal_load((const v4f*)(vb_ + i * 16384 + voff)); } } while (0)
    DA_LOAD(0);
    const int c4_ = tid & 31, kk_ = tid >> 5;
    LAS unsigned char* kw = lds + (c4_ >> 1) * CS + kk_ * 16 + (c4_ & 1) * 8;
    LAS unsigned char* vw = lds + VOFF + (c4_ >> 3) * PS + kk_ * 64 + (c4_ & 7) * 8;
    bf16x8 qr[4];
    { const bf16* Qg = P + (rowq + (r & 15)) * NIN + C_QA + h * 128 + mp * 64 + hh * 8;
#pragma unroll
      for (int d0 = 0; d0 < 4; ++d0) { const v4u w = *(const v4u*)(Qg + d0 * 16); const v4u z = {0u, 0u, 0u, 0u}; qr[d0] = __builtin_bit_cast(bf16x8, r < 16 ? w : z); } }
    f32x16 o[4];
#pragma unroll
    for (int nb = 0; nb < 4; ++nb)
#pragma unroll
        for (int i = 0; i < 16; ++i) o[nb][i] = 0.f;
    float m = -INFINITY, l = 0.f;
    const int g16 = (lane >> 4) & 1, p4 = lane & 3, q4 = (lane & 15) >> 2;
#pragma unroll 1
    for (int st = 0; st <= PAST / 128; ++st) {
        const bool last = st == PAST / 128;
        v4u nw = {0u, 0u, 0u, 0u};
        if (last) {
            const int t2 = tid & 255, key = t2 >> 4, c8 = t2 & 15;
            nw = *(const v4u*)(P + (rowq + key) * NIN + (tid < 256 ? C_KA : C_VA) + h * 128 + c8 * 8);
        }
        DA_BAR();
        if (!last) {
#pragma unroll
            for (int i = 0; i < 8; ++i) {
                *(LAS v2u*)(kw + (i >> 1) * KR + (i & 1) * 256) = (v2u){fa::cvtpk(kx[i].x, kx[i].y), fa::cvtpk(kx[i].z, kx[i].w)};
                *(LAS v2u*)(vw + (i >> 1) * VR + (i & 1) * 1024) = (v2u){fa::cvtpk(vx[i].x, vx[i].y), fa::cvtpk(vx[i].z, vx[i].w)}; }
            if (st + 1 < PAST / 128) DA_LOAD(st + 1);
        } else {
            const int t2 = tid & 255, key = t2 >> 4, c8 = t2 & 15;
            if (tid < 256) *(LAS v4u*)(lds + c8 * CS + key * 16) = nw;
            else *(LAS v4u*)(lds + VOFF + (c8 >> 2) * PS + key * 64 + (c8 & 3) * 16) = nw;
        }
        DA_BAR();
        if (!last || kr == 0) {
            const LAS unsigned char* kb = lds + kr * KR + (mp * 8 + hh) * CS + r * 16;
            f32x16 p0;
#pragma unroll
            for (int i = 0; i < 16; ++i) p0[i] = 0.f;
#pragma unroll
            for (int d0 = 0; d0 < 4; ++d0) p0 = __builtin_amdgcn_mfma_f32_32x32x16_bf16(*(const LAS bf16x8*)(kb + d0 * 2 * CS), qr[d0], p0, 0, 0, 0);
            if (last) {
#pragma unroll
                for (int i = 8; i < 16; ++i) p0[i] = -INFINITY;
            }
            float tm = p0[0];
#pragma unroll
            for (int i = 1; i < 16; ++i) tm = fmaxf(tm, p0[i]);
            tm = fmaxf(tm, __shfl_xor(tm, 32));
            if (__any(tm > m + RESC_THR)) {
                const float mn = fmaxf(m, tm), f = fexp2(m - mn); m = mn; l *= f;
                if (hh == 0) wsf[r] = f;
                float fr[16];
#pragma unroll
                for (int i = 0; i < 16; ++i) fr[i] = wsf[crow(i, hh)];
#pragma unroll
                for (int nb = 0; nb < 4; ++nb)
#pragma unroll
                    for (int i = 0; i < 16; ++i) o[nb][i] *= fr[i];
            }
            float ls = 0.f;
#pragma unroll
            for (int i = 0; i < 16; ++i) { p0[i] = fexp2(p0[i] - m); ls += p0[i]; }
            l += ls;
            const bf16x8 pf0 = pack8(p0, 0), pf1 = pack8(p0, 8);
            const LAS unsigned char* vp = lds + VOFF + kr * VR + g16 * 32 + p4 * 8 + (4 * hh + q4) * 64;
#pragma unroll
            for (int ks = 0; ks < 2; ++ks)
#pragma unroll
                for (int nb = 0; nb < 4; ++nb) {
                    const s16x4 lo = vtr(vp + nb * PS + ks * 1024), hi = vtr(vp + nb * PS + ks * 1024 + 512);
                    const bf16x8 vf = __builtin_shufflevector(lo, hi, 0, 1, 2, 3, 4, 5, 6, 7);
                    o[nb] = __builtin_amdgcn_mfma_f32_32x32x16_bf16(ks == 0 ? pf0 : pf1, vf, o[nb], 0, 0, 0);
                }
        }
    }
    l += __shfl_xor(l, 32);
    int r_e = r; asm volatile("" : "+v"(r_e));
    float lam_e = lam; asm volatile("" : "+v"(lam_e));
    DA_BAR();
    LAS float* MX = (LAS float*)(lds + MX_OFF); LAS float* LX = (LAS float*)(lds + LX_OFF); LAS float* EX = (LAS float*)(lds + EX_OFF);
    if (hh == 0) MX[wave * 32 + r] = m;
    DA_BAR();
    { const float mg = fmaxf(fmaxf(MX[(mp * 4 + 0) * 32 + r], MX[(mp * 4 + 1) * 32 + r]), fmaxf(MX[(mp * 4 + 2) * 32 + r], MX[(mp * 4 + 3) * 32 + r]));
      const float f = fexp2(m - mg); l *= f;
      if (hh == 0) { wsf[r] = f; LX[wave * 32 + r] = l; }
      float fr[8];
#pragma unroll
      for (int i = 0; i < 8; ++i) fr[i] = wsf[crow(i, hh)];
#pragma unroll
      for (int nb = 0; nb < 4; ++nb)
#pragma unroll
          for (int i = 0; i < 8; ++i) EX[wave * 2048 + (nb * 8 + i) * 64 + lane] = o[nb][i] * fr[i]; }
    DA_BAR();
    float acc[4][8];
    if (kr == 0) {
        float li[8];
#pragma unroll
        for (int i = 0; i < 8; ++i) { const int q = crow(i, hh); li[i] = (mp == 0 ? 1.0f : lam_e) / ((LX[(mp * 4 + 0) * 32 + q] + LX[(mp * 4 + 1) * 32 + q]) + (LX[(mp * 4 + 2) * 32 + q] + LX[(mp * 4 + 3) * 32 + q])); }
#pragma unroll
        for (int nb = 0; nb < 4; ++nb)
#pragma unroll
            for (int i = 0; i < 8; ++i) { const int e = (nb * 8 + i) * 64 + lane;
                acc[nb][i] = ((EX[(mp * 4 + 0) * 2048 + e] + EX[(mp * 4 + 1) * 2048 + e]) + (EX[(mp * 4 + 2) * 2048 + e] + EX[(mp * 4 + 3) * 2048 + e])) * li[i]; }
        if (mp == 1) {
#pragma unroll
            for (int nb = 0; nb < 4; ++nb)
#pragma unroll
                for (int i = 0; i < 8; ++i) *(LAS float*)(lds + X2_OFF + ((nb * 8 + i) * 64 + lane) * 4) = acc[nb][i];
        }
    }
    DA_BAR();
    if (kr == 0 && mp == 0) {
        float ssq[8];
#pragma unroll
        for (int i = 0; i < 8; ++i) ssq[i] = 0.f;
#pragma unroll
        for (int nb = 0; nb < 4; ++nb)
#pragma unroll
            for (int i = 0; i < 8; ++i) { const float d = acc[nb][i] - *(const LAS float*)(lds + X2_OFF + ((nb * 8 + i) * 64 + lane) * 4); acc[nb][i] = d; ssq[i] += d * d; }
#pragma unroll
        for (int i = 0; i < 8; ++i) { float v = ssq[i];
#pragma unroll
            for (int x = 1; x < 32; x <<= 1) v += __shfl_xor(v, x);
            ssq[i] = ONE_M_LAMINIT / sqrtf(v * (1.0f / 128.0f) + NORM_EPS); }
#pragma unroll
        for (int nb = 0; nb < 4; ++nb) { const float sn = SUB_NORM[nb * 32 + r_e];
#pragma unroll
            for (int i = 0; i < 8; ++i) { const size_t rw = rowq + crow(i, hh); Y_[rw * YLD + C_YA + h * 128 + nb * 32 + r_e] = (bf16)f2bf(acc[nb][i] * ssq[i] * sn * bf2f(P[rw * NIN + C_ZA + h * 128 + nb * 32 + r_e])); } }
    }
    DA_BAR();
#undef DA_LOAD
}
}

DI int tid_now() { int t; asm volatile("v_mov_b32 %0, %1" : "=v"(t) : "v"((int)threadIdx.x)); return t; }
__global__ void __launch_bounds__(512, 2) fwd(Args args) {
    extern __shared__ __attribute__((aligned(16))) unsigned char lds_raw[];
    LAS unsigned char* lds = (LAS unsigned char*)lds_raw;
    const int G = gridDim.x, NGW = G * 8;
    const Args& A_ = args;
#define TIDS() const int tid = tid_now(), lane = tid & 63, wave = __builtin_amdgcn_readfirstlane(tid >> 6), gw = blockIdx.x * 8 + wave; (void)lane; (void)gw;
    const int lo = args.ph_lo, hi = args.ph_hi;
#define IN(k) (lo <= (k) && (k) < hi)
#ifdef PROBE_PH
#define PROBE_T0(k) unsigned long long pt0_ = 0; if ((k) == PROBE_PH) pt0_ = __builtin_amdgcn_s_memrealtime();
#define PROBE_SPIN_EPI(code, slot) if ((code) == PROBE_PH) { const unsigned ticks_ = *(volatile LAS unsigned*)(lds + 131072 + 512 + wave * 8 + (slot) * 4); const unsigned long long ps_ = __builtin_amdgcn_s_memrealtime(); while (__builtin_amdgcn_s_memrealtime() - ps_ < ticks_) __builtin_amdgcn_s_sleep(16); }
#define PROBE_SPIN_U(code, slot) if ((code) == PROBE_PH) { const unsigned ticks_ = *(volatile LAS unsigned*)(lds + 131072 + 640 + wave * 32 + (slot) * 4); const unsigned long long ps_ = __builtin_amdgcn_s_memrealtime(); while (__builtin_amdgcn_s_memrealtime() - ps_ < ticks_) __builtin_amdgcn_s_sleep(16); }
#define PROBE_ZERO() { for (int z_ = 0; z_ < 8; ++z_) *(volatile LAS unsigned*)(lds + 131072 + 640 + wave * 32 + z_ * 4) = 0u;  *(volatile LAS unsigned*)(lds + 131072 + 512 + wave * 8) = 0u; *(volatile LAS unsigned*)(lds + 131072 + 512 + wave * 8 + 4) = 0u; }
#define PROBE_F0(k) unsigned long long pf0c_ = 0, pf0r_ = 0; if ((k) == PROBE_PH) { pf0c_ = __builtin_readcyclecounter(); pf0r_ = __builtin_amdgcn_s_memrealtime(); }
#define PROBE_F1(k) if ((k) == PROBE_PH) { const unsigned long long dc_ = __builtin_readcyclecounter() - pf0c_, dr_ = __builtin_amdgcn_s_memrealtime() - pf0r_; const unsigned long long spin_ = dc_ * 2000ull / (dr_ ? dr_ : 1ull); \
        const unsigned long long ps_ = __builtin_amdgcn_s_memrealtime(); while (__builtin_amdgcn_s_memrealtime() - ps_ < spin_) __builtin_amdgcn_s_sleep(16); }
#define PROBE_T1(k) if ((k) == PROBE_PH) { const unsigned long long pt1_ = __builtin_amdgcn_s_memrealtime(); while (__builtin_amdgcn_s_memrealtime() - pt1_ < pt1_ - pt0_) __builtin_amdgcn_s_sleep(16); }
#else
#define PROBE_F0(k)
#define PROBE_F1(k)
#define PROBE_T0(k)
#define PROBE_T1(k)
#define PROBE_SPIN_EPI(code, slot)
#define PROBE_SPIN_U(code, slot)
#define PROBE_ZERO()
#endif
#define BOTH(k) (IN(k) && IN((k) + 1))

    for (int u = threadIdx.x; u < (LDS_BYTES - LDSCTL_OFF) / 4; u += 512) ((LAS unsigned*)(lds + LDSCTL_OFF))[u] = 0u;
    __syncthreads();
    XcdBarrier bar; bar.bar = (unsigned*)WS_(WS_CTL) + CW_BAR + args.li * XCD_BAR_WORDS; bar.x = 0; bar.st = nullptr;
    if (hi - lo > 1) bar = xcd_barrier_post((unsigned*)WS_(WS_CTL) + CW_BAR + args.li * XCD_BAR_WORDS, (volatile LAS unsigned*)(lds + MISC_OFF) + 8);

    if (IN(0)) { PROBE_T0(0) TIDS()
        LAS float* scr = (LAS float*)(lds + wave * 16384);
        constexpr int I_IN = 32 * 544, I_MK = 32 * 32, I_BR = 16 * 64, I_O = 32 * 64;
        constexpr int NIT = I_IN + 2 * I_MK + 3 * I_BR + I_O;
        for (int it = gw; it < NIT; it += NGW) {
            int r = it;
            if (r < I_IN) { p0_transpose_item(W_IN, D, NIN, WT_, 0, scr, r, lane); continue; } r -= I_IN;
            if (r < I_MK) { p0_transpose_item(W_MEM_K, D, 1024, WT_, NIN, scr, r, lane); continue; } r -= I_MK;
            if (r < I_MK) { p0_transpose_item(W_MEM_V, D, 1024, WT_, NIN + 1024, scr, r, lane); continue; } r -= I_MK;
            if (r < I_BR) { p0_transpose_item(W_A, 1024, D, WABC_, 0, scr, r, lane, 3072, 0); continue; } r -= I_BR;
            if (r < I_BR) { p0_transpose_item(W_B, 1024, D, WABC_, 0, scr, r, lane, 3072, 1024); continue; } r -= I_BR;
            if (r < I_BR) { p0_transpose_item(W_C, 1024, D, WABC_, 0, scr, r, lane, 3072, 2048); continue; } r -= I_BR;
            p0_transpose_item(W_OUT, D, D, WO_, 0, scr, r, lane);
        }
        for (int m = gw; m < M + 2048; m += NGW) {
            const float* src = m < MP ? X_PROMPT + (size_t)m * D : (m < M ? X_SAMPLE + (size_t)(m - MP) * D : MEM_PROMPT + (size_t)(m - M) * D);
            p0_row_to_bf16(src, XB_ + (size_t)m * D, lane);
        }
        for (int i = blockIdx.x * 512 + tid; i < (PAST + DS) * 8; i += G * 512) p0_rope_entry(ROPE_, i);
        for (int it = gw; it < DB * NMEM * 2; it += NGW) {
            const int row = it >> 1, kv = it & 1;
            const v4f* src = (const v4f*)((kv ? CACHE_MV : CACHE_MK) + (size_t)row * 1024) + lane; v2u* dst = (v2u*)(MKV_ + (size_t)(2048 + row) * 2048 + kv * 1024) + lane;
#pragma unroll
            for (int j = 0; j < 4; ++j) { const v4f v = src[64 * j]; dst[64 * j] = (v2u){pk2(v.x, v.y), pk2(v.z, v.w)}; }
        }
        PROBE_T1(0)
        if (BOTH(0)) xcd_barrier(bar);
    }

    if (IN(1)) {
        pg8::GemmT<0, 0, 0> g{(const char*)XB_, (const char*)WT_, D, D, D, 0};
        InProjOrder S{G, (int)blockIdx.x};
        EpiIn E{P_, G_, OUT_, MKV_, LB_LOGITS, ROPE_, KC_, VC_};
        { const int wave = __builtin_amdgcn_readfirstlane(threadIdx.x >> 6); (void)wave; PROBE_ZERO() PROBE_F0(101) PROBE_T0(1) pg8::gemm_phase<EpiIn, InProjOrder, true, true>(lds, g, S, E); PROBE_T1(1) PROBE_F1(101) PROBE_SPIN_EPI(13, 0) }
        if (BOTH(1)) xcd_barrier(bar);
    }

    if (IN(2)) { TIDS()
        const float lam = __int_as_float(__builtin_amdgcn_readfirstlane(__float_as_int(lam_of(A_, lane))));
        PROBE_T0(2)
        unsigned* qctr = (unsigned*)WS_(WS_CTL) + CW_QUEUE;
        volatile LAS unsigned* qw = (volatile LAS unsigned*)(lds + LDSCTL_OFF + 64);
        int qit = 0;
#define Q_NEXT(k, id) do { if (tid == 0) qw[qit & 1] = __hip_atomic_fetch_add(qctr + 64 * (k), 1u, __ATOMIC_RELAXED, __HIP_MEMORY_SCOPE_AGENT); __syncthreads(); \
        id = __builtin_amdgcn_readfirstlane((int)qw[qit & 1]); ++qit; } while (0)
        bool had_chain = false;
        { PROBE_T0(21)
#pragma unroll 1
        for (;;) { int id; Q_NEXT(0, id); if (id >= 64 + 256) break; had_chain = had_chain || id < 64; const int tid = tid_now(), lane = tid & 63;
            const bool pr = id < 64; const int sidx = id - 64;
            hg::hgrn_unit(A_, lds, pr ? (id >> 3) * SEQ : MP + (sidx >> 3) * DS, pr ? 64 : DS, pr ? SEQ / 64 : 1, id & 7, pr ? (const float*)nullptr : STATE_HGRN + (size_t)sidx * 16384,
                          pr ? OUT_ + O_HP + (size_t)id * 16384 : OUT_ + O_HS + (size_t)sidx * 16384, wave, lane, tid); }
        PROBE_T1(21) }
        if (!had_chain && (blockIdx.x & 1)) {
#pragma unroll 1
            for (;;) { int id; Q_NEXT(1, id); if (id >= 256) break; const int tid = tid_now(), lane = tid & 63; da::decode_unit(A_, lds, id >> 3, id & 7, lam, wave, lane, tid); }
        }
#pragma unroll 1
        for (;;) { int id; Q_NEXT(2, id); if (id >= 2048) break; const int lane = tid_now() & 63; fa::attn_unit(A_, lds, id >> 8, (id >> 5) & 7, 31 - (id & 31), lam, wave, lane); }
        { PROBE_T0(23)
#pragma unroll 1
        for (;;) { int id; Q_NEXT(3, id); if (id >= 1152) break; const int lane = tid_now() & 63;
            if (id < 1024) { const int qb = id & 31, hc = (id >> 5) & 3, b = id >> 7; ca::cross_unit(A_, lds, b, hc, (size_t)b * SEQ + qb * 128, 128, wave, lane); }
            else { const int sidx = id - 1024, hc = sidx & 3, b = sidx >> 2; ca::cross_unit(A_, lds, 8 + b, hc, (size_t)MP + b * DS, DS, wave, lane); } }
        PROBE_T1(23) }
#undef Q_NEXT
        PROBE_T1(2)
#if defined(PROBE_PH) && PROBE_PH == 200
        { const unsigned long long pa_ = __builtin_amdgcn_s_memrealtime(); xcd_barrier(bar); const unsigned long long pb_ = __builtin_amdgcn_s_memrealtime(); while (__builtin_amdgcn_s_memrealtime() - pb_ < pb_ - pa_) __builtin_amdgcn_s_sleep(16); }
#else
        if (BOTH(2)) xcd_barrier(bar);
#endif
    }

    if (IN(3)) {
        pg8::GemmT<0, 0, 0> g{(const char*)Y_, (const char*)WABC_, YLD, 3072, 3072, 0};
        MergeOrder S{G, (int)blockIdx.x};
        EpiMerge E{P_, MG_};
        { const int wave = __builtin_amdgcn_readfirstlane(threadIdx.x >> 6); (void)wave; PROBE_ZERO() PROBE_F0(103) PROBE_T0(3) pg8::gemm_phase<EpiMerge, MergeOrder, true, true>(lds, g, S, E); PROBE_T1(3) PROBE_F1(103) PROBE_SPIN_EPI(33, 0) PROBE_SPIN_EPI(34, 1) PROBE_SPIN_U(35, 0) PROBE_SPIN_U(36, 1) PROBE_SPIN_U(37, 2) PROBE_SPIN_U(38, 3) PROBE_SPIN_U(39, 4) }
        if (BOTH(3)) xcd_barrier(bar);
    }

    if (IN(4)) {
        pg8::GemmT<0, 0, 0> g{(const char*)MG_, (const char*)WO_, D, D, D, 0};
        OutOrder S{G, (int)blockIdx.x};
        EpiOut E{X_PROMPT, X_SAMPLE, PRE_};
        { const int wave = __builtin_amdgcn_readfirstlane(threadIdx.x >> 6); (void)wave; PROBE_ZERO() PROBE_T0(4) pg8::gemm_phase<EpiOut, OutOrder, true, true>(lds, g, S, E); PROBE_T1(4) PROBE_SPIN_EPI(43, 0) PROBE_SPIN_U(45, 0) PROBE_SPIN_U(46, 1) PROBE_SPIN_U(47, 2) PROBE_SPIN_U(48, 3) PROBE_SPIN_U(49, 4) }
        if (BOTH(4)) xcd_barrier(bar);
    }

    if (IN(5)) { TIDS() PROBE_T0(5) for (int m = gw; m < M; m += NGW) ln_row(A_, m, lane); PROBE_T1(5) }
#undef IN
#undef BOTH
}

extern "C" void kernel_launch(void* const* d_in, const int* in_sizes, int n_in, void* d_out, int out_size, void* d_ws, size_t ws_size, hipStream_t stream) {
    static int grid = 0;
    if (grid == 0) {
        if (n_in != 24 || (size_t)out_size != O_END || ws_size < WS_END2) { fprintf(stderr, "kernel_launch: unexpected shapes (n_in %d out %d ws %zu, need ws %zu); nothing launched\n", n_in, out_size, ws_size, (size_t)WS_END2); grid = -1; return; }
        int dev = 0, cus = 0;
        if (hipGetDevice(&dev) != hipSuccess || hipDeviceGetAttribute(&cus, hipDeviceAttributeMultiprocessorCount, dev) != hipSuccess) { grid = -1; return; }
        if (hipFuncSetAttribute((const void*)fwd, hipFuncAttributeMaxDynamicSharedMemorySize, LDS_BYTES) != hipSuccess) { fprintf(stderr, "kernel_launch: hipFuncSetAttribute failed\n"); grid = -1; return; }
        grid = cus > 0 ? cus : 256;
    }
    if (grid < 0) return;
    if (hipMemsetAsync((char*)d_ws + WS_CTL, 0, CTL_ZERO_BYTES, stream) != hipSuccess) return;
    Args a{};
    for (int i = 0; i < 24; ++i) a.in[i] = (const float*)d_in[i];
    a.out = (float*)d_out; a.ws = (unsigned char*)d_ws;
    a.ph_lo = 0; a.ph_hi = 6; a.li = 0; hipLaunchKernelGGL(fwd, dim3(grid), dim3(512), LDS_BYTES, stream, a);
    const hipError_t le = hipPeekAtLastError();
    if (le != hipSuccess) fprintf(stderr, "kernel_launch: launch failed: %s\n", hipGetErrorName(le));
}
```

```cpp
#include <hip/hip_runtime.h>
#include <cstdio>
#include <cstdint>

#define GAS __attribute__((address_space(1)))
#define LAS __attribute__((address_space(3)))
typedef unsigned short bf16;
typedef unsigned v4u __attribute__((ext_vector_type(4)));
typedef unsigned v2u __attribute__((ext_vector_type(2)));
typedef float v4f __attribute__((ext_vector_type(4)));
typedef float v2f __attribute__((ext_vector_type(2)));
#define DI __device__ __forceinline__

constexpr int D = 2048, NB = 8, SEQ = 4096, MP = NB * SEQ, DB = 32, DS = 16, MS = DB * DS, M = MP + MS, PAST = 4096, NMEM = 256;
constexpr int NIN = 17408, PLD = 11264;
constexpr int C_QA = 0, C_KA = 1024, C_VA = 2048, C_ZA = 3072, C_QB = 4096, C_FB = 5120, C_IB = 6144, C_OG = 7168, C_ZB = 8192, C_QC = 9216, C_ZC = 10240, C_GA = 11264, C_GB = 13312, C_GC = 15360;
constexpr int YLD = 3072, C_YA = 0, C_YB = 1024, C_YC = 2048;
constexpr float LOG2E = 1.4426950408889634f, LN2 = 0.6931471805599453f;
constexpr float QA_SCALE = 0.125f * LOG2E, QC_SCALE = 0.0625f * LOG2E;
constexpr float DN_ALPHA = 1.189207115002721f, NORM_EPS = 1e-5f, ONE_M_LAMINIT = 0.8f, LAM_INIT = 0.2f;
constexpr size_t O_YP = 0, O_YS = (size_t)MP * D, O_KP = O_YS + (size_t)MS * D, O_VP = O_KP + (size_t)MP * 1024, O_HP = O_VP + (size_t)MP * 1024,
                 O_MK = O_HP + (size_t)NB * 8 * 128 * 128, O_MV = O_MK + (size_t)NB * NMEM * 1024, O_KS = O_MV + (size_t)NB * NMEM * 1024, O_VS = O_KS + (size_t)MS * 1024,
                 O_HS = O_VS + (size_t)MS * 1024, O_END = O_HS + (size_t)DB * 8 * 128 * 128;
static_assert(O_END == 145752064ull, "output size");
constexpr size_t MiB = 1u << 20;
constexpr size_t WS_CTL = 0, CTL_ZERO_BYTES = 1 * MiB, WS_ROPE = 1 * MiB, WS_XB = 2 * MiB, WS_WT = 140 * MiB, WS_WABC = 216 * MiB, WS_WO = 228 * MiB, WS_MKV = 374 * MiB,
                 WS_G = 244 * MiB, WS_OB = 374 * MiB, WS_P = 504 * MiB, WS_END = 1609 * MiB, WS_MG = WS_XB, WS_PRE = WS_G, WS_GT = WS_P + (size_t)715 * MiB, WS_Y = 1609 * MiB, WS_KC = 1804 * MiB, WS_VC = 1868 * MiB, WS_END2 = 1932 * MiB;
static_assert(WS_XB + (size_t)(M + 2048) * D * 2 <= WS_WT && WS_WT + (size_t)(NIN + 2048) * D * 2 <= WS_WABC && WS_G + (size_t)M * 1024 * 4 <= WS_OB && WS_OB + (size_t)M * 1024 * 4 <= WS_P && WS_P + (size_t)M * PLD * 2 <= WS_GT && WS_GT + (size_t)3 * M * D * 2 <= WS_END, "ws map");
constexpr int CW_BAR = 4096, CW_QUEUE = 32768;
constexpr int RING_BYTES = 131072, LDSCTL_OFF = RING_BYTES, MISC_OFF = LDSCTL_OFF + 320, LDS_BYTES = 147456;

DI float bf2f(unsigned short u) { return __uint_as_float((unsigned)u << 16); }
DI float bflo(unsigned u) { return __uint_as_float(u << 16); }
DI float bfhi(unsigned u) { return __uint_as_float(u & 0xffff0000u); }
DI unsigned f2bf(float f) { unsigned u = __float_as_uint(f); return (u + 0x7fffu + ((u >> 16) & 1u)) >> 16; }
DI unsigned pk2(float lo, float hi) { return f2bf(lo) | (f2bf(hi) << 16); }
DI float fexp2(float x) { return __builtin_amdgcn_exp2f(x); }
DI float frcp(float x) { return __builtin_amdgcn_rcpf(x); }
DI float sigm(float x) { return frcp(1.0f + fexp2(-x * LOG2E)); }
DI float silu(float x) { return x * sigm(x); }
DI float wave_sum(float v) {
#pragma unroll
    for (int o = 1; o < 64; o <<= 1) v += __shfl_xor(v, o);
    return v;
}
DI float wave_max(float v) {
#pragma unroll
    for (int o = 1; o < 64; o <<= 1) v = fmaxf(v, __shfl_xor(v, o));
    return v;
}

#define XB_TMO      128
#define XB_XCNT(j)  (256  + 64 * (j))
#define XB_XSUB(j)  (1280 + 64 * (j))
#define XB_XGEN(j)  (2304 + 64 * (j))
#define XB_TOP      3328
#define XB_TOPGEN   3392
#define XCD_BAR_WORDS 3456
#define XB_SPIN_CAP (1u << 18)
DI unsigned xb_ld(unsigned* p)              { return __hip_atomic_load(p, __ATOMIC_RELAXED, __HIP_MEMORY_SCOPE_AGENT); }
DI unsigned xb_add(unsigned* p, unsigned v) { return __hip_atomic_fetch_add(p, v, __ATOMIC_RELAXED, __HIP_MEMORY_SCOPE_AGENT); }
DI unsigned xb_xcc_id() { return (unsigned)__builtin_amdgcn_s_getreg((3 << 11) | 20) & 0xFu; }
#define XB_SPIN(cond, bar) do { unsigned _sp = 0; while (cond) { __builtin_amdgcn_s_sleep(1); \
    if ((++_sp & 255u) == 0u) { if (xb_ld(&(bar)[XB_TMO])) break; if (_sp > XB_SPIN_CAP) { atomicAdd(&(bar)[XB_TMO], 1u); break; } } } } while (0)
struct XcdBarrier { unsigned* bar; unsigned x; volatile LAS unsigned* st; };
DI XcdBarrier xcd_barrier_post(unsigned* bar, volatile LAS unsigned* st) {
    XcdBarrier b; b.bar = bar; b.x = xb_xcc_id(); b.st = st;
    if (threadIdx.x == 0) (void)xb_add(&bar[XB_XCNT(b.x)], 1u);
    return b;
}
DI void xcd_barrier_complete(unsigned* bar, unsigned x, unsigned& nloc, unsigned& nx) {
    const unsigned G = gridDim.x * gridDim.y * gridDim.z;
    unsigned sum, cnt, mine, sp = 0u;
    for (;;) {
        sum = 0u; cnt = 0u; mine = 0u;
#pragma unroll
        for (unsigned j = 0; j < 16; ++j) { const unsigned c = xb_ld(&bar[XB_XCNT(j)]); sum += c; cnt += (c > 0u) ? 1u : 0u; mine = (j == x) ? c : mine; }
        if (sum == G) break;
        __builtin_amdgcn_s_sleep(1);
        if ((++sp & 255u) == 0u) { if (xb_ld(&bar[XB_TMO])) break; if (sp > XB_SPIN_CAP) { atomicAdd(&bar[XB_TMO], 1u); break; } }
    }
    nloc = mine > 0u ? mine : 1u; nx = cnt > 0u ? cnt : 1u;
}
DI void xcd_barrier(const XcdBarrier& b) {
    asm volatile("s_waitcnt vmcnt(0)" ::: "memory");
    __syncthreads();
    if (threadIdx.x == 0) {
        unsigned* bar = b.bar;
        __builtin_amdgcn_s_waitcnt(0);
        unsigned nloc = b.st[0], nx = b.st[1];
        if (nloc == 0u) { xcd_barrier_complete(bar, b.x, nloc, nx); b.st[0] = nloc; b.st[1] = nx; }
        const unsigned old = xb_add(&bar[XB_XSUB(b.x)], 1u);
        const unsigned gen = old / nloc;
        if (old + 1u == (gen + 1u) * nloc) {
            __builtin_amdgcn_fence(__ATOMIC_RELEASE, "agent");
            asm volatile("s_waitcnt vmcnt(0)" ::: "memory");
            const unsigned og = xb_add(&bar[XB_TOP], 1u);
            const unsigned tg = og / nx;
            if (og + 1u == (tg + 1u) * nx) xb_add(&bar[XB_TOPGEN], 1u);
            else XB_SPIN(xb_ld(&bar[XB_TOPGEN]) == tg, bar);
            __builtin_amdgcn_fence(__ATOMIC_ACQUIRE, "agent");
            xb_add(&bar[XB_XGEN(b.x)], 1u);
            asm volatile("s_waitcnt vmcnt(0)" ::: "memory");
        } else {
            XB_SPIN(xb_ld(&bar[XB_XGEN(b.x)]) == gen, bar);
            __builtin_amdgcn_fence(__ATOMIC_ACQUIRE, "agent");
            asm volatile("s_waitcnt vmcnt(0)" ::: "memory");
        }
    }
    __syncthreads();
}

#ifdef PROBE_PH
#define PROBE_E0() const unsigned pe0_ = (unsigned)__builtin_amdgcn_s_memrealtime();
#define PROBE_E1(slot) { const unsigned pd_ = (unsigned)__builtin_amdgcn_s_memrealtime() - pe0_; volatile LAS unsigned* pw_ = (volatile LAS unsigned*)(lds + 131072 + 512 + wid * 8 + (slot) * 4); *pw_ = *pw_ + pd_; }
#define PROBE_U0() const unsigned pu0_ = (unsigned)__builtin_amdgcn_s_memrealtime();
#define PROBE_U1(ui) { const unsigned pd_ = (unsigned)__builtin_amdgcn_s_memrealtime() - pu0_; if ((ui) < 8) { volatile LAS unsigned* pw_ = (volatile LAS unsigned*)(lds + 131072 + 640 + wid * 32 + (ui) * 4); *pw_ = pd_; } }
#else
#define PROBE_E0()
#define PROBE_E1(slot)
#define PROBE_U0()
#define PROBE_U1(ui)
#endif
namespace pg8 {
#define PG8_LAS __attribute__((address_space(3)))
typedef unsigned short bf16_t;
typedef short bf16x8 __attribute__((ext_vector_type(8)));
typedef float f32x4 __attribute__((ext_vector_type(4)));
typedef unsigned u32x4 __attribute__((ext_vector_type(4)));
constexpr int BM = 256, BK = 64, HALF = 128, HTB = HALF * BK * 2, STAGE_BYTES = 8 * HTB, NXCD = 8, WGM = 8;
__host__ __device__ __forceinline__ int lds_byte(int r, int c) { const int st = (r >> 4) * 2 + (c >> 5), rr = r & 15, cc = c & 31, ob = rr * 64 + cc * 2; return st * 1024 + (ob ^ (((ob >> 9) & 1) << 5)); }
__host__ __device__ __forceinline__ void stage_rc(int b, int& R, int& C) { const int st = b / 1024, sb = b % 1024, swz = sb ^ (((sb >> 9) & 1) << 5); R = (st >> 1) * 16 + swz / 64; C = (st & 1) * 32 + (swz % 64) / 2; }
__host__ __device__ __forceinline__ int perm32(int rho) { const int n = rho >> 4, i = rho & 15; return 8 * (i >> 2) + 4 * n + (i & 3); }
struct Unit { int pm, pn, br; };
template <int AC0, int AC1, int AC2>
struct GemmT {
    const char* A; const char* Bt; int lda, ldb, K; size_t b_br;
    __device__ __forceinline__ const char* a_ptr(const Unit& u) const { const int ac = u.br == 0 ? AC0 : (u.br == 1 ? AC1 : AC2); return A + ((size_t)u.pm * BM * lda + ac) * 2; }
    __device__ __forceinline__ const char* b_ptr(const Unit& u) const { return Bt + (size_t)u.br * b_br + (size_t)u.pn * BM * ldb * 2; }
};
template <int WGM_ = WGM>
__host__ __device__ __forceinline__ void tile_of(int L, int nM, int nN, int& pm, int& pn) {
    const int nwg = nM * nN; int wgid = L; { const int q = nwg / NXCD, r = nwg % NXCD, xcd = wgid % NXCD, off = wgid / NXCD; wgid = (xcd < r ? xcd * (q + 1) : r * (q + 1) + (xcd - r) * q) + off; }
    const int nig = WGM_ * nN, gid = wgid / nig, fm = gid * WGM_, gsz = (nM - fm) < WGM_ ? (nM - fm) : WGM_;
    pm = fm + ((wgid % nig) % gsz); pn = (wgid % nig) / gsz;
}
__device__ __forceinline__ unsigned cvt_pk_bf16(float lo, float hi) { unsigned r; asm volatile("v_cvt_pk_bf16_f32 %0, %1, %2" : "=v"(r) : "v"(lo), "v"(hi)); return r; }
template <class Epi, class Sched, bool ALIGN_EPI, bool SP2, class Gemm>
__device__ __forceinline__ void gemm_phase(PG8_LAS unsigned char* lds, const Gemm g, const Sched& S, const Epi& E) {
    const int tid = threadIdx.x, wid = __builtin_amdgcn_readfirstlane(tid >> 6), lane = tid & 63, wr = wid >> 2, wc = wid & 3, fr = lane & 15, fq = lane >> 4;
    const int K = g.K, nt = K / BK;
    unsigned voffA[2], voffB[2];
#pragma unroll
    for (int i = 0; i < 2; ++i) { int R, C; stage_rc(tid * 16 + i * 8192, R, C); const int Rb = Epi::PERM ? ((R & ~31) + perm32(R & 31)) : R;
        voffA[i] = (unsigned)(R * g.lda + C) * 2u; voffB[i] = (unsigned)(Rb * g.ldb + C) * 2u; }
    const size_t kstep = (size_t)(BK * 2);
    const size_t hA = (size_t)HALF * g.lda * 2, hB = (size_t)HALF * g.ldb * 2;
    const unsigned ldsw = (unsigned)wid * 1024u;
    const int aoff = lds_byte(wr * 64 + fr, fq * 8), boff = lds_byte(wc * 32 + fr, fq * 8);
#define PG8_SA(b, h) (((b) * 2 + (h)) * HTB)
#define PG8_SB(b, h) ((4 + (b) * 2 + (h)) * HTB)
#define PG8_STAGE(bufoff, gbase, voff) do { _Pragma("unroll") for (int _i = 0; _i < 2; ++_i) \
        __builtin_amdgcn_global_load_lds((const unsigned*)((const char*)(gbase) + (voff)[_i]), (PG8_LAS unsigned*)(lds + (bufoff) + ldsw + _i * 8192), 16, 0, 0); } while (0)
#define PG8_LDA(dst, b, h) do { _Pragma("unroll") for (int m = 0; m < 4; ++m) _Pragma("unroll") for (int k = 0; k < 2; ++k) dst[m][k] = *(const PG8_LAS bf16x8*)(lds + PG8_SA(b, h) + aoff + m * 2048 + k * 1024); } while (0)
#define PG8_LDB(dst, b, h) do { _Pragma("unroll") for (int n = 0; n < 2; ++n) _Pragma("unroll") for (int k = 0; k < 2; ++k) dst[n][k] = *(const PG8_LAS bf16x8*)(lds + PG8_SB(b, h) + boff + n * 2048 + k * 1024); } while (0)
#define PG8_MMA(ai, bj, At, Bt) do { __builtin_amdgcn_s_setprio(1); _Pragma("unroll") for (int m = 0; m < 4; ++m) _Pragma("unroll") for (int n = 0; n < 2; ++n) _Pragma("unroll") for (int k = 0; k < 2; ++k) \
        acc[ai][bj][m][n] = __builtin_amdgcn_mfma_f32_16x16x32_bf16(Bt[n][k], At[m][k], acc[ai][bj][m][n], 0, 0, 0); __builtin_amdgcn_s_setprio(0); } while (0)
#define PG8_WAIT_V(n) asm volatile("s_waitcnt vmcnt(" #n ")" ::: "memory")
#define PG8_WAIT_L(n) asm volatile("s_waitcnt lgkmcnt(" #n ")" ::: "memory")
#define PG8_BAR __builtin_amdgcn_s_barrier()
#define PG8_SCHED __builtin_amdgcn_sched_barrier(0)
    Unit cur, nxt; int ui = 0;
    if (!S.next(0, cur)) return;
    f32x4 acc[2][2][4][2];
#pragma unroll
    for (int a = 0; a < 2; ++a)
#pragma unroll
        for (int b = 0; b < 2; ++b)
#pragma unroll
            for (int m = 0; m < 4; ++m)
#pragma unroll
                for (int n = 0; n < 2; ++n) acc[a][b][m][n] = (f32x4){0.f, 0.f, 0.f, 0.f};
    bf16x8 At[4][2], B0[2][2], B1[2][2];
    const char* cA = g.a_ptr(cur); const char* cB = g.b_ptr(cur);
    S.a_ready(cur);
    if constexpr (SP2) {
        PG8_STAGE(PG8_SB(0, 0), cB, voffB); PG8_STAGE(PG8_SB(0, 1), cB + hB, voffB); PG8_STAGE(PG8_SA(0, 0), cA, voffA); PG8_STAGE(PG8_SA(0, 1), cA + hA, voffA);
        if (wr == 1) PG8_BAR;
        PG8_WAIT_V(2); PG8_BAR;
        PG8_STAGE(PG8_SB(1, 0), cB + kstep, voffB); PG8_STAGE(PG8_SA(1, 0), cA + kstep, voffA); PG8_STAGE(PG8_SB(1, 1), cB + hB + kstep, voffB);
        PG8_WAIT_V(6); PG8_BAR;
    } else {
        PG8_STAGE(PG8_SB(0, 0), cB, voffB); PG8_STAGE(PG8_SA(0, 0), cA, voffA); PG8_STAGE(PG8_SB(0, 1), cB + hB, voffB); PG8_STAGE(PG8_SA(0, 1), cA + hA, voffA);
        if (wr == 1) PG8_BAR;
        PG8_WAIT_V(4); PG8_BAR;
        PG8_STAGE(PG8_SB(1, 0), cB + kstep, voffB); PG8_STAGE(PG8_SA(1, 0), cA + kstep, voffA); PG8_STAGE(PG8_SB(1, 1), cB + hB + kstep, voffB);
        PG8_WAIT_V(6); PG8_BAR;
    }
    for (;;) {
        PROBE_U0()
        const bool has_next = S.next(ui + 1, nxt);
        const char* nA = has_next ? g.a_ptr(nxt) : cA; const char* nB = has_next ? g.b_ptr(nxt) : cB;
        for (int t = 0; t < nt; t += 2) {
            if constexpr (Epi::MIDHOOK) { if (t == 16 || t == 32) { PROBE_E0() E.mid(acc, cur, t, wr, wc, fr, fq); PROBE_E1(1) } }
            const bool last = (t == nt - 2);
            const char* a1 = cA + (size_t)(t + 1) * kstep;
            const char* a2 = last ? nA : cA + (size_t)(t + 2) * kstep; const char* b2 = last ? nB : cB + (size_t)(t + 2) * kstep;
            const char* a3 = a2 + kstep; const char* b3 = b2 + kstep;
            if (last && has_next) S.a_ready(nxt);
            if constexpr (SP2) {
            PG8_LDB(B0, 0, 0); PG8_LDB(B1, 0, 1); PG8_SCHED; PG8_LDA(At, 0, 0); PG8_STAGE(PG8_SA(1, 1), a1 + hA, voffA);
            PG8_WAIT_V(8); PG8_WAIT_L(0); PG8_BAR; PG8_MMA(0, 0, At, B0); PG8_MMA(0, 1, At, B1); PG8_BAR; PG8_SCHED;
            PG8_LDA(At, 0, 1); PG8_STAGE(PG8_SB(0, 0), b2, voffB); PG8_STAGE(PG8_SB(0, 1), b2 + hB, voffB); PG8_STAGE(PG8_SA(0, 0), a2, voffA);
            PG8_WAIT_V(8); PG8_WAIT_L(0); PG8_BAR; PG8_MMA(1, 0, At, B0); PG8_MMA(1, 1, At, B1); PG8_BAR; PG8_SCHED;
            PG8_LDB(B0, 1, 0); PG8_LDB(B1, 1, 1); PG8_SCHED; PG8_LDA(At, 1, 0); PG8_STAGE(PG8_SA(0, 1), a2 + hA, voffA);
            PG8_WAIT_V(8); PG8_WAIT_L(0); PG8_BAR; PG8_MMA(0, 0, At, B0); PG8_MMA(0, 1, At, B1); PG8_BAR; PG8_SCHED;
            PG8_LDA(At, 1, 1); PG8_STAGE(PG8_SB(1, 0), b3, voffB); PG8_STAGE(PG8_SB(1, 1), b3 + hB, voffB); PG8_STAGE(PG8_SA(1, 0), a3, voffA);
            PG8_WAIT_V(8); PG8_WAIT_L(0); PG8_BAR; PG8_MMA(1, 0, At, B0); PG8_MMA(1, 1, At, B1); PG8_BAR; PG8_SCHED;
            } else {
            PG8_LDB(B0, 0, 0); PG8_SCHED; PG8_LDA(At, 0, 0); PG8_STAGE(PG8_SA(1, 1), a1 + hA, voffA);
            PG8_WAIT_L(8); PG8_BAR; PG8_WAIT_L(0); PG8_MMA(0, 0, At, B0); PG8_BAR; PG8_SCHED;
            PG8_LDB(B1, 0, 1); PG8_STAGE(PG8_SB(0, 0), b2, voffB);
            PG8_BAR; PG8_WAIT_L(0); PG8_MMA(0, 1, At, B1); PG8_BAR;
            PG8_LDA(At, 0, 1); PG8_STAGE(PG8_SA(0, 0), a2, voffA);
            PG8_BAR; PG8_WAIT_L(0); PG8_MMA(1, 0, At, B0); PG8_BAR; PG8_SCHED;
            PG8_STAGE(PG8_SB(0, 1), b2 + hB, voffB);
            PG8_WAIT_V(6); PG8_BAR; PG8_MMA(1, 1, At, B1); PG8_BAR;
            PG8_LDB(B0, 1, 0); PG8_SCHED; PG8_LDA(At, 1, 0); PG8_STAGE(PG8_SA(0, 1), a2 + hA, voffA);
            PG8_WAIT_L(8); PG8_BAR; PG8_WAIT_L(0); PG8_MMA(0, 0, At, B0); PG8_BAR; PG8_SCHED;
            PG8_LDB(B1, 1, 1); PG8_STAGE(PG8_SB(1, 0), b3, voffB);
            PG8_BAR; PG8_WAIT_L(0); PG8_MMA(0, 1, At, B1); PG8_BAR;
            PG8_LDA(At, 1, 1); PG8_STAGE(PG8_SA(1, 0), a3, voffA);
            PG8_BAR; PG8_WAIT_L(0); PG8_MMA(1, 0, At, B0); PG8_BAR; PG8_SCHED;
            PG8_STAGE(PG8_SB(1, 1), b3 + hB, voffB);
            PG8_WAIT_V(6); PG8_BAR; PG8_MMA(1, 1, At, B1); PG8_BAR;
            }
        }
        if constexpr (ALIGN_EPI) { if (wr == 0) PG8_BAR; }
        if constexpr (!Epi::AFTER_DRAIN) { PROBE_E0() E(acc, cur, wr, wc, fr, fq); PROBE_E1(0) S.done(cur); }
        PROBE_U1(ui)
        if (!has_next) break;
#pragma unroll
        for (int a = 0; a < 2; ++a)
#pragma unroll
            for (int b = 0; b < 2; ++b)
#pragma unroll
                for (int m = 0; m < 4; ++m)
#pragma unroll
                    for (int n = 0; n < 2; ++n) acc[a][b][m][n] = (f32x4){0.f, 0.f, 0.f, 0.f};
        cur = nxt; cA = nA; cB = nB; ++ui;
        if constexpr (ALIGN_EPI) { if (wr == 1) PG8_BAR; }
    }
    PG8_WAIT_V(0);
    if constexpr (!ALIGN_EPI) { if (wr == 0) PG8_BAR; }
    PG8_BAR;
    if constexpr (Epi::AFTER_DRAIN) { E.fused(acc, cur, wr, wc, fr, fq, lds, wid, lane); S.done(cur); }
#undef PG8_SA
#undef PG8_SB
#undef PG8_STAGE
#undef PG8_LDA
#undef PG8_LDB
#undef PG8_MMA
#undef PG8_WAIT_V
#undef PG8_WAIT_L
#undef PG8_BAR
#undef PG8_SCHED
}
}

struct Args { const float* in[24]; float* out; unsigned char* ws; int ph_lo, ph_hi, li, pad; };
#define IN_(k) (A_.in[k])
#define X_PROMPT IN_(0)
#define X_SAMPLE IN_(1)
#define CACHE_K IN_(2)
#define CACHE_V IN_(3)
#define STATE_HGRN IN_(4)
#define CACHE_MK IN_(5)
#define CACHE_MV IN_(6)
#define MEM_PROMPT IN_(7)
#define W_IN IN_(8)
#define LQ1 IN_(9)
#define LK1 IN_(10)
#define LQ2 IN_(11)
#define LK2 IN_(12)
#define SUB_NORM IN_(13)
#define LB_LOGITS IN_(14)
#define HGRN_NORM IN_(15)
#define W_MEM_K IN_(16)
#define W_MEM_V IN_(17)
#define W_A IN_(18)
#define W_B IN_(19)
#define W_C IN_(20)
#define W_OUT IN_(21)
#define LN_G IN_(22)
#define LN_B IN_(23)
#define OUT_ (A_.out)
#define WS_(off) (A_.ws + (off))
#define XB_ ((bf16*)WS_(WS_XB))
#define WT_ ((bf16*)WS_(WS_WT))
#define WABC_ ((bf16*)WS_(WS_WABC))
#define WO_ ((bf16*)WS_(WS_WO))
#define MKV_ ((bf16*)WS_(WS_MKV))
#define P_ ((bf16*)WS_(WS_P))
#define MG_ ((bf16*)WS_(WS_MG))
#define G_ ((float*)WS_(WS_G))
#define PRE_ ((bf16*)WS_(WS_PRE))
#define Y_ ((bf16*)WS_(WS_Y))
#define GT_ ((bf16*)WS_(WS_GT))
#define KC_ ((bf16*)WS_(WS_KC))
#define VC_ ((bf16*)WS_(WS_VC))
#define OB_ ((float*)WS_(WS_OB))
#define ROPE_ ((v2f*)WS_(WS_ROPE))
typedef const Args& Ctx;

struct InProjOrder {
    int G, c;
    DI bool next(int i, pg8::Unit& u) const {
        const int L = i * G + c; u.br = 0;
        if (L < 130 * 68) { pg8::tile_of(L, 130, 68, u.pm, u.pn); return true; }
        const int l = L - 130 * 68; if (l >= 64) return false;
        u.pm = 130 + (l & 7); u.pn = 68 + (l >> 3); return true;
    }
    DI void a_ready(const pg8::Unit&) const {}
    DI void done(const pg8::Unit&) const {}
};
struct MergeOrder {
    int G, c;
    DI bool next(int i, pg8::Unit& u) const {
        const int T = i * G + c; if (T >= 130 * 8) return false;
        pg8::tile_of<4>(T, 130, 8, u.pm, u.pn); u.br = 0; return true;
    }
    DI void a_ready(const pg8::Unit&) const {}
    DI void done(const pg8::Unit&) const {}
};
struct OutOrder {
    int G, c;
    DI bool next(int i, pg8::Unit& u) const {
        const int L = i * G + c; if (L >= 130 * 8) return false;
        pg8::tile_of<4>(L, 130, 8, u.pm, u.pn); u.br = 0; return true;
    }
    DI void a_ready(const pg8::Unit&) const {}
    DI void done(const pg8::Unit&) const {}
};

DI void st8bf(bf16* p, const float (&v)[8]) {
    v4u w; w.x = pg8::cvt_pk_bf16(v[0], v[1]); w.y = pg8::cvt_pk_bf16(v[2], v[3]); w.z = pg8::cvt_pk_bf16(v[4], v[5]); w.w = pg8::cvt_pk_bf16(v[6], v[7]);
    *(v4u*)p = w;
}
DI void st8f(float* p, const float (&v)[8]) { *(v4f*)p = (v4f){v[0], v[1], v[2], v[3]}; *(v4f*)(p + 4) = (v4f){v[4], v[5], v[6], v[7]}; }
DI void ld8bf(const bf16* p, float (&f)[8]) {
    const v4u w = *(const v4u*)p;
    f[0] = bflo(w.x); f[1] = bfhi(w.x); f[2] = bflo(w.y); f[3] = bfhi(w.y); f[4] = bflo(w.z); f[5] = bfhi(w.z); f[6] = bflo(w.w); f[7] = bfhi(w.w);
}

struct EpiIn {
    static constexpr bool PERM = true, AFTER_DRAIN = false, MIDHOOK = false;
    bf16* P; float* G; float* out; bf16* MKV; const float* lbl; const v2f* rope; bf16* KC; bf16* VC; bf16* GT;
    template <int MODE>
    DI void rows(const pg8::f32x4 (&acc)[2][2][4][2], const pg8::Unit& u, int wr, int wc, int fr, int fq) const {
        const int pn = u.pn, tc0 = wc * 32 + fq * 8;
        float lbv[2][8];
        if constexpr (MODE == 4) {
#pragma unroll
            for (int bj = 0; bj < 2; ++bj) { const int cf = (pn - 20) * 256 + bj * 128 + tc0;
#pragma unroll
                for (int i = 0; i < 8; ++i) lbv[bj][i] = sigm(lbl[cf + i] - lbl[1024 + cf + i]); }
        }
#pragma unroll
        for (int ai = 0; ai < 2; ++ai)
#pragma unroll
            for (int m = 0; m < 4; ++m) {
                const int row = u.pm * 256 + ai * 128 + wr * 64 + m * 16 + fr;
                v2f cs[8];
                if constexpr (MODE <= 1) {
                    const int pos = row < MP ? (row & (SEQ - 1)) : PAST + ((row - MP) & (DS - 1));
                    const v4f* rp = (const v4f*)(rope + (size_t)pos * 8);
#pragma unroll
                    for (int i = 0; i < 4; ++i) { const v4f t = rp[i]; cs[2 * i] = (v2f){t.x, t.y}; cs[2 * i + 1] = (v2f){t.z, t.w}; }
                }
#pragma unroll
                for (int bj = 0; bj < 2; ++bj) {
                    float v[8];
#pragma unroll
                    for (int i = 0; i < 4; ++i) { v[i] = acc[ai][bj][m][0][i]; v[4 + i] = acc[ai][bj][m][1][i]; }
                    const int col = pn * 256 + bj * 128 + tc0;
                    if constexpr (MODE <= 1) {
                        if ((wc & 1) == 0) {
                            const float sgn = fq == 0 ? -1.f : 1.f;
#pragma unroll
                            for (int i = 0; i < 8; ++i) { const float pr = __shfl_xor(v[i], 16); const float r = v[i] * cs[i].x + sgn * pr * cs[i].y; v[i] = fq < 2 ? r : v[i]; }
                        }
                        if constexpr (MODE == 0) {
#pragma unroll
                            for (int i = 0; i < 8; ++i) v[i] *= QA_SCALE;
                        }
                    }
                    if constexpr (MODE == 1 || MODE == 2) {
                        const int cs1 = (pn & 3) * 256 + bj * 128 + tc0;
                        float* dst = row < MP ? out + (MODE == 1 ? O_KP : O_VP) + (size_t)row * 1024 + cs1 : out + (MODE == 1 ? O_KS : O_VS) + (size_t)(row - MP) * 1024 + cs1;
                        st8f(dst, v);
                    }
                    if constexpr (MODE == 3) {
#pragma unroll
                        for (int i = 0; i < 8; ++i) v[i] = silu(v[i]);
                    }
                    if constexpr (MODE == 6) {
#pragma unroll
                        for (int i = 0; i < 8; ++i) v[i] = sigm(v[i]);
                    }
                    if constexpr (MODE == 7) {
#pragma unroll
                        for (int i = 0; i < 8; ++i) v[i] *= QC_SCALE;
                    }
                    if constexpr (MODE == 4) {
                        const int cf = (pn - 20) * 256 + bj * 128 + tc0;
#pragma unroll
                        for (int i = 0; i < 8; ++i) { const float lb = lbv[bj][i]; const float f = lb + (1.f - lb) * sigm(v[i]); v[i] = __builtin_amdgcn_logf(f) * LN2; }
                        st8f(G + (size_t)row * 1024 + cf, v);
                    } else if constexpr (MODE == 8) {
                        const int r = row - M, cm = (pn - 68) * 256 + bj * 128 + tc0;
                        float* dst = cm < 1024 ? out + O_MK + (size_t)r * 1024 + cm : out + O_MV + (size_t)r * 1024 + (cm - 1024);
                        st8f(dst, v);
                        st8bf(MKV + (size_t)r * 2048 + cm, v);
                    } else if constexpr (MODE == 1 || MODE == 2) {
                        if (row < MP) {
                            const int cc = (pn & 3) * 256 + bj * 128 + tc0, hd = cc >> 7;
                            st8bf((MODE == 1 ? KC : VC) + ((size_t)((row >> 12) * 8 + hd) * SEQ + (row & (SEQ - 1))) * 128 + (cc & 127), v);
                        } else st8bf(P + (size_t)row * PLD + col, v);
                    } else if constexpr (MODE == 6) {
                        if (pn >= 44) {
                            const int tix = ((pn - 44) >> 3) * (130 * 8) + u.pm * 8 + ((pn - 44) & 7), tid = (wr * 4 + wc) * 64 + fq * 16 + fr;
                            st8bf(GT + (size_t)tix * 65536 + ((ai * 4 + m) * 2 + bj) * 4096 + tid * 8, v);
                        } else st8bf(P + (size_t)row * PLD + col, v);
                    } else {
                        st8bf(P + (size_t)row * PLD + col, v);
                    }
                }
            }
    }
    DI void operator()(const pg8::f32x4 (&acc)[2][2][4][2], const pg8::Unit& u, int wr, int wc, int fr, int fq) const {
        const int pn = u.pn;
        int mode;
        if (pn >= 68) mode = 8;
        else if (pn >= 44) mode = 6;
        else { const int seg = pn >> 2; mode = seg == 0 ? 0 : seg == 1 ? 1 : seg == 2 ? 2 : seg == 5 ? 4 : seg == 6 ? 5 : seg == 7 ? 6 : seg == 9 ? 7 : 3; }
        switch (mode) {
            case 0: rows<0>(acc, u, wr, wc, fr, fq); break;
            case 1: rows<1>(acc, u, wr, wc, fr, fq); break;
            case 2: rows<2>(acc, u, wr, wc, fr, fq); break;
            case 3: rows<3>(acc, u, wr, wc, fr, fq); break;
            case 4: rows<4>(acc, u, wr, wc, fr, fq); break;
            case 5: rows<5>(acc, u, wr, wc, fr, fq); break;
            case 6: rows<6>(acc, u, wr, wc, fr, fq); break;
            case 7: rows<7>(acc, u, wr, wc, fr, fq); break;
            default: rows<8>(acc, u, wr, wc, fr, fq); break;
        }
    }
};

struct EpiMerge {
    static constexpr bool PERM = true, AFTER_DRAIN = false, MIDHOOK = true;
    const bf16* GT; bf16* MG;
    DI void mid(pg8::f32x4 (&acc)[2][2][4][2], const pg8::Unit& u, int t, int wr, int wc, int fr, int fq) const {
        const float plo = t == 16 ? 0.f : 1e-6f, lo = 1e-6f;
        unsigned off0 = (unsigned)((u.pm * 8 + u.pn) * 65536 + ((wr * 4 + wc) * 64 + fq * 16 + fr) * 8);
        asm volatile("" : "+v"(off0));
        const bf16* gpv = GT + (size_t)(t == 16 ? 0 : 1) * (130 * 8 * 65536) + off0; const bf16* gnx = gpv + (size_t)130 * 8 * 65536;
#pragma unroll
        for (int ai = 0; ai < 2; ++ai)
#pragma unroll
            for (int mh = 0; mh < 2; ++mh) {
                v4u a[2][2], b[2][2];
#pragma unroll
                for (int m2 = 0; m2 < 2; ++m2)
#pragma unroll
                    for (int bj = 0; bj < 2; ++bj) { const int go = ((ai * 4 + mh * 2 + m2) * 2 + bj) * 4096; a[m2][bj] = *(const v4u*)(gpv + go); b[m2][bj] = *(const v4u*)(gnx + go); }
#pragma unroll
                for (int m2 = 0; m2 < 2; ++m2)
#pragma unroll
                    for (int bj = 0; bj < 2; ++bj) { const v4u x = a[m2][bj], y = b[m2][bj];
#define RT(pa, pb) (fmaxf((pa), plo) * frcp(fmaxf((pb), lo)))
                        pg8::f32x4& a0 = acc[ai][bj][mh * 2 + m2][0]; pg8::f32x4& a1 = acc[ai][bj][mh * 2 + m2][1];
                        a0[0] *= RT(bflo(x.x), bflo(y.x)); a0[1] *= RT(bfhi(x.x), bfhi(y.x)); a0[2] *= RT(bflo(x.y), bflo(y.y)); a0[3] *= RT(bfhi(x.y), bfhi(y.y));
                        a1[0] *= RT(bflo(x.z), bflo(y.z)); a1[1] *= RT(bfhi(x.z), bfhi(y.z)); a1[2] *= RT(bflo(x.w), bflo(y.w)); a1[3] *= RT(bfhi(x.w), bfhi(y.w));
#undef RT
                    }
            }
    }
    DI void operator()(const pg8::f32x4 (&acc)[2][2][4][2], const pg8::Unit& u, int wr, int wc, int fr, int fq) const {
        const int tc0 = wc * 32 + fq * 8;
        const bf16* gc = GT + (size_t)2 * (130 * 8 * 65536) + (size_t)(u.pm * 8 + u.pn) * 65536 + ((wr * 4 + wc) * 64 + fq * 16 + fr) * 8;
#pragma unroll
        for (int ai = 0; ai < 2; ++ai) {
            v4u gw[4][2];
#pragma unroll
            for (int m = 0; m < 4; ++m)
#pragma unroll
                for (int bj = 0; bj < 2; ++bj) gw[m][bj] = *(const v4u*)(gc + ((ai * 4 + m) * 2 + bj) * 4096);
#pragma unroll
            for (int m = 0; m < 4; ++m) { const int row = u.pm * 256 + ai * 128 + wr * 64 + m * 16 + fr;
#pragma unroll
                for (int bj = 0; bj < 2; ++bj) { const int col = u.pn * 256 + bj * 128 + tc0;
                    const v4u g = gw[m][bj]; const pg8::f32x4 a0 = acc[ai][bj][m][0], a1 = acc[ai][bj][m][1]; const float lo = 1e-6f;
                    float v[8];
                    v[0] = a0[0] * fmaxf(bflo(g.x), lo); v[1] = a0[1] * fmaxf(bfhi(g.x), lo); v[2] = a0[2] * fmaxf(bflo(g.y), lo); v[3] = a0[3] * fmaxf(bfhi(g.y), lo);
                    v[4] = a1[0] * fmaxf(bflo(g.z), lo); v[5] = a1[1] * fmaxf(bfhi(g.z), lo); v[6] = a1[2] * fmaxf(bflo(g.w), lo); v[7] = a1[3] * fmaxf(bfhi(g.w), lo);
                    st8bf(MG + (size_t)row * D + col, v); } }
        }
    }
};

struct EpiOut {
    static constexpr bool PERM = true, AFTER_DRAIN = false, MIDHOOK = false;
    const float* xp; const float* xs; bf16* pre;
    DI void operator()(const pg8::f32x4 (&acc)[2][2][4][2], const pg8::Unit& u, int wr, int wc, int fr, int fq) const {
        const int tc0 = wc * 32 + fq * 8;
#pragma unroll
        for (int ai = 0; ai < 2; ++ai)
#pragma unroll
            for (int mh = 0; mh < 2; ++mh) {
                v4f xv[2][2][2];
#pragma unroll
                for (int m2 = 0; m2 < 2; ++m2) { const int row = u.pm * 256 + ai * 128 + wr * 64 + (mh * 2 + m2) * 16 + fr;
                    const float* xr = row < MP ? xp + (size_t)row * D : xs + (size_t)(row - MP) * D;
#pragma unroll
                    for (int bj = 0; bj < 2; ++bj)
#pragma unroll
                        for (int n = 0; n < 2; ++n) xv[m2][bj][n] = __builtin_nontemporal_load((const v4f*)(xr + u.pn * 256 + bj * 128 + tc0 + 4 * n)); }
#pragma unroll
                for (int m2 = 0; m2 < 2; ++m2) { const int m = mh * 2 + m2, row = u.pm * 256 + ai * 128 + wr * 64 + m * 16 + fr;
#pragma unroll
                    for (int bj = 0; bj < 2; ++bj) { const int col = u.pn * 256 + bj * 128 + tc0;
                        const v4f x0 = xv[m2][bj][0], x1 = xv[m2][bj][1]; const pg8::f32x4 a0 = acc[ai][bj][m][0], a1 = acc[ai][bj][m][1];
                        const float v[8] = {DN_ALPHA * x0.x + a0[0], DN_ALPHA * x0.y + a0[1], DN_ALPHA * x0.z + a0[2], DN_ALPHA * x0.w + a0[3],
                                            DN_ALPHA * x1.x + a1[0], DN_ALPHA * x1.y + a1[1], DN_ALPHA * x1.z + a1[2], DN_ALPHA * x1.w + a1[3]};
                        st8bf(pre + (size_t)row * D + col, v); } }
            }
    }
};

DI void p0_transpose_item(const float* W, int K, int N, bf16* WT, int row_off, LAS float* scr, int item, int lane, int ldw = 0, int coff = 0) {
    if (ldw == 0) ldw = K;
    const int nblk = N / 32, kb = item / nblk, nb = item % nblk, k0 = 64 * kb, n0 = 32 * nb;
#pragma unroll 8
    for (int i = 0; i < 32; ++i) { const int kk = 2 * i + (lane >> 5); scr[kk * 33 + (lane & 31)] = W[(size_t)(k0 + kk) * N + n0 + (lane & 31)]; }
    asm volatile("s_waitcnt lgkmcnt(0)" ::: "memory");
    const int c = lane & 7;
#pragma unroll
    for (int j = 0; j < 4; ++j) { const int n = (lane >> 3) + 8 * j; const LAS float* s = scr + (8 * c) * 33 + n;
        v4u o; o.x = pk2(s[0 * 33], s[1 * 33]); o.y = pk2(s[2 * 33], s[3 * 33]); o.z = pk2(s[4 * 33], s[5 * 33]); o.w = pk2(s[6 * 33], s[7 * 33]);
        *(v4u*)(WT + (size_t)(row_off + n0 + n) * ldw + coff + k0 + 8 * c) = o; }
    asm volatile("s_waitcnt lgkmcnt(0)" ::: "memory");
}
DI void p0_row_to_bf16(const float* xrow, bf16* orow, int lane) {
    const v4f* xr = (const v4f*)xrow + lane;
    v2u* o8 = (v2u*)orow + lane;
#pragma unroll
    for (int j = 0; j < 8; ++j) { const v4f v = xr[64 * j]; o8[64 * j] = (v2u){pk2(v.x, v.y), pk2(v.z, v.w)}; }
}
DI void p0_rope_entry(v2f* rope, int idx) {
    const int pos = idx >> 3, i = idx & 7;
    const float invf = i == 0 ? 1.0f : i == 1 ? 0.1939227432012558f : i == 2 ? 0.03760603070259094f : i == 3 ? 0.007292664609849453f : i == 4 ? 0.0014142135623842478f
                     : i == 5 ? 0.00027424818836152554f : i == 6 ? 5.318296098266728e-05f : 1.0313386155758053e-05f;
    const float ang = (float)pos * invf;
    const double x = (double)ang, twopi = 6.283185307179586476925286766559;
    const double k = __builtin_rint(x / twopi), r = x - k * twopi, r2 = r * r;
    double c = 1.0, s = 1.0;
#pragma unroll
    for (int n = 17; n >= 1; --n) { c = 1.0 - c * r2 / (double)((2 * n - 1) * (2 * n)); s = 1.0 - s * r2 / (double)((2 * n) * (2 * n + 1)); }
    rope[idx] = (v2f){(float)c, (float)(s * r)};
}

DI void ln_row(Ctx A_, int m, int lane) {
    const v4u* pr = (const v4u*)(PRE_ + (size_t)m * D) + lane;
    float v[4][8]; float s = 0.f;
#pragma unroll
    for (int j = 0; j < 4; ++j) { const v4u w = pr[64 * j];
        v[j][0] = bflo(w.x); v[j][1] = bfhi(w.x); v[j][2] = bflo(w.y); v[j][3] = bfhi(w.y); v[j][4] = bflo(w.z); v[j][5] = bfhi(w.z); v[j][6] = bflo(w.w); v[j][7] = bfhi(w.w);
#pragma unroll
        for (int e = 0; e < 8; ++e) s += v[j][e]; }
    const float mean = wave_sum(s) * (1.0f / D); float s2 = 0.f;
#pragma unroll
    for (int j = 0; j < 4; ++j)
#pragma unroll
        for (int e = 0; e < 8; ++e) { v[j][e] -= mean; s2 += v[j][e] * v[j][e]; }
    const float rstd = 1.0f / sqrtf(wave_sum(s2) * (1.0f / D) + NORM_EPS);
#pragma unroll
    for (int j = 0; j < 4; ++j) { const int c0 = 512 * j + 8 * lane;
        const v4f g0 = *(const v4f*)(LN_G + c0), g1 = *(const v4f*)(LN_G + c0 + 4), b0 = *(const v4f*)(LN_B + c0), b1 = *(const v4f*)(LN_B + c0 + 4);
        float* o = OUT_ + (size_t)m * D + c0;
        *(v4f*)o = (v4f){v[j][0] * rstd * g0.x + b0.x, v[j][1] * rstd * g0.y + b0.y, v[j][2] * rstd * g0.z + b0.z, v[j][3] * rstd * g0.w + b0.w};
        *(v4f*)(o + 4) = (v4f){v[j][4] * rstd * g1.x + b1.x, v[j][5] * rstd * g1.y + b1.y, v[j][6] * rstd * g1.z + b1.z, v[j][7] * rstd * g1.w + b1.w}; }
}


DI void glds16(const void* gsrc, unsigned lds_dst) { unsigned keep;
    asm volatile("s_mov_b32 %0, m0\n\ts_mov_b32 m0, %2\n\ts_nop 0\n\tglobal_load_lds_dwordx4 %1, off\n\ts_mov_b32 m0, %0" : "=&s"(keep) : "v"(gsrc), "s"(lds_dst) : "memory"); }
DI unsigned lds_addr(const LAS void* p) { return (unsigned)__builtin_amdgcn_readfirstlane((int)(unsigned)(size_t)p); }
constexpr float RESC_THR = 8.0f;
DI float lam_of(Ctx A_, int lane) {
    const float d1 = wave_sum(LQ1[lane] * LK1[lane]), d2 = wave_sum(LQ2[lane] * LK2[lane]);
    return __expf(d1) - __expf(d2) + LAM_INIT;
}
namespace fa {
typedef short bf16x8 __attribute__((ext_vector_type(8)));
typedef short s16x4 __attribute__((ext_vector_type(4)));
typedef float f32x16 __attribute__((ext_vector_type(16)));
typedef float f32x2_t __attribute__((ext_vector_type(2)));
typedef __bf16 bf16x2_t __attribute__((ext_vector_type(2)));
typedef short v4i16_t __attribute__((ext_vector_type(4)));
constexpr int KT = 16384, VT = 16384, BUF = KT + VT, NBUF = 3, WSF_OFF = NBUF * BUF;
DI int crow(int i, int hh) { return (i & 3) + 8 * (i >> 2) + 4 * hh; }
DI unsigned cvtpk(float lo, float hi) { f32x2_t v = {lo, hi}; bf16x2_t b = __builtin_convertvector(v, bf16x2_t); return __builtin_bit_cast(unsigned, b); }
DI bf16x8 pack8(const f32x16& x, int s8) {
    v4u p; p.x = cvtpk(x[s8], x[s8 + 1]); p.y = cvtpk(x[s8 + 2], x[s8 + 3]); p.z = cvtpk(x[s8 + 4], x[s8 + 5]); p.w = cvtpk(x[s8 + 6], x[s8 + 7]);
    return __builtin_bit_cast(bf16x8, p);
}
DI s16x4 vtr(const LAS unsigned char* p) { return __builtin_bit_cast(s16x4, __builtin_amdgcn_ds_read_tr16_b64_v4i16((LAS v4i16_t*)p)); }
DI void load_tile(LAS unsigned char* buf, const bf16* Kg, const bf16* Vg, int kv0, int wave, int lane) {
#pragma unroll
    for (int i = 0; i < 2; ++i) { const int c = 2 * wave + i;
        glds16(Kg + (size_t)(kv0 + lane) * 128 + c * 8, lds_addr(buf + c * 1024)); }
#pragma unroll
    for (int i = 0; i < 2; ++i) { const int pc = 2 * wave + i;
        glds16(Vg + (size_t)(kv0 + 16 * (pc & 3) + (lane >> 2)) * 128 + (pc >> 2) * 32 + (lane & 3) * 8, lds_addr(buf + KT + (pc >> 2) * 4096 + (pc & 3) * 1024)); }
}
DI void attn_unit(Ctx A_, LAS unsigned char* lds, int b, int h, int qb, float lam, int wave, int lane) {
    const int r = lane & 31, hh = lane >> 5, mp = wave >> 2, rg = wave & 3;
    bf16* P = P_;
    const size_t rowb = (size_t)b * SEQ;
    const bf16* Kg = KC_ + (size_t)(b * 8 + h) * SEQ * 128; const bf16* Vg = VC_ + (size_t)(b * 8 + h) * SEQ * 128;
    const int q0 = qb * 128 + rg * 32;
    const int NT = 2 * qb + 2, NTw = 2 * qb + 1 + (rg >> 1);
    LAS float* wsf = (LAS float*)(lds + WSF_OFF) + wave * 128;
    bf16x8 qr[4];
    { const bf16* Qg = P + (rowb + q0 + r) * PLD + C_QA + h * 128 + mp * 64 + hh * 8;
#pragma unroll
      for (int d0 = 0; d0 < 4; ++d0) qr[d0] = *(const bf16x8*)(Qg + d0 * 16); }
    load_tile(lds, Kg, Vg, 0, wave, lane);
    load_tile(lds + BUF, Kg, Vg, 64, wave, lane);
    asm volatile("" : "+v"(qr[0]), "+v"(qr[1]), "+v"(qr[2]), "+v"(qr[3]));
    f32x16 o[4];
#pragma unroll
    for (int nb = 0; nb < 4; ++nb)
#pragma unroll
        for (int i = 0; i < 16; ++i) o[nb][i] = 0.f;
    float m = 0.f, l = 0.f;
    const int g16 = (lane >> 4) & 1, p4 = lane & 3, q4 = (lane & 15) >> 2;
    int slot = 0;
    for (int t = 0; t < NT; ++t) {
        if (t + 1 < NT) asm volatile("s_waitcnt vmcnt(4) lgkmcnt(0)" ::: "memory"); else asm volatile("s_waitcnt vmcnt(0) lgkmcnt(0)" ::: "memory");
        __builtin_amdgcn_s_barrier(); asm volatile("" ::: "memory");
        if (t + 2 < NT) { const int s2 = slot == 0 ? 2 : slot - 1; load_tile(lds + s2 * BUF, Kg, Vg, (t + 2) * 64, wave, lane); }
        if (t < NTw) {
            const LAS unsigned char* buf = lds + slot * BUF;
            const LAS unsigned char* kb = buf + (mp * 8 + hh) * 1024 + r * 16;
            const bool first = t == 0;
            const float mi = first ? 0.f : m;
            f32x16 p0, p1;
#pragma unroll
            for (int i = 0; i < 16; ++i) { p0[i] = -mi; p1[i] = -mi; }
            { bf16x8 kf[8];
#pragma unroll
              for (int d0 = 0; d0 < 4; ++d0) { kf[2 * d0] = *(const LAS bf16x8*)(kb + d0 * 2048); kf[2 * d0 + 1] = *(const LAS bf16x8*)(kb + d0 * 2048 + 512); }
              __builtin_amdgcn_sched_barrier(0);
              __builtin_amdgcn_s_setprio(1);
#pragma unroll
              for (int d0 = 0; d0 < 4; ++d0) {
                  p0 = __builtin_amdgcn_mfma_f32_32x32x16_bf16(kf[2 * d0], qr[d0], p0, 0, 0, 0);
                  p1 = __builtin_amdgcn_mfma_f32_32x32x16_bf16(kf[2 * d0 + 1], qr[d0], p1, 0, 0, 0);
              }
              __builtin_amdgcn_s_setprio(0);
              __builtin_amdgcn_sched_barrier(0); }
#define MX3(a, b, c) __builtin_fmaxf(__builtin_fmaxf((a), (b)), (c))
            float ta = MX3(p0[0], p0[1], p1[0]), tb2 = MX3(p0[2], p0[3], p1[1]); ta = MX3(ta, p1[2], p1[3]);
#pragma unroll
            for (int i = 4; i < 16; i += 4) { ta = MX3(ta, p0[i], p0[i + 1]); tb2 = MX3(tb2, p0[i + 2], p0[i + 3]); ta = MX3(ta, p1[i], p1[i + 1]); tb2 = MX3(tb2, p1[i + 2], p1[i + 3]); }
#undef MX3
            float tm = fmaxf(ta, tb2);
            { const auto rr = __builtin_amdgcn_permlane32_swap(__float_as_uint(tm), __float_as_uint(tm), false, false); tm = fmaxf(__uint_as_float(rr[0]), __uint_as_float(rr[1])); }
            if (first || __any(tm > RESC_THR)) {
                const float dl = first ? tm : fmaxf(tm, 0.f), f = fexp2(-dl); m = mi + dl; l *= f;
#pragma unroll
                for (int i = 0; i < 16; ++i) { p0[i] -= dl; p1[i] -= dl; }
                if (hh == 0) wsf[r] = f;
                float fr[16];
#pragma unroll
                for (int i = 0; i < 16; ++i) fr[i] = wsf[crow(i, hh)];
#pragma unroll
                for (int nb = 0; nb < 4; ++nb)
#pragma unroll
                    for (int i = 0; i < 16; ++i) o[nb][i] *= fr[i];
            }
            float ls = 0.f;
#pragma unroll
            for (int i = 0; i < 16; ++i) { p0[i] = fexp2(p0[i]); p1[i] = fexp2(p1[i]); ls += p0[i] + p1[i]; }
            l += ls;
            bf16x8 pf[4]; pf[0] = pack8(p0, 0); pf[1] = pack8(p0, 8); pf[2] = pack8(p1, 0); pf[3] = pack8(p1, 8);
            const LAS unsigned char* vp = buf + KT + g16 * 32 + p4 * 8 + (4 * hh + q4) * 64;
            { bf16x8 fa4[4], fb4[4];
#define LOADV(f, ks) _Pragma("unroll") for (int nb = 0; nb < 4; ++nb) { const s16x4 lo = vtr(vp + nb * 4096 + (ks) * 1024), hi = vtr(vp + nb * 4096 + (ks) * 1024 + 512); f[nb] = __builtin_shufflevector(lo, hi, 0, 1, 2, 3, 4, 5, 6, 7); }
#define MMV(f, ks) __builtin_amdgcn_s_setprio(1); _Pragma("unroll") for (int nb = 0; nb < 4; ++nb) o[nb] = __builtin_amdgcn_mfma_f32_32x32x16_bf16(pf[ks], f[nb], o[nb], 0, 0, 0); __builtin_amdgcn_s_setprio(0);
              LOADV(fa4, 0) LOADV(fb4, 1) __builtin_amdgcn_sched_barrier(0);
              MMV(fa4, 0) LOADV(fa4, 2) __builtin_amdgcn_sched_barrier(0);
              MMV(fb4, 1) LOADV(fb4, 3) __builtin_amdgcn_sched_barrier(0);
              MMV(fa4, 2) MMV(fb4, 3) __builtin_amdgcn_sched_barrier(0);
#undef LOADV
#undef MMV
            }
        }
        slot = slot == 2 ? 0 : slot + 1;
    }
    l += __shfl_xor(l, 32);
    if (hh == 0) wsf[32 + r] = l;
    float rl[16];
#pragma unroll
    for (int i = 0; i < 16; ++i) rl[i] = 1.0f / wsf[32 + crow(i, hh)];
    float lam_e = lam; asm volatile("" : "+v"(lam_e));
    const float sc = mp == 0 ? 1.0f : lam_e;
#pragma unroll
    for (int nb = 0; nb < 4; ++nb)
#pragma unroll
        for (int i = 0; i < 16; ++i) o[nb][i] *= rl[i] * sc;
    asm volatile("s_waitcnt vmcnt(0) lgkmcnt(0)" ::: "memory"); __builtin_amdgcn_s_barrier(); asm volatile("" ::: "memory");
    int r_e = r, hh_e = hh; asm volatile("" : "+v"(r_e), "+v"(hh_e));
    int rowq_e = (int)rowb + q0, h_e = h; asm volatile("" : "+s"(rowq_e), "+s"(h_e));
    LAS float* X2 = (LAS float*)lds + rg * 4096 + (hh_e * 32 + r_e);
    if (mp == 1) {
#pragma unroll
        for (int nb = 0; nb < 4; ++nb)
#pragma unroll
            for (int i = 0; i < 16; ++i) X2[(nb * 16 + i) * 64] = o[nb][i];
    }
    asm volatile("s_waitcnt lgkmcnt(0)" ::: "memory"); __builtin_amdgcn_s_barrier(); asm volatile("" ::: "memory");
    if (mp == 0) {
        float ssq[16];
#pragma unroll
        for (int i = 0; i < 16; ++i) ssq[i] = 0.f;
#pragma unroll
        for (int nb = 0; nb < 4; ++nb)
#pragma unroll
            for (int i = 0; i < 16; ++i) { const float d = o[nb][i] - X2[(nb * 16 + i) * 64]; o[nb][i] = d; ssq[i] += d * d; }
#pragma unroll
        for (int i = 0; i < 16; ++i) {
            float v = ssq[i];
#pragma unroll
            for (int x = 1; x < 32; x <<= 1) v += __shfl_xor(v, x);
            ssq[i] = ONE_M_LAMINIT / sqrtf(v * (1.0f / 128.0f) + NORM_EPS);
        }
#pragma unroll
        for (int nb = 0; nb < 4; ++nb) {
            const float sn = SUB_NORM[nb * 32 + r_e];
#pragma unroll
            for (int i = 0; i < 16; ++i) {
                const size_t rw = (size_t)(rowq_e + crow(i, hh_e));
                Y_[rw * YLD + C_YA + h_e * 128 + nb * 32 + r_e] = (bf16)f2bf(o[nb][i] * ssq[i] * sn * bf2f(P[rw * PLD + C_ZA + h_e * 128 + nb * 32 + r_e]));
            }
        }
    }
    asm volatile("s_waitcnt lgkmcnt(0)" ::: "memory"); __builtin_amdgcn_s_barrier(); asm volatile("" ::: "memory");
}
DI void attn_phase(Ctx A_, LAS unsigned char* lds, int G, int c, float lam, int wave, int lane) {
    if (G == 256) {
        const int bh = c >> 2, s = c & 3;
#pragma unroll 1
        for (int i = 0; i < 8; ++i) { const int base = 4 * (i >> 1) + s; const int qb = (i & 1) ? 31 - base : base;
            attn_unit(A_, lds, bh >> 3, bh & 7, qb, lam, wave, lane); }
    } else {
#pragma unroll 1
        for (int u = c; u < 2048; u += G) { const int qb = 31 - (u >> 6), bh = u & 63; attn_unit(A_, lds, bh >> 3, bh & 7, qb, lam, wave, lane); }
    }
}
}

namespace hg {
using fa::bf16x8; using fa::s16x4; using fa::f32x16; using fa::crow; using fa::pack8; using fa::vtr;
constexpr int RP = 272;
constexpr int OFF_QT = 0, OFF_KT = 17408, OFF_QS = 34816, OFF_KS = 52224, OFF_V = 69632, OFF_OX = 86016, OFF_SEG = 118784, OFF_DEC = 122880;
static_assert(OFF_DEC + 512 <= RING_BYTES, "hgrn lds map");
#define HG_BAR() do { asm volatile("s_waitcnt vmcnt(0) lgkmcnt(0)" ::: "memory"); __builtin_amdgcn_s_barrier(); asm volatile("" ::: "memory"); } while (0)
#define HG_LBAR() do { asm volatile("s_waitcnt lgkmcnt(0)" ::: "memory"); __builtin_amdgcn_s_barrier(); asm volatile("" ::: "memory"); } while (0)
DI void hgrn_unit(Ctx A_, LAS unsigned char* lds, int row0, int T, int NC, int h, const float* s0, float* sout, int wave, int lane, int tid) {
    bf16* P = P_; const float* G = G_;
    const int r = lane & 31, hh = lane >> 5, j = wave & 3, tb = wave >> 2;
    const int dkp = tid & 63, seg = wave;
    const int g16 = (lane >> 4) & 1, p4 = lane & 3, q4 = (lane & 15) >> 2;
    f32x16 S[4];
#pragma unroll
    for (int i = 0; i < 4; ++i)
#pragma unroll
        for (int e = 0; e < 16; ++e) S[i][e] = s0 ? s0[(size_t)(32 * i + crow(e, hh)) * 128 + 32 * j + r] : 0.f;
    v2f gx[8]; unsigned qx[8], vx[8];
#define HG_LOAD(c) do { _Pragma("unroll") for (int i = 0; i < 8; ++i) { const int t = 8 * seg + i; const size_t row = (size_t)row0 + 64 * (c) + t; \
        if (t < T) { gx[i] = *(const v2f*)(G + row * 1024 + h * 128 + 2 * dkp); qx[i] = *(const unsigned*)(P + row * PLD + C_QB + h * 128 + 2 * dkp); vx[i] = *(const unsigned*)(P + row * PLD + C_IB + h * 128 + 2 * dkp); } \
        else { gx[i] = (v2f){0.f, 0.f}; qx[i] = 0u; vx[i] = 0u; } } } while (0)
    HG_LOAD(0);
#pragma unroll 1
    for (int c = 0; c < NC; ++c) {
        float b0[8], b1[8]; float a0 = 0.f, a1 = 0.f;
#pragma unroll
        for (int i = 0; i < 8; ++i) { a0 += gx[i].x; a1 += gx[i].y; b0[i] = a0; b1[i] = a1; }
        *(LAS v2f*)(lds + OFF_SEG + (seg * 128 + 2 * dkp) * 4) = (v2f){a0, a1};
        HG_LBAR();
        float pre0 = 0.f, pre1 = 0.f, mid0 = 0.f, mid1 = 0.f, last0 = 0.f, last1 = 0.f;
#pragma unroll
        for (int sg = 0; sg < 8; ++sg) { const v2f sv = *(const LAS v2f*)(lds + OFF_SEG + (sg * 128 + 2 * dkp) * 4);
            if (sg < seg) { pre0 += sv.x; pre1 += sv.y; } if (sg < 4) { mid0 += sv.x; mid1 += sv.y; } last0 += sv.x; last1 += sv.y; }
#pragma unroll
        for (int i = 0; i < 8; ++i) {
            const int t = 8 * seg + i;
            const float bb0 = b0[i] + pre0, bb1 = b1[i] + pre1;
            const float k0 = 1.f - fexp2(gx[i].x * LOG2E), k1 = 1.f - fexp2(gx[i].y * LOG2E), q0 = bflo(qx[i]), q1 = bfhi(qx[i]);
            *(LAS unsigned*)(lds + OFF_QT + t * RP + 4 * dkp) = fa::cvtpk(q0 * fexp2((bb0 - mid0) * LOG2E), q1 * fexp2((bb1 - mid1) * LOG2E));
            *(LAS unsigned*)(lds + OFF_KT + t * RP + 4 * dkp) = fa::cvtpk(k0 * fexp2((mid0 - bb0) * LOG2E), k1 * fexp2((mid1 - bb1) * LOG2E));
            *(LAS unsigned*)(lds + OFF_QS + t * RP + 4 * dkp) = fa::cvtpk(q0 * fexp2(bb0 * LOG2E), q1 * fexp2(bb1 * LOG2E));
            *(LAS unsigned*)(lds + OFF_KS + t * RP + 4 * dkp) = fa::cvtpk(k0 * fexp2((last0 - bb0) * LOG2E), k1 * fexp2((last1 - bb1) * LOG2E));
            *(LAS unsigned*)(lds + OFF_V + (dkp >> 4) * 4096 + t * 64 + (dkp & 15) * 4) = vx[i];
        }
        if (seg == 0) *(LAS v2f*)(lds + OFF_DEC + 8 * dkp) = (v2f){fexp2(last0 * LOG2E), fexp2(last1 * LOG2E)};
        if (c + 1 < NC) HG_LOAD(c + 1);
        HG_LBAR();
        v4u ogw0 = {0u, 0u, 0u, 0u}, ogw1 = ogw0, zw0 = ogw0, zw1 = ogw0;
        { const int tc = tid >> 3, cgc = tid & 7;
          if (tc < T) { const size_t rowc = (size_t)row0 + 64 * c + tc; const v4u* ogq = (const v4u*)(P + rowc * PLD + C_OG + h * 128 + 16 * cgc); const v4u* zq = (const v4u*)(P + rowc * PLD + C_ZB + h * 128 + 16 * cgc);
              ogw0 = ogq[0]; ogw1 = ogq[1]; zw0 = zq[0]; zw1 = zq[1]; } }
        f32x16 X[2];
#pragma unroll
        for (int sb = 0; sb < 2; ++sb) {
#pragma unroll
            for (int e = 0; e < 16; ++e) X[sb][e] = 0.f;
            if (sb <= tb) {
#pragma unroll
                for (int d0 = 0; d0 < 8; ++d0) {
                    const bf16x8 ka = *(const LAS bf16x8*)(lds + OFF_KT + (32 * sb + r) * RP + (16 * d0 + 8 * hh) * 2);
                    const bf16x8 qb = *(const LAS bf16x8*)(lds + OFF_QT + (32 * tb + r) * RP + (16 * d0 + 8 * hh) * 2);
                    X[sb] = __builtin_amdgcn_mfma_f32_32x32x16_bf16(ka, qb, X[sb], 0, 0, 0);
                }
                if (sb == tb) {
#pragma unroll
                    for (int e = 0; e < 16; ++e) X[sb][e] = crow(e, hh) > r ? 0.f : X[sb][e];
                }
            }
        }
        f32x16 o;
#pragma unroll
        for (int e = 0; e < 16; ++e) o[e] = 0.f;
        { const LAS unsigned char* vp = lds + OFF_V + j * 4096 + g16 * 32 + p4 * 8 + (4 * hh + q4) * 64;
#pragma unroll
          for (int sb = 0; sb < 2; ++sb) if (sb <= tb) {
#pragma unroll
              for (int s2 = 0; s2 < 2; ++s2) {
                  const bf16x8 pf = pack8(X[sb], 8 * s2);
                  const s16x4 lo = vtr(vp + (32 * sb + 16 * s2) * 64), hi = vtr(vp + (32 * sb + 16 * s2) * 64 + 512);
                  const bf16x8 vf = __builtin_shufflevector(lo, hi, 0, 1, 2, 3, 4, 5, 6, 7);
                  o = __builtin_amdgcn_mfma_f32_32x32x16_bf16(pf, vf, o, 0, 0, 0);
              } } }
#pragma unroll
        for (int i = 0; i < 4; ++i)
#pragma unroll
            for (int s2 = 0; s2 < 2; ++s2) {
                const LAS unsigned char* ap = lds + OFF_QS + (32 * tb + r) * RP + (32 * i + 16 * s2 + 4 * hh) * 2;
                const v2u alo = *(const LAS v2u*)ap, ahi = *(const LAS v2u*)(ap + 16);
                const v4u a4 = {alo.x, alo.y, ahi.x, ahi.y};
                o = __builtin_amdgcn_mfma_f32_32x32x16_bf16(__builtin_bit_cast(bf16x8, a4), pack8(S[i], 8 * s2), o, 0, 0, 0);
            }
#pragma unroll
        for (int e = 0; e < 16; ++e) *(LAS float*)(lds + OFF_OX + ((32 * tb + crow(e, hh)) * 128 + 32 * j + r) * 4) = o[e];
#pragma unroll
        for (int i = 0; i < 4; ++i)
#pragma unroll
            for (int k4 = 0; k4 < 4; ++k4) { const v4f dq = *(const LAS v4f*)(lds + OFF_DEC + (32 * i + 8 * k4 + 4 * hh) * 4);
                S[i][4 * k4] *= dq.x; S[i][4 * k4 + 1] *= dq.y; S[i][4 * k4 + 2] *= dq.z; S[i][4 * k4 + 3] *= dq.w; }
#pragma unroll
        for (int ks = 0; ks < 4; ++ks) {
            const LAS unsigned char* vq = lds + OFF_V + j * 4096 + (16 * ks + 8 * hh + q4) * 64 + g16 * 32 + p4 * 8;
            const s16x4 vlo = vtr(vq), vhi = vtr(vq + 256);
            const bf16x8 vb = __builtin_shufflevector(vlo, vhi, 0, 1, 2, 3, 4, 5, 6, 7);
#pragma unroll
            for (int i = 0; i < 4; ++i) {
                const LAS unsigned char* kq = lds + OFF_KS + (16 * ks + 8 * hh + q4) * RP + (32 * i + 16 * g16 + 4 * p4) * 2;
                const s16x4 klo = vtr(kq), khi = vtr(kq + 4 * RP);
                const bf16x8 ka = __builtin_shufflevector(klo, khi, 0, 1, 2, 3, 4, 5, 6, 7);
                S[i] = __builtin_amdgcn_mfma_f32_32x32x16_bf16(ka, vb, S[i], 0, 0, 0);
            }
        }
        HG_LBAR();
        {
            const int t = tid >> 3, cg = tid & 7;
            const LAS v4f* ox = (const LAS v4f*)(lds + OFF_OX + (t * 128 + 16 * cg) * 4);
            const v4f x0 = ox[0], x1 = ox[1], x2 = ox[2], x3 = ox[3];
            float ss = (x0.x * x0.x + x0.y * x0.y + x0.z * x0.z + x0.w * x0.w) + (x1.x * x1.x + x1.y * x1.y + x1.z * x1.z + x1.w * x1.w)
                     + (x2.x * x2.x + x2.y * x2.y + x2.z * x2.z + x2.w * x2.w) + (x3.x * x3.x + x3.y * x3.y + x3.z * x3.z + x3.w * x3.w);
            ss += __shfl_xor(ss, 1); ss += __shfl_xor(ss, 2); ss += __shfl_xor(ss, 4);
            if (t < T) {
                const float inv = 1.0f / sqrtf(ss * (1.0f / 128.0f) + NORM_EPS);
                const size_t row = (size_t)row0 + 64 * c + t;
                const float* gn = HGRN_NORM + h * 128 + 16 * cg;
                bf16* yp = Y_ + row * YLD + C_YB + h * 128 + 16 * cg;
                const float og[16] = {bflo(ogw0.x), bfhi(ogw0.x), bflo(ogw0.y), bfhi(ogw0.y), bflo(ogw0.z), bfhi(ogw0.z), bflo(ogw0.w), bfhi(ogw0.w), bflo(ogw1.x), bfhi(ogw1.x), bflo(ogw1.y), bfhi(ogw1.y), bflo(ogw1.z), bfhi(ogw1.z), bflo(ogw1.w), bfhi(ogw1.w)};
                const float z[16] = {bflo(zw0.x), bfhi(zw0.x), bflo(zw0.y), bfhi(zw0.y), bflo(zw0.z), bfhi(zw0.z), bflo(zw0.w), bfhi(zw0.w), bflo(zw1.x), bfhi(zw1.x), bflo(zw1.y), bfhi(zw1.y), bflo(zw1.z), bfhi(zw1.z), bflo(zw1.w), bfhi(zw1.w)};
                const float xv[16] = {x0.x, x0.y, x0.z, x0.w, x1.x, x1.y, x1.z, x1.w, x2.x, x2.y, x2.z, x2.w, x3.x, x3.y, x3.z, x3.w};
                float y[16];
#pragma unroll
                for (int e = 0; e < 16; ++e) y[e] = xv[e] * inv * gn[e] * og[e] * z[e];
                st8bf(yp, *(float(*)[8])y); st8bf(yp + 8, *(float(*)[8])(y + 8));
            }
        }
    }
    if (tb == 0) {
#pragma unroll
        for (int i = 0; i < 4; ++i)
#pragma unroll
            for (int e = 0; e < 16; ++e) sout[(size_t)(32 * i + crow(e, hh)) * 128 + 32 * j + r] = S[i][e];
    }
    HG_BAR();
#undef HG_LOAD
}
}

namespace ca {
using fa::bf16x8; using fa::s16x4; using fa::f32x16; using fa::crow; using fa::pack8; using fa::vtr;
constexpr int KT = 16384, BUF = 32768, WSF_OFF = RING_BYTES + 1024;
DI void load_tile(LAS unsigned char* buf, const bf16* Kg, const bf16* Vg, int kv0, int wave, int lane) {
#pragma unroll
    for (int i = 0; i < 2; ++i) { const int pc = 2 * wave + i;
        glds16(Kg + (size_t)(kv0 + (lane & 31)) * 2048 + (2 * pc + (lane >> 5)) * 8, lds_addr(buf + pc * 1024)); }
#pragma unroll
    for (int i = 0; i < 2; ++i) { const int pc = 2 * wave + i;
        glds16(Vg + (size_t)(kv0 + 16 * (pc & 1) + (lane >> 2)) * 2048 + (pc >> 1) * 32 + (lane & 3) * 8, lds_addr(buf + KT + (pc >> 1) * 2048 + (pc & 1) * 1024)); }
}
DI void cross_unit(Ctx A_, LAS unsigned char* lds, int kvb, int hc, size_t row0, int nrows, int wave, int lane) {
    const int r = lane & 31, hh = lane >> 5, rg = wave & 3, dvh = wave >> 2;
    bf16* P = P_;
    const bf16* Kg = MKV_ + (size_t)kvb * NMEM * 2048 + hc * 256; const bf16* Vg = Kg + 1024;
    LAS float* wsf = (LAS float*)(lds + WSF_OFF) + wave * 128;
    const bool act = rg * 32 < nrows;
    load_tile(lds, Kg, Vg, 0, wave, lane);
    bf16x8 qr[16];
    { const bf16* Qg = P + (row0 + rg * 32 + r) * PLD + C_QC + hc * 256 + hh * 8;
#pragma unroll
      for (int d0 = 0; d0 < 16; ++d0) qr[d0] = *(const bf16x8*)(Qg + d0 * 16); }
    asm volatile("" : "+v"(qr[0]), "+v"(qr[1]), "+v"(qr[2]), "+v"(qr[3]), "+v"(qr[4]), "+v"(qr[5]), "+v"(qr[6]), "+v"(qr[7]), "+v"(qr[8]), "+v"(qr[9]), "+v"(qr[10]), "+v"(qr[11]), "+v"(qr[12]), "+v"(qr[13]), "+v"(qr[14]), "+v"(qr[15]));
    f32x16 o[4];
#pragma unroll
    for (int nb = 0; nb < 4; ++nb)
#pragma unroll
        for (int i = 0; i < 16; ++i) o[nb][i] = 0.f;
    float m = -INFINITY, l = 0.f;
    const int g16 = (lane >> 4) & 1, p4 = lane & 3, q4 = (lane & 15) >> 2;
#pragma unroll 1
    for (int t = 0; t < 8; ++t) {
        asm volatile("s_waitcnt vmcnt(0) lgkmcnt(0)" ::: "memory"); __builtin_amdgcn_s_barrier(); asm volatile("" ::: "memory");
        if (t + 1 < 8) load_tile(lds + ((t + 1) & 1) * BUF, Kg, Vg, (t + 1) * 32, wave, lane);
        if (act) {
            const LAS unsigned char* buf = lds + (t & 1) * BUF;
            const LAS unsigned char* kb = buf + hh * 512 + r * 16;
            f32x16 p0;
#pragma unroll
            for (int i = 0; i < 16; ++i) p0[i] = 0.f;
#pragma unroll
            for (int d0 = 0; d0 < 16; ++d0) p0 = __builtin_amdgcn_mfma_f32_32x32x16_bf16(*(const LAS bf16x8*)(kb + d0 * 1024), qr[d0], p0, 0, 0, 0);
            float tm = p0[0];
#pragma unroll
            for (int i = 1; i < 16; ++i) tm = fmaxf(tm, p0[i]);
            tm = fmaxf(tm, __shfl_xor(tm, 32));
            if (__any(tm > m + RESC_THR)) {
                const float mn = fmaxf(m, tm), f = fexp2(m - mn); m = mn; l *= f;
                if (hh == 0) wsf[r] = f;
                float fr[16];
#pragma unroll
                for (int i = 0; i < 16; ++i) fr[i] = wsf[crow(i, hh)];
#pragma unroll
                for (int nb = 0; nb < 4; ++nb)
#pragma unroll
                    for (int i = 0; i < 16; ++i) o[nb][i] *= fr[i];
            }
            float ls = 0.f;
#pragma unroll
            for (int i = 0; i < 16; ++i) { p0[i] = fexp2(p0[i] - m); ls += p0[i]; }
            l += ls;
            const bf16x8 pf0 = pack8(p0, 0), pf1 = pack8(p0, 8);
            const LAS unsigned char* vp = buf + KT + dvh * 8192 + g16 * 32 + p4 * 8 + (4 * hh + q4) * 64;
#pragma unroll
            for (int ks = 0; ks < 2; ++ks)
#pragma unroll
                for (int nb = 0; nb < 4; ++nb) {
                    const s16x4 lo = vtr(vp + nb * 2048 + ks * 1024), hi = vtr(vp + nb * 2048 + ks * 1024 + 512);
                    const bf16x8 vf = __builtin_shufflevector(lo, hi, 0, 1, 2, 3, 4, 5, 6, 7);
                    o[nb] = __builtin_amdgcn_mfma_f32_32x32x16_bf16(ks == 0 ? pf0 : pf1, vf, o[nb], 0, 0, 0);
                }
        }
    }
    if (act) {
        l += __shfl_xor(l, 32);
        if (hh == 0) wsf[32 + r] = l;
        float rl[16];
#pragma unroll
        for (int i = 0; i < 16; ++i) rl[i] = 1.0f / wsf[32 + crow(i, hh)];
#pragma unroll
        for (int nb = 0; nb < 4; ++nb)
#pragma unroll
            for (int i = 0; i < 16; ++i) {
                const int q = rg * 32 + crow(i, hh);
                if (q < nrows) { const size_t eo = (row0 + q) * PLD + hc * 256 + dvh * 128 + nb * 32 + r; Y_[(row0 + q) * YLD + C_YC + hc * 256 + dvh * 128 + nb * 32 + r] = (bf16)f2bf(o[nb][i] * rl[i] * bf2f(P[eo + C_ZC])); }
            }
    }
    asm volatile("s_waitcnt vmcnt(0) lgkmcnt(0)" ::: "memory"); __builtin_amdgcn_s_barrier(); asm volatile("" ::: "memory");
}
}

namespace da {
using fa::bf16x8; using fa::s16x4; using fa::f32x16; using fa::crow; using fa::pack8; using fa::vtr;
constexpr int CS = 528, KR = 16 * CS, PS = 2080, VR = 4 * PS, VOFF = 34816, WSF_OFF = RING_BYTES + 1024;
constexpr int EX_OFF = 0, MX_OFF = 65536, LX_OFF = 65536 + 1024, X2_OFF = 65536 + 2048;
static_assert(VOFF >= 4 * KR && VOFF + 4 * VR <= RING_BYTES && X2_OFF + 8192 <= RING_BYTES, "decode lds map");
#define DA_BAR() do { asm volatile("s_waitcnt lgkmcnt(0)" ::: "memory"); __builtin_amdgcn_s_barrier(); asm volatile("" ::: "memory"); } while (0)
DI void decode_unit(Ctx A_, LAS unsigned char* lds, int b, int h, float lam, int wave, int lane, int tid) {
    const int r = lane & 31, hh = lane >> 5, mp = wave >> 2, kr = wave & 3;
    bf16* P = P_;
    LAS float* wsf = (LAS float*)(lds + WSF_OFF) + wave * 128;
    const float* Kc = CACHE_K + ((size_t)b * PAST * 8 + h) * 128; const float* Vc = CACHE_V + ((size_t)b * PAST * 8 + h) * 128;
    const size_t rowq = (size_t)MP + b * DS;
    v4f kx[8], vx[8];
    const unsigned voff = (unsigned)((tid >> 5) * 1024 + (tid & 31) * 4);
#define DA_LOAD(st) do { const float* kb_ = Kc + (size_t)(st) * 131072; const float* vb_ = Vc + (size_t)(st) * 131072; \
        _Pragma("unroll") for (int i = 0; i < 8; ++i) { kx[i] = __builtin_nontemporal_load((const v4f*)(kb_ + i * 16384 + voff)); vx[i] = __builtin_nontemporal_load((const v4f*)(vb_ + i * 16384 + voff)); } } while (0)
    DA_LOAD(0);
    const int c4_ = tid & 31, kk_ = tid >> 5;
    LAS unsigned char* kw = lds + (c4_ >> 1) * CS + kk_ * 16 + (c4_ & 1) * 8;
    LAS unsigned char* vw = lds + VOFF + (c4_ >> 3) * PS + kk_ * 64 + (c4_ & 7) * 8;
    bf16x8 qr[4];
    { const bf16* Qg = P + (rowq + (r & 15)) * PLD + C_QA + h * 128 + mp * 64 + hh * 8;
#pragma unroll
      for (int d0 = 0; d0 < 4; ++d0) { const v4u w = *(const v4u*)(Qg + d0 * 16); const v4u z = {0u, 0u, 0u, 0u}; qr[d0] = __builtin_bit_cast(bf16x8, r < 16 ? w : z); } }
    f32x16 o[4];
#pragma unroll
    for (int nb = 0; nb < 4; ++nb)
#pragma unroll
        for (int i = 0; i < 16; ++i) o[nb][i] = 0.f;
    float m = -INFINITY, l = 0.f;
    const int g16 = (lane >> 4) & 1, p4 = lane & 3, q4 = (lane & 15) >> 2;
#pragma unroll 1
    for (int st = 0; st <= PAST / 128; ++st) {
        const bool last = st == PAST / 128;
        v4u nw = {0u, 0u, 0u, 0u};
        if (last) {
            const int t2 = tid & 255, key = t2 >> 4, c8 = t2 & 15;
            nw = *(const v4u*)(P + (rowq + key) * PLD + (tid < 256 ? C_KA : C_VA) + h * 128 + c8 * 8);
        }
        DA_BAR();
        if (!last) {
#pragma unroll
            for (int i = 0; i < 8; ++i) {
                *(LAS v2u*)(kw + (i >> 1) * KR + (i & 1) * 256) = (v2u){fa::cvtpk(kx[i].x, kx[i].y), fa::cvtpk(kx[i].z, kx[i].w)};
                *(LAS v2u*)(vw + (i >> 1) * VR + (i & 1) * 1024) = (v2u){fa::cvtpk(vx[i].x, vx[i].y), fa::cvtpk(vx[i].z, vx[i].w)}; }
            if (st + 1 < PAST / 128) DA_LOAD(st + 1);
        } else {
            const int t2 = tid & 255, key = t2 >> 4, c8 = t2 & 15;
            if (tid < 256) *(LAS v4u*)(lds + c8 * CS + key * 16) = nw;
            else *(LAS v4u*)(lds + VOFF + (c8 >> 2) * PS + key * 64 + (c8 & 3) * 16) = nw;
        }
        DA_BAR();
        if (!last || kr == 0) {
            const LAS unsigned char* kb = lds + kr * KR + (mp * 8 + hh) * CS + r * 16;
            f32x16 p0;
#pragma unroll
            for (int i = 0; i < 16; ++i) p0[i] = 0.f;
#pragma unroll
            for (int d0 = 0; d0 < 4; ++d0) p0 = __builtin_amdgcn_mfma_f32_32x32x16_bf16(*(const LAS bf16x8*)(kb + d0 * 2 * CS), qr[d0], p0, 0, 0, 0);
            if (last) {
#pragma unroll
                for (int i = 8; i < 16; ++i) p0[i] = -INFINITY;
            }
            float tm = p0[0];
#pragma unroll
            for (int i = 1; i < 16; ++i) tm = fmaxf(tm, p0[i]);
            tm = fmaxf(tm, __shfl_xor(tm, 32));
            if (__any(tm > m + RESC_THR)) {
                const float mn = fmaxf(m, tm), f = fexp2(m - mn); m = mn; l *= f;
                if (hh == 0) wsf[r] = f;
                float fr[16];
#pragma unroll
                for (int i = 0; i < 16; ++i) fr[i] = wsf[crow(i, hh)];
#pragma unroll
                for (int nb = 0; nb < 4; ++nb)
#pragma unroll
                    for (int i = 0; i < 16; ++i) o[nb][i] *= fr[i];
            }
            float ls = 0.f;
#pragma unroll
            for (int i = 0; i < 16; ++i) { p0[i] = fexp2(p0[i] - m); ls += p0[i]; }
            l += ls;
            const bf16x8 pf0 = pack8(p0, 0), pf1 = pack8(p0, 8);
            const LAS unsigned char* vp = lds + VOFF + kr * VR + g16 * 32 + p4 * 8 + (4 * hh + q4) * 64;
#pragma unroll
            for (int ks = 0; ks < 2; ++ks)
#pragma unroll
                for (int nb = 0; nb < 4; ++nb) {
                    const s16x4 lo = vtr(vp + nb * PS + ks * 1024), hi = vtr(vp + nb * PS + ks * 1024 + 512);
                    const bf16x8 vf = __builtin_shufflevector(lo, hi, 0, 1, 2, 3, 4, 5, 6, 7);
                    o[nb] = __builtin_amdgcn_mfma_f32_32x32x16_bf16(ks == 0 ? pf0 : pf1, vf, o[nb], 0, 0, 0);
                }
        }
    }
    l += __shfl_xor(l, 32);
    int r_e = r; asm volatile("" : "+v"(r_e));
    float lam_e = lam; asm volatile("" : "+v"(lam_e));
    DA_BAR();
    LAS float* MX = (LAS float*)(lds + MX_OFF); LAS float* LX = (LAS float*)(lds + LX_OFF); LAS float* EX = (LAS float*)(lds + EX_OFF);
    if (hh == 0) MX[wave * 32 + r] = m;
    DA_BAR();
    { const float mg = fmaxf(fmaxf(MX[(mp * 4 + 0) * 32 + r], MX[(mp * 4 + 1) * 32 + r]), fmaxf(MX[(mp * 4 + 2) * 32 + r], MX[(mp * 4 + 3) * 32 + r]));
      const float f = fexp2(m - mg); l *= f;
      if (hh == 0) { wsf[r] = f; LX[wave * 32 + r] = l; }
      float fr[8];
#pragma unroll
      for (int i = 0; i < 8; ++i) fr[i] = wsf[crow(i, hh)];
#pragma unroll
      for (int nb = 0; nb < 4; ++nb)
#pragma unroll
          for (int i = 0; i < 8; ++i) EX[wave * 2048 + (nb * 8 + i) * 64 + lane] = o[nb][i] * fr[i]; }
    DA_BAR();
    float acc[4][8];
    if (kr == 0) {
        float li[8];
#pragma unroll
        for (int i = 0; i < 8; ++i) { const int q = crow(i, hh); li[i] = (mp == 0 ? 1.0f : lam_e) / ((LX[(mp * 4 + 0) * 32 + q] + LX[(mp * 4 + 1) * 32 + q]) + (LX[(mp * 4 + 2) * 32 + q] + LX[(mp * 4 + 3) * 32 + q])); }
#pragma unroll
        for (int nb = 0; nb < 4; ++nb)
#pragma unroll
            for (int i = 0; i < 8; ++i) { const int e = (nb * 8 + i) * 64 + lane;
                acc[nb][i] = ((EX[(mp * 4 + 0) * 2048 + e] + EX[(mp * 4 + 1) * 2048 + e]) + (EX[(mp * 4 + 2) * 2048 + e] + EX[(mp * 4 + 3) * 2048 + e])) * li[i]; }
        if (mp == 1) {
#pragma unroll
            for (int nb = 0; nb < 4; ++nb)
#pragma unroll
                for (int i = 0; i < 8; ++i) *(LAS float*)(lds + X2_OFF + ((nb * 8 + i) * 64 + lane) * 4) = acc[nb][i];
        }
    }
    DA_BAR();
    if (kr == 0 && mp == 0) {
        float ssq[8];
#pragma unroll
        for (int i = 0; i < 8; ++i) ssq[i] = 0.f;
#pragma unroll
        for (int nb = 0; nb < 4; ++nb)
#pragma unroll
            for (int i = 0; i < 8; ++i) { const float d = acc[nb][i] - *(const LAS float*)(lds + X2_OFF + ((nb * 8 + i) * 64 + lane) * 4); acc[nb][i] = d; ssq[i] += d * d; }
#pragma unroll
        for (int i = 0; i < 8; ++i) { float v = ssq[i];
#pragma unroll
            for (int x = 1; x < 32; x <<= 1) v += __shfl_xor(v, x);
            ssq[i] = ONE_M_LAMINIT / sqrtf(v * (1.0f / 128.0f) + NORM_EPS); }
#pragma unroll
        for (int nb = 0; nb < 4; ++nb) { const float sn = SUB_NORM[nb * 32 + r_e];
#pragma unroll
            for (int i = 0; i < 8; ++i) { const size_t rw = rowq + crow(i, hh); Y_[rw * YLD + C_YA + h * 128 + nb * 32 + r_e] = (bf16)f2bf(acc[nb][i] * ssq[i] * sn * bf2f(P[rw * PLD + C_ZA + h * 128 + nb * 32 + r_e])); } }
    }
    DA_BAR();
#undef DA_LOAD
}
}

DI int tid_now() { int t; asm volatile("v_mov_b32 %0, %1" : "=v"(t) : "v"((int)threadIdx.x)); return t; }
__global__ void __launch_bounds__(512, 2) fwd(Args args) {
    extern __shared__ __attribute__((aligned(16))) unsigned char lds_raw[];
    LAS unsigned char* lds = (LAS unsigned char*)lds_raw;
    const int G = gridDim.x, NGW = G * 8;
    const Args& A_ = args;
#define TIDS() const int tid = tid_now(), lane = tid & 63, wave = __builtin_amdgcn_readfirstlane(tid >> 6), gw = blockIdx.x * 8 + wave; (void)lane; (void)gw;
    const int lo = args.ph_lo, hi = args.ph_hi;
#define IN(k) (lo <= (k) && (k) < hi)
#ifdef PROBE_PH
#define PROBE_T0(k) unsigned long long pt0_ = 0; if ((k) == PROBE_PH) pt0_ = __builtin_amdgcn_s_memrealtime();
#define PROBE_SPIN_EPI(code, slot) if ((code) == PROBE_PH) { const unsigned ticks_ = *(volatile LAS unsigned*)(lds + 131072 + 512 + wave * 8 + (slot) * 4); const unsigned long long ps_ = __builtin_amdgcn_s_memrealtime(); while (__builtin_amdgcn_s_memrealtime() - ps_ < ticks_) __builtin_amdgcn_s_sleep(16); }
#define PROBE_SPIN_U(code, slot) if ((code) == PROBE_PH) { const unsigned ticks_ = *(volatile LAS unsigned*)(lds + 131072 + 640 + wave * 32 + (slot) * 4); const unsigned long long ps_ = __builtin_amdgcn_s_memrealtime(); while (__builtin_amdgcn_s_memrealtime() - ps_ < ticks_) __builtin_amdgcn_s_sleep(16); }
#define PROBE_ZERO() { for (int z_ = 0; z_ < 8; ++z_) *(volatile LAS unsigned*)(lds + 131072 + 640 + wave * 32 + z_ * 4) = 0u;  *(volatile LAS unsigned*)(lds + 131072 + 512 + wave * 8) = 0u; *(volatile LAS unsigned*)(lds + 131072 + 512 + wave * 8 + 4) = 0u; }
#define PROBE_F0(k) unsigned long long pf0c_ = 0, pf0r_ = 0; if ((k) == PROBE_PH) { pf0c_ = __builtin_readcyclecounter(); pf0r_ = __builtin_amdgcn_s_memrealtime(); }
#define PROBE_F1(k) if ((k) == PROBE_PH) { const unsigned long long dc_ = __builtin_readcyclecounter() - pf0c_, dr_ = __builtin_amdgcn_s_memrealtime() - pf0r_; const unsigned long long spin_ = dc_ * 2000ull / (dr_ ? dr_ : 1ull); \
        const unsigned long long ps_ = __builtin_amdgcn_s_memrealtime(); while (__builtin_amdgcn_s_memrealtime() - ps_ < spin_) __builtin_amdgcn_s_sleep(16); }
#define PROBE_T1(k) if ((k) == PROBE_PH) { const unsigned long long pt1_ = __builtin_amdgcn_s_memrealtime(); while (__builtin_amdgcn_s_memrealtime() - pt1_ < pt1_ - pt0_) __builtin_amdgcn_s_sleep(16); }
#else
#define PROBE_F0(k)
#define PROBE_F1(k)
#define PROBE_T0(k)
#define PROBE_T1(k)
#define PROBE_SPIN_EPI(code, slot)
#define PROBE_SPIN_U(code, slot)
#define PROBE_ZERO()
#endif
#define BOTH(k) (IN(k) && IN((k) + 1))

    for (int u = threadIdx.x; u < (LDS_BYTES - LDSCTL_OFF) / 4; u += 512) ((LAS unsigned*)(lds + LDSCTL_OFF))[u] = 0u;
    __syncthreads();
    XcdBarrier bar; bar.bar = (unsigned*)WS_(WS_CTL) + CW_BAR + args.li * XCD_BAR_WORDS; bar.x = 0; bar.st = nullptr;
    if (hi - lo > 1) bar = xcd_barrier_post((unsigned*)WS_(WS_CTL) + CW_BAR + args.li * XCD_BAR_WORDS, (volatile LAS unsigned*)(lds + MISC_OFF) + 8);

    if (IN(0)) { PROBE_T0(0) TIDS()
        LAS float* scr = (LAS float*)(lds + wave * 16384);
        constexpr int I_IN = 32 * 544, I_MK = 32 * 32, I_BR = 16 * 64, I_O = 32 * 64;
        constexpr int NIT = I_IN + 2 * I_MK + 3 * I_BR + I_O;
        for (int it = gw; it < NIT; it += NGW) {
            int r = it;
            if (r < I_IN) { p0_transpose_item(W_IN, D, NIN, WT_, 0, scr, r, lane); continue; } r -= I_IN;
            if (r < I_MK) { p0_transpose_item(W_MEM_K, D, 1024, WT_, NIN, scr, r, lane); continue; } r -= I_MK;
            if (r < I_MK) { p0_transpose_item(W_MEM_V, D, 1024, WT_, NIN + 1024, scr, r, lane); continue; } r -= I_MK;
            if (r < I_BR) { p0_transpose_item(W_A, 1024, D, WABC_, 0, scr, r, lane, 3072, 0); continue; } r -= I_BR;
            if (r < I_BR) { p0_transpose_item(W_B, 1024, D, WABC_, 0, scr, r, lane, 3072, 1024); continue; } r -= I_BR;
            if (r < I_BR) { p0_transpose_item(W_C, 1024, D, WABC_, 0, scr, r, lane, 3072, 2048); continue; } r -= I_BR;
            p0_transpose_item(W_OUT, D, D, WO_, 0, scr, r, lane);
        }
        for (int m = gw; m < M + 2048; m += NGW) {
            const float* src = m < MP ? X_PROMPT + (size_t)m * D : (m < M ? X_SAMPLE + (size_t)(m - MP) * D : MEM_PROMPT + (size_t)(m - M) * D);
            p0_row_to_bf16(src, XB_ + (size_t)m * D, lane);
        }
        for (int i = blockIdx.x * 512 + tid; i < (PAST + DS) * 8; i += G * 512) p0_rope_entry(ROPE_, i);
        for (int it = gw; it < DB * NMEM * 2; it += NGW) {
            const int row = it >> 1, kv = it & 1;
            const v4f* src = (const v4f*)((kv ? CACHE_MV : CACHE_MK) + (size_t)row * 1024) + lane; v2u* dst = (v2u*)(MKV_ + (size_t)(2048 + row) * 2048 + kv * 1024) + lane;
#pragma unroll
            for (int j = 0; j < 4; ++j) { const v4f v = src[64 * j]; dst[64 * j] = (v2u){pk2(v.x, v.y), pk2(v.z, v.w)}; }
        }
        PROBE_T1(0)
        if (BOTH(0)) xcd_barrier(bar);
    }

    if (IN(1)) {
        pg8::GemmT<0, 0, 0> g{(const char*)XB_, (const char*)WT_, D, D, D, 0};
        InProjOrder S{G, (int)blockIdx.x};
        EpiIn E{P_, G_, OUT_, MKV_, LB_LOGITS, ROPE_, KC_, VC_, GT_};
        { const int wave = __builtin_amdgcn_readfirstlane(threadIdx.x >> 6); (void)wave; PROBE_ZERO() PROBE_F0(101) PROBE_T0(1) pg8::gemm_phase<EpiIn, InProjOrder, true, true>(lds, g, S, E); PROBE_T1(1) PROBE_F1(101) PROBE_SPIN_EPI(13, 0) }
        if (BOTH(1)) xcd_barrier(bar);
    }

    if (IN(2)) { TIDS()
        const float lam = __int_as_float(__builtin_amdgcn_readfirstlane(__float_as_int(lam_of(A_, lane))));
        PROBE_T0(2)
        unsigned* qctr = (unsigned*)WS_(WS_CTL) + CW_QUEUE;
        volatile LAS unsigned* qw = (volatile LAS unsigned*)(lds + LDSCTL_OFF + 64);
        int qit = 0;
#define Q_NEXT(k, id) do { if (tid == 0) qw[qit & 1] = __hip_atomic_fetch_add(qctr + 64 * (k), 1u, __ATOMIC_RELAXED, __HIP_MEMORY_SCOPE_AGENT); __syncthreads(); \
        id = __builtin_amdgcn_readfirstlane((int)qw[qit & 1]); ++qit; } while (0)
        bool had_chain = false;
        { PROBE_T0(21)
#pragma unroll 1
        for (;;) { int id; Q_NEXT(0, id); if (id >= 64 + 256) break; had_chain = had_chain || id < 64; const int tid = tid_now(), lane = tid & 63;
            const bool pr = id < 64; const int sidx = id - 64;
            hg::hgrn_unit(A_, lds, pr ? (id >> 3) * SEQ : MP + (sidx >> 3) * DS, pr ? 64 : DS, pr ? SEQ / 64 : 1, id & 7, pr ? (const float*)nullptr : STATE_HGRN + (size_t)sidx * 16384,
                          pr ? OUT_ + O_HP + (size_t)id * 16384 : OUT_ + O_HS + (size_t)sidx * 16384, wave, lane, tid); }
        PROBE_T1(21) }
        if (!had_chain && (blockIdx.x & 1)) {
#pragma unroll 1
            for (;;) { int id; Q_NEXT(1, id); if (id >= 256) break; const int tid = tid_now(), lane = tid & 63; da::decode_unit(A_, lds, id >> 3, id & 7, lam, wave, lane, tid); }
        }
#pragma unroll 1
        for (;;) { int id; Q_NEXT(2, id); if (id >= 2048) break; const int lane = tid_now() & 63; fa::attn_unit(A_, lds, id >> 8, (id >> 5) & 7, 31 - (id & 31), lam, wave, lane); }
        { PROBE_T0(23)
#pragma unroll 1
        for (;;) { int id; Q_NEXT(3, id); if (id >= 1152) break; const int lane = tid_now() & 63;
            if (id < 1024) { const int qb = id & 31, hc = (id >> 5) & 3, b = id >> 7; ca::cross_unit(A_, lds, b, hc, (size_t)b * SEQ + qb * 128, 128, wave, lane); }
            else { const int sidx = id - 1024, hc = sidx & 3, b = sidx >> 2; ca::cross_unit(A_, lds, 8 + b, hc, (size_t)MP + b * DS, DS, wave, lane); } }
        PROBE_T1(23) }
#undef Q_NEXT
        PROBE_T1(2)
#if defined(PROBE_PH) && PROBE_PH == 200
        { const unsigned long long pa_ = __builtin_amdgcn_s_memrealtime(); xcd_barrier(bar); const unsigned long long pb_ = __builtin_amdgcn_s_memrealtime(); while (__builtin_amdgcn_s_memrealtime() - pb_ < pb_ - pa_) __builtin_amdgcn_s_sleep(16); }
#else
        if (BOTH(2)) xcd_barrier(bar);
#endif
    }

    if (IN(3)) {
        pg8::GemmT<0, 0, 0> g{(const char*)Y_, (const char*)WABC_, YLD, 3072, 3072, 0};
        MergeOrder S{G, (int)blockIdx.x};
        EpiMerge E{GT_, MG_};
        { const int wave = __builtin_amdgcn_readfirstlane(threadIdx.x >> 6); (void)wave; PROBE_ZERO() PROBE_F0(103) PROBE_T0(3) pg8::gemm_phase<EpiMerge, MergeOrder, true, true>(lds, g, S, E); PROBE_T1(3) PROBE_F1(103) PROBE_SPIN_EPI(33, 0) PROBE_SPIN_EPI(34, 1) PROBE_SPIN_U(35, 0) PROBE_SPIN_U(36, 1) PROBE_SPIN_U(37, 2) PROBE_SPIN_U(38, 3) PROBE_SPIN_U(39, 4) }
        if (BOTH(3)) xcd_barrier(bar);
    }

    if (IN(4)) {
        pg8::GemmT<0, 0, 0> g{(const char*)MG_, (const char*)WO_, D, D, D, 0};
        OutOrder S{G, (int)blockIdx.x};
        EpiOut E{X_PROMPT, X_SAMPLE, PRE_};
        { const int wave = __builtin_amdgcn_readfirstlane(threadIdx.x >> 6); (void)wave; PROBE_ZERO() PROBE_T0(4) pg8::gemm_phase<EpiOut, OutOrder, true, true>(lds, g, S, E); PROBE_T1(4) PROBE_SPIN_EPI(43, 0) PROBE_SPIN_U(45, 0) PROBE_SPIN_U(46, 1) PROBE_SPIN_U(47, 2) PROBE_SPIN_U(48, 3) PROBE_SPIN_U(49, 4) }
        if (BOTH(4)) xcd_barrier(bar);
    }

    if (IN(5)) { TIDS() PROBE_T0(5) for (int m = gw; m < M; m += NGW) ln_row(A_, m, lane); PROBE_T1(5) }
#undef IN
#undef BOTH
}

extern "C" void kernel_launch(void* const* d_in, const int* in_sizes, int n_in, void* d_out, int out_size, void* d_ws, size_t ws_size, hipStream_t stream) {
    static int grid = 0;
    if (grid == 0) {
        if (n_in != 24 || (size_t)out_size != O_END || ws_size < WS_END2) { fprintf(stderr, "kernel_launch: unexpected shapes (n_in %d out %d ws %zu, need ws %zu); nothing launched\n", n_in, out_size, ws_size, (size_t)WS_END2); grid = -1; return; }
        int dev = 0, cus = 0;
        if (hipGetDevice(&dev) != hipSuccess || hipDeviceGetAttribute(&cus, hipDeviceAttributeMultiprocessorCount, dev) != hipSuccess) { grid = -1; return; }
        if (hipFuncSetAttribute((const void*)fwd, hipFuncAttributeMaxDynamicSharedMemorySize, LDS_BYTES) != hipSuccess) { fprintf(stderr, "kernel_launch: hipFuncSetAttribute failed\n"); grid = -1; return; }
        grid = cus > 0 ? cus : 256;
    }
    if (grid < 0) return;
    if (hipMemsetAsync((char*)d_ws + WS_CTL, 0, CTL_ZERO_BYTES, stream) != hipSuccess) return;
    Args a{};
    for (int i = 0; i < 24; ++i) a.in[i] = (const float*)d_in[i];
    a.out = (float*)d_out; a.ws = (unsigned char*)d_ws;
    a.ph_lo = 0; a.ph_hi = 6; a.li = 0; hipLaunchKernelGGL(fwd, dim3(grid), dim3(512), LDS_BYTES, stream, a);
    const hipError_t le = hipPeekAtLastError();
    if (le != hipSuccess) fprintf(stderr, "kernel_launch: launch failed: %s\n", hipGetErrorName(le));
}
```
